# Optimizing an MI355X kernel written in HIP

```python
import math
import numpy as np
import jax
import jax.numpy as jnp
from jax import lax

D_MODEL = 1024
BATCH = 8
SEQ = 8192
DEPTH = 1
DEC_BATCH = 1
DEC_SEQ = 16384
PAST_LEN = 128

GRID_W = 64
HEAD_DIM = 128
N_Q_HEADS = 8
N_KV_HEADS = 2
ATTN_W = N_Q_HEADS * HEAD_DIM
KV_W = N_KV_HEADS * HEAD_DIM
Q_BLOCK = 128
ROPE_THETA = 10000.0
SSM_W = 512
SSM_GROUP = 16
SSM_GROUPS = SSM_W // SSM_GROUP
SSM_STATE = 64
STEP_MIN = 0.001
STEP_MAX = 0.1
N_MEM = 256
X_HEADS = 4
X_HEAD_DIM = 128
X_W = X_HEADS * X_HEAD_DIM
N_BRANCH = 3
IN_SIZES = (ATTN_W, KV_W, KV_W, ATTN_W, SSM_W, SSM_W, X_W, X_W, N_BRANCH * D_MODEL)
IN_W = ATTN_W + 2 * KV_W + ATTN_W + 2 * SSM_W + 2 * X_W + N_BRANCH * D_MODEL
EPS = 1e-6
F32 = jnp.float32

kernel_name = 'hybrid_gqa_s5_memory_encoder'


def rmsnorm(x, g):
    xf = x.astype(F32)
    y = xf * lax.rsqrt(jnp.mean(xf * xf, axis=-1, keepdims=True) + EPS) * g.astype(F32)
    return y.astype(x.dtype)


def axial_rope(seq_len):
    rows = seq_len // GRID_W
    row = jnp.broadcast_to(jnp.arange(rows, dtype=F32)[:, None], (rows, GRID_W)).reshape(-1)
    col = jnp.broadcast_to(jnp.arange(GRID_W, dtype=F32)[None, :], (rows, GRID_W)).reshape(-1)
    n_pairs = HEAD_DIM // 4
    freqs = ROPE_THETA ** (-jnp.arange(n_pairs, dtype=F32) / n_pairs)
    ang = jnp.concatenate([row[:, None] * freqs, col[:, None] * freqs], axis=-1)
    return jnp.cos(ang), jnp.sin(ang)


def apply_rope(x, cos, sin):
    xr = x.reshape(x.shape[:-1] + (HEAD_DIM // 2, 2))
    x0, x1 = xr[..., 0], xr[..., 1]
    c = cos[None, :, None, :]
    s = sin[None, :, None, :]
    return jnp.stack([x0 * c - x1 * s, x0 * s + x1 * c], axis=-1).reshape(x.shape)


def blocked_gqa(q, k, v):
    bsz, seq_len = q.shape[:2]
    grp = N_Q_HEADS // N_KV_HEADS
    n_blocks = seq_len // Q_BLOCK
    qb = q.reshape(bsz, n_blocks, Q_BLOCK, N_KV_HEADS, grp, HEAD_DIM).transpose(1, 0, 2, 3, 4, 5)
    scale = HEAD_DIM ** -0.5

    def one_block(qi):
        s = jnp.einsum('bqkgd,bskd->bkgqs', qi, k) * scale
        p = jax.nn.softmax(s.astype(F32), axis=-1)
        return jnp.einsum('bkgqs,bskd->bqkgd', p, v)

    o = lax.map(one_block, qb)
    return o.transpose(1, 0, 2, 3, 4, 5).reshape(bsz, seq_len, ATTN_W)


def s5_scan(u_g, a_re, a_im, b_re, b_im, c_re, c_im, log_step, reverse):
    lam = lax.complex(jnp.minimum(a_re.astype(F32), -1e-4), a_im.astype(F32))
    step = jnp.exp(log_step.astype(F32))[:, None]
    lam_bar = jnp.exp(lam * step)
    b_mat = lax.complex(b_re.astype(F32), b_im.astype(F32))
    b_bar = ((lam_bar - 1.0) / lam)[..., None] * b_mat
    bu = jnp.einsum('gnc,blgc->blgn', b_bar, u_g.astype(jnp.complex64))
    a = jnp.broadcast_to(lam_bar, bu.shape)

    def combine(left, right):
        a1, b1 = left
        a2, b2 = right
        return a2 * a1, a2 * b1 + b2

    _, states = lax.associative_scan(combine, (a, bu), axis=1, reverse=reverse)
    c_mat = lax.complex(c_re.astype(F32), c_im.astype(F32))
    return jnp.einsum('gcn,blgn->blgc', c_mat, states).real


def memory_cross_attention(q_x, mem, norm_mem, w_mem_kv):
    bsz, seq_len, _ = q_x.shape
    n_mem = mem.shape[1]
    kv = (rmsnorm(mem, norm_mem) @ w_mem_kv).astype(F32)
    k_m, v_m = jnp.split(kv, 2, axis=-1)
    k_m = k_m.reshape(bsz, n_mem, X_HEADS, X_HEAD_DIM)
    v_m = v_m.reshape(bsz, n_mem, X_HEADS, X_HEAD_DIM)
    qh = q_x.astype(F32).reshape(bsz, seq_len, X_HEADS, X_HEAD_DIM)
    s = jnp.einsum('blhd,bmhd->bhlm', qh, k_m) * (X_HEAD_DIM ** -0.5)
    p = jax.nn.softmax(s, axis=-1)
    return jnp.einsum('bhlm,bmhd->blhd', p, v_m).reshape(bsz, seq_len, X_W)


def hybrid_layer(x, mem, norm_in, w_in, q_norm, k_norm, s5_a_re, s5_a_im, s5_b_re, s5_b_im,
                 s5_c_re, s5_c_im, s5_log_step, s5_d, w_glu, b_glu, norm_mem, w_mem_kv,
                 w_proj_attn, w_proj_ssm, w_proj_cross, w_out):
    bsz, seq_len, _ = x.shape
    h = rmsnorm(x, norm_in)
    z = h @ w_in
    split_at = np.cumsum(IN_SIZES)[:-1].tolist()
    q, k, v, gate_a, u_s, gate_s, q_x, gate_x, merge_logits = jnp.split(z, split_at, axis=-1)

    cos, sin = axial_rope(seq_len)
    qh = rmsnorm(q.astype(F32).reshape(bsz, seq_len, N_Q_HEADS, HEAD_DIM), q_norm)
    kh = rmsnorm(k.astype(F32).reshape(bsz, seq_len, N_KV_HEADS, HEAD_DIM), k_norm)
    qh = apply_rope(qh, cos, sin)
    kh = apply_rope(kh, cos, sin)
    vh = v.astype(F32).reshape(bsz, seq_len, N_KV_HEADS, HEAD_DIM)
    y_a = blocked_gqa(qh, kh, vh) * jax.nn.silu(gate_a.astype(F32))

    u = u_s.astype(F32)
    u_g = u.reshape(bsz, seq_len, SSM_GROUPS, SSM_GROUP)
    y_s = (s5_scan(u_g, s5_a_re[0], s5_a_im[0], s5_b_re[0], s5_b_im[0], s5_c_re[0], s5_c_im[0], s5_log_step[0], False)
           + s5_scan(u_g, s5_a_re[1], s5_a_im[1], s5_b_re[1], s5_b_im[1], s5_c_re[1], s5_c_im[1], s5_log_step[1], True))
    y_s = y_s.reshape(bsz, seq_len, SSM_W) + s5_d.astype(F32) * u
    y_s = jax.nn.gelu(y_s)
    y_s = y_s * jax.nn.sigmoid(y_s @ w_glu.astype(F32) + b_glu.astype(F32))
    y_s = y_s * jax.nn.silu(gate_s.astype(F32))

    y_x = memory_cross_attention(q_x, mem, norm_mem, w_mem_kv) * jax.nn.silu(gate_x.astype(F32))

    g = jax.nn.sigmoid(merge_logits.astype(F32)).reshape(bsz, seq_len, N_BRANCH, D_MODEL)
    merged = (g[:, :, 0] * (y_a.astype(x.dtype) @ w_proj_attn)
              + g[:, :, 1] * (y_s.astype(x.dtype) @ w_proj_ssm)
              + g[:, :, 2] * (y_x.astype(x.dtype) @ w_proj_cross))
    return x + (merged.astype(x.dtype) @ w_out)


def trunk(x, mem, norm_in, w_in, q_norm, k_norm, s5_a_re, s5_a_im, s5_b_re, s5_b_im, s5_c_re,
          s5_c_im, s5_log_step, s5_d, w_glu, b_glu, norm_mem, w_mem_kv, w_proj_attn, w_proj_ssm,
          w_proj_cross, w_out, norm_final):
    for l in range(DEPTH):
        x = hybrid_layer(x, mem, norm_in[l], w_in[l], q_norm[l], k_norm[l], s5_a_re[l], s5_a_im[l],
                         s5_b_re[l], s5_b_im[l], s5_c_re[l], s5_c_im[l], s5_log_step[l], s5_d[l],
                         w_glu[l], b_glu[l], norm_mem[l], w_mem_kv[l], w_proj_attn[l], w_proj_ssm[l],
                         w_proj_cross[l], w_out[l])
    return rmsnorm(x, norm_final)


def setup_inputs(seed: int = 0) -> dict:
    key = jax.random.key(seed)
    ks = jax.random.split(key, 28)
    nrm = lambda k, shape, scale: jax.random.normal(k, shape, F32) * scale
    n_idx = jnp.arange(SSM_STATE, dtype=F32)
    s5_shape = (DEPTH, 2, SSM_GROUPS, SSM_STATE)
    return {
        'x_prompt': nrm(ks[0], (BATCH, SEQ, D_MODEL), 1.0),
        'x_sample': nrm(ks[1], (DEC_BATCH, DEC_SEQ, D_MODEL), 1.0),
        'mem_prompt': nrm(ks[2], (BATCH, N_MEM, D_MODEL), 1.0),
        'mem_sample': nrm(ks[3], (DEC_BATCH, N_MEM, D_MODEL), 1.0),
        'norm_in': 1.0 + nrm(ks[4], (DEPTH, D_MODEL), 0.02),
        'w_in': nrm(ks[5], (DEPTH, D_MODEL, IN_W), D_MODEL ** -0.5),
        'q_norm': 1.0 + nrm(ks[6], (DEPTH, HEAD_DIM), 0.02),
        'k_norm': 1.0 + nrm(ks[7], (DEPTH, HEAD_DIM), 0.02),
        's5_a_re': -0.5 + nrm(ks[8], s5_shape, 0.01),
        's5_a_im': math.pi * n_idx + nrm(ks[9], s5_shape, 0.01),
        's5_b_re': nrm(ks[10], (DEPTH, 2, SSM_GROUPS, SSM_STATE, SSM_GROUP), (2.0 * SSM_GROUP) ** -0.5),
        's5_b_im': nrm(ks[11], (DEPTH, 2, SSM_GROUPS, SSM_STATE, SSM_GROUP), (2.0 * SSM_GROUP) ** -0.5),
        's5_c_re': nrm(ks[12], (DEPTH, 2, SSM_GROUPS, SSM_GROUP, SSM_STATE), (2.0 * SSM_STATE) ** -0.5),
        's5_c_im': nrm(ks[13], (DEPTH, 2, SSM_GROUPS, SSM_GROUP, SSM_STATE), (2.0 * SSM_STATE) ** -0.5),
        's5_log_step': jax.random.uniform(ks[14], (DEPTH, 2, SSM_GROUPS), F32, math.log(STEP_MIN), math.log(STEP_MAX)),
        's5_d': nrm(ks[15], (DEPTH, SSM_W), 1.0),
        'w_glu': nrm(ks[16], (DEPTH, SSM_W, SSM_W), SSM_W ** -0.5),
        'b_glu': nrm(ks[17], (DEPTH, SSM_W), 0.01),
        'norm_mem': 1.0 + nrm(ks[18], (DEPTH, D_MODEL), 0.02),
        'w_mem_kv': nrm(ks[19], (DEPTH, D_MODEL, 2 * X_W), D_MODEL ** -0.5),
        'w_proj_attn': nrm(ks[20], (DEPTH, ATTN_W, D_MODEL), ATTN_W ** -0.5),
        'w_proj_ssm': nrm(ks[21], (DEPTH, SSM_W, D_MODEL), SSM_W ** -0.5),
        'w_proj_cross': nrm(ks[22], (DEPTH, X_W, D_MODEL), X_W ** -0.5),
        'w_out': nrm(ks[23], (DEPTH, D_MODEL, D_MODEL), D_MODEL ** -0.5),
        'norm_final': 1.0 + nrm(ks[24], (D_MODEL,), 0.02),
    }


def reference(x_prompt, x_sample, mem_prompt, mem_sample, norm_in, w_in, q_norm, k_norm,
              s5_a_re, s5_a_im, s5_b_re, s5_b_im, s5_c_re, s5_c_im, s5_log_step, s5_d,
              w_glu, b_glu, norm_mem, w_mem_kv, w_proj_attn, w_proj_ssm, w_proj_cross,
              w_out, norm_final):
    weights = (norm_in, w_in, q_norm, k_norm, s5_a_re, s5_a_im, s5_b_re, s5_b_im, s5_c_re,
               s5_c_im, s5_log_step, s5_d, w_glu, b_glu, norm_mem, w_mem_kv, w_proj_attn,
               w_proj_ssm, w_proj_cross, w_out, norm_final)
    y_prompt = trunk(x_prompt, mem_prompt, *weights)
    y_sample = trunk(x_sample, mem_sample, *weights)
    return (y_prompt, y_sample)
```

```cpp
#include <hip/hip_runtime.h>
#include <hip/hip_cooperative_groups.h>
#include <cstdio>
#include <cstdint>
namespace cg = cooperative_groups;

#define LAS __attribute__((address_space(3)))
typedef unsigned short bf16_t;
typedef short bf16x8 __attribute__((ext_vector_type(8)));
typedef short s16x4 __attribute__((ext_vector_type(4)));
typedef float f32x4 __attribute__((ext_vector_type(4)));
typedef float f32x16 __attribute__((ext_vector_type(16)));
typedef unsigned u32x4 __attribute__((ext_vector_type(4)));
typedef unsigned u32x2 __attribute__((ext_vector_type(2)));

constexpr int DM = 1024, NTOK = 81920, NPROMPT = 65536, SEQ_P = 8192, SEQ_S = 16384;
constexpr int NMEMROWS = 2304;
constexpr int CH = 64;
constexpr int NCHUNK = NTOK / CH;
constexpr int AGK = 1280;
constexpr float EPS = 1e-6f;

constexpr size_t MiB = 1u << 20;
constexpr size_t WS_COS = 1 * MiB, WS_SIN = 1 * MiB + 65536;
constexpr size_t WS_KT = 2 * MiB;
constexpr size_t WS_WIN = 6 * MiB;
constexpr size_t WS_WMKV = 21 * MiB, WS_WPA = 23 * MiB, WS_WPS = 25 * MiB, WS_WPX = 26 * MiB, WS_WOUT = 27 * MiB, WS_WGLU = 29 * MiB;
constexpr size_t WS_MN = 30 * MiB, WS_KVM = 35 * MiB;
constexpr size_t WS_XN = 40 * MiB;
constexpr size_t WS_Q = 200 * MiB;
constexpr size_t WS_GA = 360 * MiB;
constexpr size_t WS_K = 520 * MiB, WS_V = 560 * MiB, WS_U = 600 * MiB;
constexpr size_t WS_PS = 520 * MiB;
constexpr size_t WS_GS = 680 * MiB;
constexpr size_t WS_QX = 760 * MiB;
constexpr size_t WS_GX = 840 * MiB;
constexpr size_t WS_PX = 840 * MiB;
constexpr size_t WS_END = 1000 * MiB;
constexpr size_t DO_AG = 0, DO_WG = 100 * MiB, DO_WE = 180 * MiB, DO_EC = 196 * MiB;

constexpr int LDS_BYTES = 135168;

__device__ __forceinline__ unsigned cvtpk(float lo, float hi) { unsigned r; asm volatile("v_cvt_pk_bf16_f32 %0, %1, %2" : "=v"(r) : "v"(lo), "v"(hi)); return r; }
__device__ __forceinline__ float bflo(unsigned w) { return __uint_as_float(w << 16); }
__device__ __forceinline__ float bfhi(unsigned w) { return __uint_as_float(w & 0xffff0000u); }
__device__ __forceinline__ float bf2f(bf16_t s) { return __uint_as_float(((unsigned)s) << 16); }
__device__ __forceinline__ float sigmoidf_(float x) { return __builtin_amdgcn_rcpf(1.f + __builtin_amdgcn_exp2f(-1.4426950408889634f * x)); }
__device__ __forceinline__ float siluf_(float x) { return x * sigmoidf_(x); }
__device__ __forceinline__ float gelu_tanh_(float x) { return x * sigmoidf_(1.5957691216057308f * (x + 0.044715f * x * x * x)); }
__device__ __forceinline__ int opaque_tid(int wv) { int l; asm volatile("v_mbcnt_lo_u32_b32 %0, -1, 0\n\tv_mbcnt_hi_u32_b32 %0, -1, %0" : "=v"(l)); return wv * 64 + l; }
__device__ __forceinline__ float wave_sum(float v) {
#pragma unroll
    for (int o = 1; o < 64; o <<= 1) v += __shfl_xor(v, o);
    return v;
}
__device__ __forceinline__ void cexp_turns(float turns, float& c, float& s) { const float f = turns - rintf(turns); c = cospif(2.f * f); s = sinpif(2.f * f); }
__device__ __forceinline__ void lam_pow(float are, float aim, float dt, float p, float& re, float& im) {
    const float mag = __expf(are * dt * p); float c, s; cexp_turns(aim * dt * p * 0.15915494309189535f, c, s); re = mag * c; im = mag * s;
}
__device__ __forceinline__ void zoh_coef(float are, float aim, float dt, float& cr, float& ci) {
    const float x = are * dt, y = aim * dt; const float ex1 = expm1f(x); float cy, sy; cexp_turns(y * 0.15915494309189535f, cy, sy);
    const float re1 = ex1 * cy + (cy - 1.f), im1 = (1.f + ex1) * sy; const float den = 1.f / (are * are + aim * aim);
    cr = (re1 * are + im1 * aim) * den; ci = (im1 * are - re1 * aim) * den;
}

namespace pg8 {
constexpr int BM = 256, BK = 64, HALF = 128, HTB = HALF * BK * 2, STAGE_BYTES = 8 * HTB, NXCD = 8, WGM = 8;
__host__ __device__ __forceinline__ int lds_byte(int r, int c) { const int st = (r >> 4) * 2 + (c >> 5), rr = r & 15, cc = c & 31, ob = rr * 64 + cc * 2; return st * 1024 + (ob ^ (((ob >> 9) & 1) << 5)); }
__host__ __device__ __forceinline__ void stage_rc(int b, int& R, int& C) { const int st = b / 1024, sb = b % 1024, swz = sb ^ (((sb >> 9) & 1) << 5); R = (st >> 1) * 16 + swz / 64; C = (st & 1) * 32 + (swz % 64) / 2; }
__host__ __device__ __forceinline__ int perm32(int rho) { const int n = rho >> 4, i = rho & 15; return 8 * (i >> 2) + 4 * n + (i & 3); }
struct Unit { int pm, pn; };
struct Gemm { const bf16_t* A; const bf16_t* Bt; int lda, ldb, K; };

struct StaticOrder {
    int nM, nN, nwg, G, c;
    __device__ void init(int M, int N, int G_, int c_) { nM = M / BM; nN = N / BM; nwg = nM * nN; G = G_; c = c_; }
    __device__ bool next(int i, Unit& u) const {
        const long L = (long)i * G + c; if (L >= nwg) return false;
        int wgid = (int)L; { const int q = nwg / NXCD, r = nwg % NXCD, xcd = wgid % NXCD, off = wgid / NXCD; wgid = (xcd < r ? xcd * (q + 1) : r * (q + 1) + (xcd - r) * q) + off; }
        const int nig = WGM * nN, gid = wgid / nig, fm = gid * WGM, gsz = (nM - fm) < WGM ? (nM - fm) : WGM;
        u.pm = fm + ((wgid % nig) % gsz); u.pn = (wgid % nig) / gsz; return true;
    }
};
struct GroupedOrder {
    int RT, CT, total, G, c;
    __device__ void init(int ng, int RT_, int CT_, int G_, int c_) { RT = RT_; CT = CT_; total = ng * RT_ * CT_; G = G_; c = c_; }
    __device__ bool next(int i, Unit& u) const {
        const int L = i * G + c; if (L >= total) return false;
        const int per = RT * CT, g = L / per, rem = L % per, b = rem / RT, a = rem % RT; u.pm = g * RT + a; u.pn = g * CT + b; return true;
    }
};
struct TripleOrder {
    int G, c;
    __device__ bool next(int i, Unit& u) const {
        const int tr = (i / 3) * G + c; if (tr >= 1280) return false;
        const int br = i % 3; u.pm = tr >> 2; u.pn = br * 4 + (tr & 3); return true;
    }
};

template <class F> struct Epi8 {
    static constexpr bool PERM = true;
    F f;
    __device__ __forceinline__ void operator()(const f32x4 (&acc)[2][2][4][2], const Unit& u, int wr, int wc, int fr, int fq) const {
        const int row0 = u.pm * BM + wr * 64 + fr, col0 = u.pn * BM + wc * 32 + 8 * fq;
#pragma unroll
        for (int ai = 0; ai < 2; ++ai)
#pragma unroll
            for (int m = 0; m < 4; ++m) {
#pragma unroll
                for (int bj = 0; bj < 2; ++bj) f(u, row0 + ai * HALF + m * 16, col0 + bj * HALF, acc[ai][bj][m][0], acc[ai][bj][m][1]);
                asm volatile("" ::: "memory");
            }
    }
};

template <class Epi, class Sched>
__device__ __forceinline__ void gemm_phase(LAS unsigned char* lds, const Gemm g, const Sched& S, const Epi& E, int wv) {
    const int tid = opaque_tid(wv), wid = __builtin_amdgcn_readfirstlane(tid >> 6), lane = tid & 63, wr = wid >> 2, wc = wid & 3, fr = lane & 15, fq = lane >> 4;
    const int K = g.K, nt = K / BK;
    unsigned voffA[2], voffB[2];
#pragma unroll
    for (int i = 0; i < 2; ++i) { int R, C; stage_rc(tid * 16 + i * 8192, R, C); const int Rb = Epi::PERM ? ((R & ~31) + perm32(R & 31)) : R;
        voffA[i] = (unsigned)(R * g.lda + C) * 2u; voffB[i] = (unsigned)(Rb * g.ldb + C) * 2u; }
    const size_t kstep = (size_t)(BK * 2);
    const size_t hstepA = (size_t)HALF * g.lda * 2, hstepB = (size_t)HALF * g.ldb * 2;
    const size_t tstepA = 2 * hstepA, tstepB = 2 * hstepB;
    const unsigned ldsw = (unsigned)wid * 1024u;
    const int aoff = lds_byte(wr * 64 + fr, fq * 8), boff = lds_byte(wc * 32 + fr, fq * 8);
#define PG8_SA(b, h) (((b) * 2 + (h)) * HTB)
#define PG8_SB(b, h) ((4 + (b) * 2 + (h)) * HTB)
#define PG8_STAGE(bufoff, gbase, voff) do { _Pragma("unroll") for (int _i = 0; _i < 2; ++_i) \
        __builtin_amdgcn_global_load_lds((const unsigned*)((const char*)(gbase) + (voff)[_i]), (LAS unsigned*)(lds + (bufoff) + ldsw + _i * 8192), 16, 0, 0); } while (0)
#define PG8_LDA(dst, b, h) do { _Pragma("unroll") for (int m = 0; m < 4; ++m) _Pragma("unroll") for (int k = 0; k < 2; ++k) dst[m][k] = *(const LAS bf16x8*)(lds + PG8_SA(b, h) + aoff + m * 2048 + k * 1024); } while (0)
#define PG8_LDB(dst, b, h) do { _Pragma("unroll") for (int n = 0; n < 2; ++n) _Pragma("unroll") for (int k = 0; k < 2; ++k) dst[n][k] = *(const LAS bf16x8*)(lds + PG8_SB(b, h) + boff + n * 2048 + k * 1024); } while (0)
#define PG8_MMA(ai, bj, At, Bt) do { __builtin_amdgcn_s_setprio(1); _Pragma("unroll") for (int m = 0; m < 4; ++m) _Pragma("unroll") for (int n = 0; n < 2; ++n) _Pragma("unroll") for (int k = 0; k < 2; ++k) \
        acc[ai][bj][m][n] = __builtin_amdgcn_mfma_f32_16x16x32_bf16(Bt[n][k], At[m][k], acc[ai][bj][m][n], 0, 0, 0); __builtin_amdgcn_s_setprio(0); } while (0)
#define PG8_WAIT_V(n) asm volatile("s_waitcnt vmcnt(" #n ")" ::: "memory")
#define PG8_WAIT_L(n) asm volatile("s_waitcnt lgkmcnt(" #n ")" ::: "memory")
#define PG8_BAR __builtin_amdgcn_s_barrier()
#define PG8_SCHED __builtin_amdgcn_sched_barrier(0)
    Unit cur, nxt; int ui = 0;
    if (!S.next(0, cur)) return;
    f32x4 acc[2][2][4][2];
#pragma unroll
    for (int a = 0; a < 2; ++a)
#pragma unroll
        for (int b = 0; b < 2; ++b)
#pragma unroll
            for (int m = 0; m < 4; ++m)
#pragma unroll
                for (int n = 0; n < 2; ++n) acc[a][b][m][n] = (f32x4){0.f, 0.f, 0.f, 0.f};
    bf16x8 At[4][2], B0[2][2], B1[2][2];
    const char* cA = (const char*)g.A + (size_t)cur.pm * tstepA; const char* cB = (const char*)g.Bt + (size_t)cur.pn * tstepB;
    PG8_STAGE(PG8_SB(0, 0), cB, voffB); PG8_STAGE(PG8_SB(0, 1), cB + hstepB, voffB); PG8_STAGE(PG8_SA(0, 0), cA, voffA); PG8_STAGE(PG8_SA(0, 1), cA + hstepA, voffA);
    if (wr == 1) PG8_BAR;
    PG8_WAIT_V(2); PG8_BAR;
    PG8_STAGE(PG8_SB(1, 0), cB + kstep, voffB); PG8_STAGE(PG8_SA(1, 0), cA + kstep, voffA); PG8_STAGE(PG8_SB(1, 1), cB + hstepB + kstep, voffB);
    PG8_WAIT_V(6); PG8_BAR;
    for (;;) {
        const bool has_next = S.next(ui + 1, nxt);
        const char* nA = has_next ? (const char*)g.A + (size_t)nxt.pm * tstepA : cA; const char* nB = has_next ? (const char*)g.Bt + (size_t)nxt.pn * tstepB : cB;
        for (int t = 0; t < nt; t += 2) {
            const bool last = (t == nt - 2);
            const char* a1 = cA + (size_t)(t + 1) * kstep;
            const char* a2 = last ? nA : cA + (size_t)(t + 2) * kstep; const char* b2 = last ? nB : cB + (size_t)(t + 2) * kstep;
            const char* a3 = a2 + kstep; const char* b3 = b2 + kstep;
            PG8_LDB(B0, 0, 0); PG8_LDB(B1, 0, 1); PG8_SCHED; PG8_LDA(At, 0, 0); PG8_STAGE(PG8_SA(1, 1), a1 + hstepA, voffA);
            PG8_WAIT_V(8); PG8_WAIT_L(0); PG8_BAR; PG8_MMA(0, 0, At, B0); PG8_MMA(0, 1, At, B1); PG8_BAR; PG8_SCHED;
            PG8_LDA(At, 0, 1); PG8_STAGE(PG8_SB(0, 0), b2, voffB); PG8_STAGE(PG8_SB(0, 1), b2 + hstepB, voffB); PG8_STAGE(PG8_SA(0, 0), a2, voffA);
            PG8_WAIT_V(8); PG8_WAIT_L(0); PG8_BAR; PG8_MMA(1, 0, At, B0); PG8_MMA(1, 1, At, B1); PG8_BAR; PG8_SCHED;
            PG8_LDB(B0, 1, 0); PG8_LDB(B1, 1, 1); PG8_SCHED; PG8_LDA(At, 1, 0); PG8_STAGE(PG8_SA(0, 1), a2 + hstepA, voffA);
            PG8_WAIT_V(8); PG8_WAIT_L(0); PG8_BAR; PG8_MMA(0, 0, At, B0); PG8_MMA(0, 1, At, B1); PG8_BAR; PG8_SCHED;
            PG8_LDA(At, 1, 1); PG8_STAGE(PG8_SB(1, 0), b3, voffB); PG8_STAGE(PG8_SB(1, 1), b3 + hstepB, voffB); PG8_STAGE(PG8_SA(1, 0), a3, voffA);
            PG8_WAIT_V(8); PG8_WAIT_L(0); PG8_BAR; PG8_MMA(1, 0, At, B0); PG8_MMA(1, 1, At, B1); PG8_BAR; PG8_SCHED;
        }
        if (wr == 0) PG8_BAR;
        E(acc, cur, wr, wc, fr, fq);
        if (!has_next) break;
#pragma unroll
        for (int a = 0; a < 2; ++a)
#pragma unroll
            for (int b = 0; b < 2; ++b)
#pragma unroll
                for (int m = 0; m < 4; ++m)
#pragma unroll
                    for (int n = 0; n < 2; ++n) acc[a][b][m][n] = (f32x4){0.f, 0.f, 0.f, 0.f};
        cur = nxt; cA = nA; cB = nB; ++ui;
        if (wr == 1) PG8_BAR;
    }
    PG8_WAIT_V(0);
    PG8_BAR;
#undef PG8_SA
#undef PG8_SB
#undef PG8_STAGE
#undef PG8_LDA
#undef PG8_LDB
#undef PG8_MMA
#undef PG8_WAIT_V
#undef PG8_WAIT_L
#undef PG8_BAR
#undef PG8_SCHED
}
}

__device__ __forceinline__ u32x4 pack8(f32x4 v0, f32x4 v1) { u32x4 w; w.x = cvtpk(v0[0], v0[1]); w.y = cvtpk(v0[2], v0[3]); w.z = cvtpk(v1[0], v1[1]); w.w = cvtpk(v1[2], v1[3]); return w; }
__device__ __forceinline__ void unpack8(u32x4 w, f32x4& a, f32x4& b) { a = (f32x4){bflo(w.x), bfhi(w.x), bflo(w.y), bfhi(w.y)}; b = (f32x4){bflo(w.z), bfhi(w.z), bflo(w.w), bfhi(w.w)}; }
__device__ __forceinline__ f32x4 silu4(f32x4 v) { return (f32x4){siluf_(v[0]), siluf_(v[1]), siluf_(v[2]), siluf_(v[3])}; }
__device__ __forceinline__ f32x4 sig4(f32x4 v) { return (f32x4){sigmoidf_(v[0]), sigmoidf_(v[1]), sigmoidf_(v[2]), sigmoidf_(v[3])}; }
__device__ __forceinline__ f32x4 gelu4(f32x4 v) { return (f32x4){gelu_tanh_(v[0]), gelu_tanh_(v[1]), gelu_tanh_(v[2]), gelu_tanh_(v[3])}; }

struct FInProj {
    unsigned char* ws;
    __device__ __forceinline__ void operator()(const pg8::Unit& u, int row, int col, f32x4 v0, f32x4 v1) const {
        const int pn = u.pn; size_t off; int ld, c; bool act = false;
        if (pn < 4) { off = WS_Q; ld = 1024; c = col; }
        else if (pn == 4) { off = WS_K; ld = 256; c = col - 1024; }
        else if (pn == 5) { off = WS_V; ld = 256; c = col - 1280; }
        else if (pn < 10) { off = WS_GA; ld = 1024; c = col - 1536; act = true; }
        else if (pn < 12) { off = WS_U; ld = 512; c = col - 2560; }
        else if (pn < 14) { off = WS_GS; ld = 512; c = col - 3072; act = true; }
        else if (pn < 16) { off = WS_QX; ld = 512; c = col - 3584; }
        else { off = WS_GX; ld = 512; c = col - 4096; act = true; }
        if (act) { v0 = silu4(v0); v1 = silu4(v1); }
        *(u32x4*)((bf16_t*)(ws + off) + (size_t)row * ld + c) = pack8(v0, v1);
    }
};
struct FStoreBf16 { bf16_t* O; int ldc;
    __device__ __forceinline__ void operator()(const pg8::Unit&, int row, int col, f32x4 v0, f32x4 v1) const { *(u32x4*)(O + (size_t)row * ldc + col) = pack8(v0, v1); } };
struct FStoreEC { float* O;
    __device__ __forceinline__ void operator()(const pg8::Unit& u, int row, int col, f32x4 v0, f32x4 v1) const { float* p = O + (size_t)row * 256 + (col - u.pn * 256); *(f32x4*)p = v0; *(f32x4*)(p + 4) = v1; } };
struct FS5Out { bf16_t* YG;
    __device__ __forceinline__ void operator()(const pg8::Unit& u, int row, int col, f32x4 v0, f32x4 v1) const {
        const int g = u.pn >> 2, chunk = row - g * NCHUNK, cl = col - g * 1024, i = cl >> 4, c0 = cl & 15;
        *(u32x4*)(YG + (size_t)(chunk * CH + i) * 512 + g * 16 + c0) = pack8(gelu4(v0), gelu4(v1));
    } };
struct FGlu { const bf16_t* YG; bf16_t* GS; const float* bias;
    __device__ __forceinline__ void operator()(const pg8::Unit&, int row, int col, f32x4 v0, f32x4 v1) const {
        const size_t o = (size_t)row * 512 + col; f32x4 y0, y1, g0, g1; unpack8(*(const u32x4*)(YG + o), y0, y1); unpack8(*(const u32x4*)(GS + o), g0, g1);
        const f32x4 b0 = *(const f32x4*)(bias + col), b1 = *(const f32x4*)(bias + col + 4);
        *(u32x4*)(GS + o) = pack8(y0 * sig4(v0 + b0) * g0, y1 * sig4(v1 + b1) * g1);
    } };
static_assert(WS_GA == 360 * MiB && WS_PS == 520 * MiB && WS_PX == 840 * MiB, "FMerge offset arithmetic");
struct FMerge { const unsigned char* wsb; float* ACC; bf16_t* MG;
    __device__ __forceinline__ void operator()(const pg8::Unit& u, int row, int col, f32x4 v0, f32x4 v1) const {
        const int br = u.pn >> 2, c = col - br * 1024; const size_t o = (size_t)row * 1024 + c;
        const bf16_t* P = (const bf16_t*)(wsb + (size_t)(360 + 160 * br + 160 * (br >> 1)) * MiB);
        f32x4 p0, p1; unpack8(*(const u32x4*)(P + o), p0, p1);
        f32x4 t0 = sig4(v0) * p0, t1 = sig4(v1) * p1;
        float* a = ACC + o;
        if (br == 0) { *(f32x4*)a = t0; *(f32x4*)(a + 4) = t1; }
        else { t0 += *(const f32x4*)a; t1 += *(const f32x4*)(a + 4);
            if (br == 1) { *(f32x4*)a = t0; *(f32x4*)(a + 4) = t1; } else { *(u32x4*)(MG + o) = pack8(t0, t1); } }
    } };
struct FOut { const float* xp; const float* xs; float* out;
    __device__ __forceinline__ void operator()(const pg8::Unit&, int row, int col, f32x4 v0, f32x4 v1) const {
        const float* x = (row < NPROMPT ? xp + (size_t)row * DM : xs + (size_t)(row - NPROMPT) * DM) + col; float* o = out + (size_t)row * DM + col;
        *(f32x4*)o = *(const f32x4*)x + v0; *(f32x4*)(o + 4) = *(const f32x4*)(x + 4) + v1;
    } };

namespace att {
constexpr int D = 128, NW = 8, QBLK = 32, KVBLK = 64;
constexpr float SCALE = 0.088388347648318440f, THR = 8.f;
constexpr size_t SHM_V = KVBLK * D * 2, SHM_K = KVBLK * D * 2, SHM_ATTN = 2 * SHM_V + 2 * SHM_K + NW * 64 * 4;
#define KSWZ(row, colB) ((row) * 256 + ((colB) ^ (((row) & 7) << 4)))
#define SBAR() __builtin_amdgcn_sched_barrier(0)
__device__ __forceinline__ int crow(int r, int hi) { return (r & 3) + 8 * (r >> 2) + 4 * hi; }
__device__ __forceinline__ void partialSM(f32x16& p0, f32x16& p1, float& m_reg, float& mn, float& alpha) {
    constexpr float C = SCALE * 1.4426950408889634f;
    float pmax = p0[0];
#pragma unroll
    for (int r = 1; r < 16; ++r) pmax = fmaxf(pmax, p0[r]);
#pragma unroll
    for (int r = 0; r < 16; ++r) pmax = fmaxf(pmax, p1[r]);
    { auto rr = __builtin_amdgcn_permlane32_swap(__float_as_uint(pmax), __float_as_uint(pmax), false, false);
      pmax = fmaxf(__uint_as_float(rr[0]), __uint_as_float(rr[1])); }
    if (__builtin_expect(__all(pmax - m_reg <= THR / SCALE), 1)) { mn = m_reg; alpha = 1.f; }
    else { mn = fmaxf(m_reg, pmax); alpha = __builtin_amdgcn_exp2f((m_reg - mn) * C); m_reg = mn; }
    const float mnC = -mn * C;
#pragma unroll
    for (int r = 0; r < 16; ++r) p0[r] = fmaf(p0[r], C, mnC);
#pragma unroll
    for (int r = 0; r < 16; ++r) p1[r] = fmaf(p1[r], C, mnC);
#pragma unroll
    for (int r = 0; r < 16; ++r) p0[r] = __builtin_amdgcn_exp2f(p0[r]);
}
__device__ __forceinline__ void finishSM(f32x16& p0, f32x16& p1, float alpha, float& l_reg, bf16x8& pa0, bf16x8& pa1, bf16x8& pa2, bf16x8& pa3) {
#pragma unroll
    for (int r = 0; r < 16; ++r) p1[r] = __builtin_amdgcn_exp2f(p1[r]);
    float ps = 0;
#pragma unroll
    for (int r = 0; r < 16; ++r) ps += p0[r];
#pragma unroll
    for (int r = 0; r < 16; ++r) ps += p1[r];
    { auto rr = __builtin_amdgcn_permlane32_swap(__float_as_uint(ps), __float_as_uint(ps), false, false);
      ps = __uint_as_float(rr[0]) + __uint_as_float(rr[1]); }
    l_reg = l_reg * alpha + ps;
#define PK4(P, BASE, OUT) do { unsigned a0 = cvtpk(P[BASE + 0], P[BASE + 1]), a1 = cvtpk(P[BASE + 2], P[BASE + 3]);   \
    unsigned b0 = cvtpk(P[BASE + 4], P[BASE + 5]), b1 = cvtpk(P[BASE + 6], P[BASE + 7]);                              \
    auto r0 = __builtin_amdgcn_permlane32_swap(a0, b0, false, false); auto r1 = __builtin_amdgcn_permlane32_swap(a1, b1, false, false); \
    u32x4 w = {r0[0], r1[0], r0[1], r1[1]}; OUT = *reinterpret_cast<bf16x8*>(&w); } while (0)
    PK4(p0, 0, pa0); PK4(p0, 8, pa1); PK4(p1, 0, pa2); PK4(p1, 8, pa3);
#undef PK4
}
__device__ __forceinline__ void qkt(f32x16& p0, f32x16& p1, const bf16_t* Ks, const bf16x8* qr, int r32, int hi) {
    p0 = f32x16{}; p1 = f32x16{};
#pragma unroll
    for (int d0 = 0; d0 < 8; ++d0) { const int cb = (d0 * 16 + hi * 8) * 2;
        bf16x8 b0 = *reinterpret_cast<const bf16x8*>((const char*)Ks + KSWZ(r32, cb));
        bf16x8 b1 = *reinterpret_cast<const bf16x8*>((const char*)Ks + KSWZ(32 + r32, cb));
        p0 = __builtin_amdgcn_mfma_f32_32x32x16_bf16(b0, qr[d0], p0, 0, 0, 0);
        p1 = __builtin_amdgcn_mfma_f32_32x32x16_bf16(b1, qr[d0], p1, 0, 0, 0); }
}
__device__ __forceinline__ int v_st(int k, int c) { const int kk = (k & ~0xC) | ((k & 4) << 1) | ((k & 8) >> 1); return ((kk >> 3) * 4 + (c >> 5)) * 512 + ((kk & 7) * 32 + (c & 31)) * 2; }
__device__ __forceinline__ int v_rd_base(int lane) { return ((lane & 3) << 3) | (((lane >> 2) & 3) << 6) | (((lane >> 4) & 1) << 5) | (((lane >> 5) & 1) << 8); }
constexpr int v_rd_off(int d0, int ks, int half) { return d0 * 512 + ks * 4096 + half * 2048; }
template <int OFF> __device__ __forceinline__ s16x4 tr_read(int vb) {
    s16x4 r; asm volatile("ds_read_b64_tr_b16 %0, %1 offset:%2" : "=&v"(r) : "v"(vb), "i"(OFF) : "memory"); return r;
}
template <int D0> __device__ __forceinline__ void pv_one(f32x16& od, int vb, bf16x8 pa0, bf16x8 pa1, bf16x8 pa2, bf16x8 pa3) {
    const s16x4 l0 = tr_read<v_rd_off(D0, 0, 0)>(vb), h0 = tr_read<v_rd_off(D0, 0, 1)>(vb), l1 = tr_read<v_rd_off(D0, 1, 0)>(vb), h1 = tr_read<v_rd_off(D0, 1, 1)>(vb);
    const s16x4 l2 = tr_read<v_rd_off(D0, 2, 0)>(vb), h2 = tr_read<v_rd_off(D0, 2, 1)>(vb), l3 = tr_read<v_rd_off(D0, 3, 0)>(vb), h3 = tr_read<v_rd_off(D0, 3, 1)>(vb);
    asm volatile("s_waitcnt lgkmcnt(0)" ::: "memory"); SBAR();
#define PK(L, H) (bf16x8){L[0], L[1], L[2], L[3], H[0], H[1], H[2], H[3]}
    od = __builtin_amdgcn_mfma_f32_32x32x16_bf16(pa0, PK(l0, h0), od, 0, 0, 0);
    od = __builtin_amdgcn_mfma_f32_32x32x16_bf16(pa1, PK(l1, h1), od, 0, 0, 0);
    od = __builtin_amdgcn_mfma_f32_32x32x16_bf16(pa2, PK(l2, h2), od, 0, 0, 0);
    od = __builtin_amdgcn_mfma_f32_32x32x16_bf16(pa3, PK(l3, h3), od, 0, 0, 0);
#undef PK
}
__device__ __forceinline__ void pv_d0(f32x16* o, int vb, bf16x8 pa0, bf16x8 pa1, bf16x8 pa2, bf16x8 pa3) {
    pv_one<0>(o[0], vb, pa0, pa1, pa2, pa3); pv_one<1>(o[1], vb, pa0, pa1, pa2, pa3); pv_one<2>(o[2], vb, pa0, pa1, pa2, pa3); pv_one<3>(o[3], vb, pa0, pa1, pa2, pa3);
}

template <bool ROPE, int LDQ, int LDK>
__device__ __forceinline__ void attn_unit(const bf16_t* Qb, const bf16_t* __restrict__ Kh, const bf16_t* __restrict__ Vh, const bf16_t* Gb, bf16_t* Ob,
                                          int seq, char* lds, int t0, const float* __restrict__ qw, const float* __restrict__ cosT, const float* __restrict__ sinT, int wv) {
    const int tid = opaque_tid(wv), wid = __builtin_amdgcn_readfirstlane(tid >> 6), lane = tid & 63, r32 = lane & 31, hi = lane >> 5;
    bf16_t* V_lds = (bf16_t*)lds; bf16_t* K_lds = (bf16_t*)(lds + 2 * SHM_V);
    float* wsl = (float*)(lds + 2 * SHM_V + 2 * SHM_K) + wid * 64; float* li_l = wsl; float* al_l = wsl + 32;
    float m_reg = -1e30f, l_reg = 0; f32x16 o[4] = {}; bf16x8 qr[8];
    const bf16_t* Qw = Qb + (long)(wid * QBLK + r32) * LDQ + hi * 8;
#pragma unroll
    for (int d0 = 0; d0 < 8; ++d0) qr[d0] = *reinterpret_cast<const bf16x8*>(Qw + d0 * 16);
    if constexpr (ROPE) {
        float ss = 0.f;
#pragma unroll
        for (int d0 = 0; d0 < 8; ++d0)
#pragma unroll
            for (int j = 0; j < 8; ++j) { const float x = bf2f((bf16_t)qr[d0][j]); ss += x * x; }
        { auto rr = __builtin_amdgcn_permlane32_swap(__float_as_uint(ss), __float_as_uint(ss), false, false); ss = __uint_as_float(rr[0]) + __uint_as_float(rr[1]); }
        const float rstd = rsqrtf(ss * (1.f / 128.f) + EPS);
        const int t = t0 + wid * QBLK + r32;
#pragma unroll
        for (int d0 = 0; d0 < 8; ++d0) {
            const int pos = (d0 < 4) ? (t >> 6) : (t & 63);
            const f32x4 cs = *(const f32x4*)(cosT + pos * 32 + (d0 & 3) * 8 + hi * 4), sn = *(const f32x4*)(sinT + pos * 32 + (d0 & 3) * 8 + hi * 4);
            const f32x4 w0 = *(const f32x4*)(qw + d0 * 16 + hi * 8), w1 = *(const f32x4*)(qw + d0 * 16 + hi * 8 + 4);
            float x[8];
#pragma unroll
            for (int j = 0; j < 8; ++j) x[j] = bf2f((bf16_t)qr[d0][j]) * rstd * (j < 4 ? w0[j] : w1[j - 4]);
            u32x4 w;
            w.x = cvtpk(x[0] * cs[0] - x[1] * sn[0], x[0] * sn[0] + x[1] * cs[0]);
            w.y = cvtpk(x[2] * cs[1] - x[3] * sn[1], x[2] * sn[1] + x[3] * cs[1]);
            w.z = cvtpk(x[4] * cs[2] - x[5] * sn[2], x[4] * sn[2] + x[5] * cs[2]);
            w.w = cvtpk(x[6] * cs[3] - x[7] * sn[3], x[6] * sn[3] + x[7] * cs[3]);
            qr[d0] = *reinterpret_cast<bf16x8*>(&w);
        }
    }
    const int sr = tid >> 4, sc = (tid & 15) * 8, vst0 = v_st(sr, sc), vst1 = v_st(32 + sr, sc);
    const int vb0 = (int)(uintptr_t)V_lds + v_rd_base(lane);
    struct { bf16x8 vs0, vs1, ks0, ks1; } sr_[2];
#define SLOAD(i, k0) do { sr_[i].vs0 = *(const bf16x8*)(&Vh[(long)((k0) + sr) * LDK + sc]); sr_[i].vs1 = *(const bf16x8*)(&Vh[(long)((k0) + 32 + sr) * LDK + sc]); \
    sr_[i].ks0 = *(const bf16x8*)(&Kh[(long)((k0) + sr) * LDK + sc]); sr_[i].ks1 = *(const bf16x8*)(&Kh[(long)((k0) + 32 + sr) * LDK + sc]); } while (0)
#define SWRITE(b, i) do { *(bf16x8*)((char*)V_lds + (b) * SHM_V + vst0) = sr_[i].vs0;          \
    *(bf16x8*)((char*)V_lds + (b) * SHM_V + vst1) = sr_[i].vs1; int kc = sc * 2;               \
    *(bf16x8*)((char*)K_lds + (b) * SHM_K + KSWZ(sr, kc)) = sr_[i].ks0;                       \
    *(bf16x8*)((char*)K_lds + (b) * SHM_K + KSWZ(32 + sr, kc)) = sr_[i].ks1; } while (0)
#define SWAIT() asm volatile("s_waitcnt vmcnt(4)" ::: "memory")
#define RESC(a) do { if (__any((a) < 1.f)) { if (hi == 0) al_l[r32] = (a); asm volatile("s_waitcnt lgkmcnt(0)" ::: "memory"); \
    _Pragma("unroll") for (int d = 0; d < 4; ++d) _Pragma("unroll") for (int r = 0; r < 16; ++r) o[d][r] *= al_l[crow(r, hi)]; } } while (0)
    f32x16 pA0, pA1, pB0, pB1; float mnA, mnB, alA, alB; bf16x8 pa0, pa1, pa2, pa3; const int NT = seq / KVBLK;
    constexpr int SE = 0, SO = 1;
    SLOAD(SE, 0); asm volatile("s_waitcnt vmcnt(0)" ::: "memory"); SWRITE(0, SE); __syncthreads();
    qkt(pA0, pA1, K_lds, qr, r32, hi); partialSM(pA0, pA1, m_reg, mnA, alA);
    SLOAD(SO, KVBLK); if (2 < NT) SLOAD(SE, 2 * KVBLK);
    SWAIT(); SWRITE(1, SO); __syncthreads();
    for (int j = 1; j + 1 < NT; j += 2) {
        SBAR(); qkt(pB0, pB1, (bf16_t*)((char*)K_lds + SHM_K), qr, r32, hi);
        finishSM(pA0, pA1, alA, l_reg, pa0, pa1, pa2, pa3); SBAR();
        SLOAD(SO, (j + 2) * KVBLK); SBAR();
        pv_d0(o, vb0, pa0, pa1, pa2, pa3); partialSM(pB0, pB1, m_reg, mnB, alB);
        __syncthreads(); SWAIT(); SWRITE(0, SE);
        RESC(alB); __syncthreads();
        SBAR(); qkt(pA0, pA1, K_lds, qr, r32, hi);
        finishSM(pB0, pB1, alB, l_reg, pa0, pa1, pa2, pa3); SBAR();
        if (j + 3 < NT) SLOAD(SE, (j + 3) * KVBLK); SBAR();
        pv_d0(o, vb0 + (int)SHM_V, pa0, pa1, pa2, pa3); partialSM(pA0, pA1, m_reg, mnA, alA);
        __syncthreads(); SWAIT(); SWRITE(1, SO);
        RESC(alA); __syncthreads();
    }
    SBAR(); qkt(pB0, pB1, (bf16_t*)((char*)K_lds + SHM_K), qr, r32, hi);
    finishSM(pA0, pA1, alA, l_reg, pa0, pa1, pa2, pa3); SBAR();
    pv_d0(o, vb0, pa0, pa1, pa2, pa3); partialSM(pB0, pB1, m_reg, mnB, alB);
    __syncthreads(); RESC(alB);
    finishSM(pB0, pB1, alB, l_reg, pa0, pa1, pa2, pa3); SBAR();
    pv_d0(o, vb0 + (int)SHM_V, pa0, pa1, pa2, pa3);
    if (hi == 0) li_l[r32] = l_reg; asm volatile("s_waitcnt lgkmcnt(0)" ::: "memory");
    float rli[16];
#pragma unroll
    for (int r = 0; r < 16; ++r) rli[r] = __builtin_amdgcn_rcpf(li_l[crow(r, hi)]);
    bf16_t* Ow = Ob + (long)(wid * QBLK) * LDQ; const bf16_t* Gw = Gb + (long)(wid * QBLK) * LDQ;
    const unsigned lo = (unsigned)(hi * 4 * LDQ + r32);
#pragma unroll
    for (int r = 0; r < 16; ++r) { const int ur = ((r & 3) + 8 * (r >> 2)) * LDQ;
#pragma unroll
        for (int d0 = 0; d0 < 4; ++d0) { const float gte = bf2f((Gw + ur + d0 * 32)[lo]);
            (Ow + ur + d0 * 32)[lo] = (bf16_t)(cvtpk(o[d0][r] * rli[r] * gte, 0.f) & 0xffffu); }
        if ((r & 1) == 1) asm volatile("" ::: "memory"); }
    __syncthreads();
#undef SLOAD
#undef SWRITE
#undef SWAIT
#undef RESC
}
#undef KSWZ
#undef SBAR
}

struct Params {
    const float* in[25];
    float* out; unsigned char* ws;
};

__device__ __forceinline__ void transpose_item(const float* __restrict__ W, int K, int N, bf16_t* __restrict__ WT, LAS float* scr, int item, int lane) {
    const int nblk = N / 32, kb = item / nblk, nb = item % nblk, k0 = 64 * kb, n0 = 32 * nb;
#pragma unroll 8
    for (int i = 0; i < 32; ++i) { const int kk = 2 * i + (lane >> 5); scr[kk * 33 + (lane & 31)] = W[(size_t)(k0 + kk) * N + n0 + (lane & 31)]; }
    asm volatile("s_waitcnt lgkmcnt(0)" ::: "memory");
    const int c = lane & 7;
#pragma unroll
    for (int j = 0; j < 4; ++j) { const int n = (lane >> 3) + 8 * j; const LAS float* s = scr + (8 * c) * 33 + n;
        u32x4 o; o.x = cvtpk(s[0 * 33], s[1 * 33]); o.y = cvtpk(s[2 * 33], s[3 * 33]); o.z = cvtpk(s[4 * 33], s[5 * 33]); o.w = cvtpk(s[6 * 33], s[7 * 33]);
        *(u32x4*)(WT + (size_t)(n0 + n) * K + k0 + 8 * c) = o; }
    asm volatile("s_waitcnt lgkmcnt(0)" ::: "memory");
}
__device__ __forceinline__ void rms_row_bf16(const float* __restrict__ xrow, const float* __restrict__ g, bf16_t* __restrict__ orow, int lane) {
    const f32x4* xr = (const f32x4*)xrow + lane; f32x4 v[4]; float s = 0.f;
#pragma unroll
    for (int j = 0; j < 4; ++j) { v[j] = xr[64 * j]; s += (v[j].x * v[j].x + v[j].y * v[j].y) + (v[j].z * v[j].z + v[j].w * v[j].w); }
    const float rstd = rsqrtf(wave_sum(s) * (1.f / DM) + EPS);
    u32x2* o8 = (u32x2*)orow + lane;
#pragma unroll
    for (int j = 0; j < 4; ++j) { const f32x4 gw = ((const f32x4*)g)[lane + 64 * j]; u32x2 w; w.x = cvtpk(v[j].x * rstd * gw.x, v[j].y * rstd * gw.y); w.y = cvtpk(v[j].z * rstd * gw.z, v[j].w * rstd * gw.w); o8[64 * j] = w; }
}

#ifndef PHMASK
#define PHMASK 0xFFF
#endif
#define PHON(n) (((PHMASK) >> (n)) & 1)
__global__ void __launch_bounds__(512, 2) hybrid_fwd(Params P) {
    extern __shared__ __attribute__((aligned(16))) unsigned char lds[];
    cg::grid_group grid = cg::this_grid();
    LAS unsigned char* ldsl = (LAS unsigned char*)lds;
    const int G = gridDim.x, bid = blockIdx.x, wv = __builtin_amdgcn_readfirstlane(threadIdx.x >> 6);
    const int vcu = (G % 8 == 0) ? (bid % 8) * (G / 8) + bid / 8 : bid;
    const int NGW = G * 8; const long NGT = (long)G * 512;
#define PHASE_IDS const int tid = opaque_tid(wv), lane = tid & 63, wave = __builtin_amdgcn_readfirstlane(tid >> 6), gw = bid * 8 + wave; const long gtid = (long)bid * 512 + tid; (void)lane; (void)gw; (void)gtid;
    unsigned char* ws = P.ws; unsigned char* dob = (unsigned char*)P.out;
    const float* xp = P.in[0]; const float* xs = P.in[1];
    const float *a_re = P.in[8], *a_im = P.in[9], *b_re = P.in[10], *b_im = P.in[11], *c_re = P.in[12], *c_im = P.in[13], *lstep = P.in[14], *s5d = P.in[15];
    float* cosT = (float*)(ws + WS_COS); float* sinT = (float*)(ws + WS_SIN); float* KT = (float*)(ws + WS_KT);
    bf16_t* WIN = (bf16_t*)(ws + WS_WIN); bf16_t* XN = (bf16_t*)(ws + WS_XN);
    bf16_t* AG = (bf16_t*)(dob + DO_AG); bf16_t* WG = (bf16_t*)(dob + DO_WG); bf16_t* WE = (bf16_t*)(dob + DO_WE); float* EC = (float*)(dob + DO_EC);

    if constexpr (PHON(0))
    {
        PHASE_IDS
        LAS float* scr = (LAS float*)(ldsl + wave * 16384);
        constexpr int I_IN = 16 * 240, I_MKV = 16 * 32, I_PA = 16 * 32, I_PS = 8 * 32, I_PX = 8 * 32, I_OUT = 16 * 32, I_GLU = 8 * 16;
        constexpr int NITEMS = I_IN + I_MKV + I_PA + I_PS + I_PX + I_OUT + I_GLU;
        for (int it = gw; it < NITEMS; it += NGW) {
            int r = it;
            if (r < I_IN) { transpose_item(P.in[5], 1024, 7680, WIN, scr, r, lane); continue; } r -= I_IN;
            if (r < I_MKV) { transpose_item(P.in[19], 1024, 1024, (bf16_t*)(ws + WS_WMKV), scr, r, lane); continue; } r -= I_MKV;
            if (r < I_PA) { transpose_item(P.in[20], 1024, 1024, (bf16_t*)(ws + WS_WPA), scr, r, lane); continue; } r -= I_PA;
            if (r < I_PS) { transpose_item(P.in[21], 512, 1024, (bf16_t*)(ws + WS_WPS), scr, r, lane); continue; } r -= I_PS;
            if (r < I_PX) { transpose_item(P.in[22], 512, 1024, (bf16_t*)(ws + WS_WPX), scr, r, lane); continue; } r -= I_PX;
            if (r < I_OUT) { transpose_item(P.in[23], 1024, 1024, (bf16_t*)(ws + WS_WOUT), scr, r, lane); continue; } r -= I_OUT;
            transpose_item(P.in[16], 512, 512, (bf16_t*)(ws + WS_WGLU), scr, r, lane);
        }
        for (int m = gw; m < NTOK + NMEMROWS; m += NGW) {
            if (m < NTOK) rms_row_bf16(m < NPROMPT ? xp + (size_t)m * DM : xs + (size_t)(m - NPROMPT) * DM, P.in[4], XN + (size_t)m * DM, lane);
            else { const int r = m - NTOK; rms_row_bf16(r < 2048 ? P.in[2] + (size_t)r * DM : P.in[3] + (size_t)(r - 2048) * DM, P.in[18], (bf16_t*)(ws + WS_MN) + (size_t)r * DM, lane); }
        }
        for (long i = gtid; i < 256 * 32; i += NGT) { const int pos = (int)(i >> 5), j = (int)(i & 31);
            const float freq = exp2f(-(float)j * (13.287712379549449f / 32.f)); const float ang = (float)pos * freq; float c, s; cexp_turns(ang * 0.15915494309189535f, c, s); cosT[i] = c; sinT[i] = s; }
        for (long idx = gtid; idx < 65536; idx += NGT) {
            const int chp = (int)(idx & 15), tau = (int)((idx >> 4) & 63), g = (int)((idx >> 10) & 31), dir = (int)(idx >> 15), dg = dir * 32 + g;
            const float dt = __expf(lstep[dg]); float acc[16];
#pragma unroll
            for (int c = 0; c < 16; ++c) acc[c] = 0.f;
            for (int n = 0; n < 64; ++n) {
                const float are = fminf(a_re[dg * 64 + n], -1e-4f), aim = a_im[dg * 64 + n];
                float cr, ci; zoh_coef(are, aim, dt, cr, ci);
                const float br = b_re[(dg * 64 + n) * 16 + chp], bi = b_im[(dg * 64 + n) * 16 + chp];
                const float bbr = cr * br - ci * bi, bbi = cr * bi + ci * br;
                float pr, pi; lam_pow(are, aim, dt, (float)tau, pr, pi);
                const float ppr = pr * bbr - pi * bbi, ppi = pr * bbi + pi * bbr;
#pragma unroll
                for (int c = 0; c < 16; ++c) acc[c] += c_re[(dg * 16 + c) * 64 + n] * ppr - c_im[(dg * 16 + c) * 64 + n] * ppi;
            }
#pragma unroll
            for (int c = 0; c < 16; ++c) KT[((size_t)(dg * 64 + tau) * 16 + c) * 16 + chp] = acc[c];
        }
        for (long idx = gtid; idx < 32 * 256 * 64; idx += NGT) {
            const int j = (int)(idx & 63), col = (int)((idx >> 6) & 255), g = (int)(idx >> 14), dir = col >> 7, part = (col >> 6) & 1, n = col & 63, dg = dir * 32 + g;
            const float dt = __expf(lstep[dg]); const float are = fminf(a_re[dg * 64 + n], -1e-4f), aim = a_im[dg * 64 + n];
            float cr, ci; zoh_coef(are, aim, dt, cr, ci); float pr, pi; lam_pow(are, aim, dt, (float)(dir ? j : 63 - j), pr, pi);
            const float qr_ = pr * cr - pi * ci, qi_ = pr * ci + pi * cr;
            float v[16];
#pragma unroll
            for (int c = 0; c < 16; ++c) { const float br = b_re[(dg * 64 + n) * 16 + c], bi = b_im[(dg * 64 + n) * 16 + c]; v[c] = part ? (qr_ * bi + qi_ * br) : (qr_ * br - qi_ * bi); }
            u32x4 w0, w1; w0.x = cvtpk(v[0], v[1]); w0.y = cvtpk(v[2], v[3]); w0.z = cvtpk(v[4], v[5]); w0.w = cvtpk(v[6], v[7]);
            w1.x = cvtpk(v[8], v[9]); w1.y = cvtpk(v[10], v[11]); w1.z = cvtpk(v[12], v[13]); w1.w = cvtpk(v[14], v[15]);
            bf16_t* d = WE + ((size_t)(g * 256 + col)) * 1024 + j * 16; *(u32x4*)d = w0; *(u32x4*)(d + 8) = w1;
        }
    }
    __syncthreads();
    grid.sync();

    if constexpr (PHON(1))
    {
        pg8::Gemm g{XN, WIN, 1024, 1024, 1024}; pg8::StaticOrder S; S.init(NTOK, 4608, G, bid);
        pg8::Epi8<FInProj> E{FInProj{ws}};
        pg8::gemm_phase(ldsl, g, S, E, wv);
    }
    if constexpr (PHON(1))
    {
        pg8::Gemm g{(const bf16_t*)(ws + WS_MN), (const bf16_t*)(ws + WS_WMKV), 1024, 1024, 1024}; pg8::StaticOrder S; S.init(NMEMROWS, 1024, G, (bid + 128) % G);
        pg8::Epi8<FStoreBf16> E{FStoreBf16{(bf16_t*)(ws + WS_KVM), 1024}};
        pg8::gemm_phase(ldsl, g, S, E, wv);
    }
    __syncthreads();
    grid.sync();

    if constexpr (PHON(2))
    {
        PHASE_IDS
        const bf16_t* U = (const bf16_t*)(ws + WS_U);
        for (int c = bid; c < NCHUNK; c += G) {
            LAS u32x4* st = (LAS u32x4*)ldsl;
#pragma unroll
            for (int it = 0; it < 8; ++it) { const int idx = it * 512 + tid, i = idx >> 6, p = idx & 63;
                st[(p >> 1) * 129 + i * 2 + (p & 1)] = *(const u32x4*)(U + (size_t)(c * CH + i) * 512 + p * 8); }
            __syncthreads();
#pragma unroll
            for (int it = 0; it < 8; ++it) { const int idx = it * 512 + tid, g = idx >> 7, q = idx & 127;
                *(u32x4*)(AG + ((size_t)(g * NCHUNK + c)) * AGK + q * 8) = st[g * 129 + q]; }
            __syncthreads();
        }
        bf16_t* Kb = (bf16_t*)(ws + WS_K); const float* kw = P.in[7];
        for (int rr = gw; rr < NTOK * 2; rr += NGW) {
            const int token = rr >> 1, kvh = rr & 1; unsigned* p = (unsigned*)(Kb + (size_t)token * 256 + kvh * 128) + lane;
            const unsigned w = *p; float x0 = bflo(w), x1 = bfhi(w);
            const float rstd = rsqrtf(wave_sum(x0 * x0 + x1 * x1) * (1.f / 128.f) + EPS);
            x0 *= rstd * kw[2 * lane]; x1 *= rstd * kw[2 * lane + 1];
            const int t = token < NPROMPT ? (token & (SEQ_P - 1)) : (token - NPROMPT); const int pos = lane < 32 ? (t >> 6) : (t & 63);
            const float cs = cosT[pos * 32 + (lane & 31)], sn = sinT[pos * 32 + (lane & 31)];
            *p = cvtpk(x0 * cs - x1 * sn, x0 * sn + x1 * cs);
        }
        for (long idx = gtid; idx < 32L * 1024 * 160; idx += NGT) {
            const int q = (int)(idx % 160), r = (int)((idx / 160) & 1023), g = (int)(idx / 163840), i = r >> 4, ch = r & 15;
            float v[8];
            if (q < 128) {
                const int j = q >> 1, c0 = (q & 1) * 8, tau = i - j;
                if (tau != 0) { const float* src = KT + ((size_t)(((tau > 0 ? 0 : 32) + g) * 64 + (tau > 0 ? tau : -tau)) * 16 + ch) * 16 + c0;
                    const f32x4 a = *(const f32x4*)src, b = *(const f32x4*)(src + 4); v[0] = a[0]; v[1] = a[1]; v[2] = a[2]; v[3] = a[3]; v[4] = b[0]; v[5] = b[1]; v[6] = b[2]; v[7] = b[3]; }
                else { const float* s0 = KT + ((size_t)(g * 64) * 16 + ch) * 16 + c0; const float* s1 = KT + ((size_t)((32 + g) * 64) * 16 + ch) * 16 + c0; const float dsk = s5d[g * 16 + ch];
#pragma unroll
                    for (int e = 0; e < 8; ++e) v[e] = s0[e] + s1[e] + ((c0 + e) == ch ? dsk : 0.f); }
            } else {
                const int kk = (q - 128) * 8, dir = kk >> 7, part = (kk >> 6) & 1, n0 = kk & 63, dg = dir * 32 + g; const float dt = __expf(lstep[dg]); const float pw = (float)(dir ? 64 - i : i + 1);
#pragma unroll
                for (int e = 0; e < 8; ++e) { const int n = n0 + e; const float are = fminf(a_re[dg * 64 + n], -1e-4f), aim = a_im[dg * 64 + n]; float pr, pi; lam_pow(are, aim, dt, pw, pr, pi);
                    const float cr = c_re[(dg * 16 + ch) * 64 + n], ci = c_im[(dg * 16 + ch) * 64 + n]; v[e] = part ? -(cr * pi + ci * pr) : (cr * pr - ci * pi); }
            }
            u32x4 w; w.x = cvtpk(v[0], v[1]); w.y = cvtpk(v[2], v[3]); w.z = cvtpk(v[4], v[5]); w.w = cvtpk(v[6], v[7]);
            *(u32x4*)(WG + ((size_t)(g * 1024 + r)) * AGK + q * 8) = w;
        }
    }
    __syncthreads();
    grid.sync();

    if constexpr (PHON(3))
    {
        pg8::Gemm g{AG, WE, AGK, 1024, 1024}; pg8::GroupedOrder S; S.init(32, 5, 1, G, bid);
        pg8::Epi8<FStoreEC> E{FStoreEC{EC}};
        pg8::gemm_phase(ldsl, g, S, E, wv);
    }
    __syncthreads();
    grid.sync();

    if constexpr (PHON(4)) { PHASE_IDS
    for (long idx = gtid; idx < 9 * 32 * 2 * 64; idx += NGT) {
        const int n = (int)(idx & 63), dir = (int)((idx >> 6) & 1), g = (int)((idx >> 7) & 31), b = (int)(idx >> 12), dg = dir * 32 + g;
        const int c0 = b < 8 ? b * 128 : 1024, c1 = b < 8 ? c0 + 128 : 1280;
        const float dt = __expf(lstep[dg]); const float are = fminf(a_re[dg * 64 + n], -1e-4f), aim = a_im[dg * 64 + n];
        float lr, li; lam_pow(are, aim, dt, 64.f, lr, li);
        float sr = 0.f, si = 0.f;
        const int colE = dir * 128 + n;
        for (int k = 0; k < c1 - c0; ++k) {
            const int c = dir ? (c1 - 1 - k) : (c0 + k);
            bf16_t* ag = AG + ((size_t)(g * NCHUNK + c)) * AGK + 1024 + colE; ag[0] = (bf16_t)(cvtpk(sr, 0.f) & 0xffffu); ag[64] = (bf16_t)(cvtpk(si, 0.f) & 0xffffu);
            const float* e = EC + ((size_t)(g * NCHUNK + c)) * 256 + colE; const float er = e[0], ei = e[64];
            const float nr = lr * sr - li * si + er, ni = lr * si + li * sr + ei; sr = nr; si = ni;
        }
    }
    }
    __syncthreads();
    grid.sync();

    if constexpr (PHON(5))
    {
        pg8::Gemm g{AG, WG, AGK, AGK, AGK}; pg8::GroupedOrder S; S.init(32, 5, 4, G, bid);
        pg8::Epi8<FS5Out> E{FS5Out{(bf16_t*)(ws + WS_U)}};
        pg8::gemm_phase(ldsl, g, S, E, wv);
    }
    __syncthreads();
    grid.sync();

    if constexpr (PHON(6))
    {
        pg8::Gemm g{(const bf16_t*)(ws + WS_U), (const bf16_t*)(ws + WS_WGLU), 512, 512, 512}; pg8::StaticOrder S; S.init(NTOK, 512, G, bid);
        pg8::Epi8<FGlu> E{FGlu{(const bf16_t*)(ws + WS_U), (bf16_t*)(ws + WS_GS), P.in[17]}};
        pg8::gemm_phase(ldsl, g, S, E, wv);
    }

    if constexpr (PHON(7))
    {
        bf16_t* Q = (bf16_t*)(ws + WS_Q); const bf16_t* Kb = (const bf16_t*)(ws + WS_K); const bf16_t* Vb = (const bf16_t*)(ws + WS_V); const bf16_t* GA = (const bf16_t*)(ws + WS_GA);
        { const int per = (512 + G - 1) / G;
          for (int ui = vcu * per; ui < (vcu + 1) * per && ui < 512; ++ui) {
              const int qb = ui & 63, h = ui >> 6, kvh = h >> 2; const size_t tok0 = (size_t)NPROMPT + qb * 256;
              att::attn_unit<true, 1024, 256>(Q + tok0 * 1024 + h * 128, Kb + (size_t)NPROMPT * 256 + kvh * 128, Vb + (size_t)NPROMPT * 256 + kvh * 128, GA + tok0 * 1024 + h * 128,
                                              Q + tok0 * 1024 + h * 128, SEQ_S, (char*)lds, qb * 256, P.in[6], cosT, sinT, wv);
          } }
        { const int per = (2048 + G - 1) / G;
          for (int ui = vcu * per; ui < (vcu + 1) * per && ui < 2048; ++ui) {
              const int qb = ui & 31, hq = (ui >> 5) & 3, kvh = (ui >> 7) & 1, b = ui >> 8, h = kvh * 4 + hq; const size_t tok0 = (size_t)b * SEQ_P + qb * 256, kt0 = (size_t)b * SEQ_P;
              att::attn_unit<true, 1024, 256>(Q + tok0 * 1024 + h * 128, Kb + kt0 * 256 + kvh * 128, Vb + kt0 * 256 + kvh * 128, GA + tok0 * 1024 + h * 128,
                                              Q + tok0 * 1024 + h * 128, SEQ_P, (char*)lds, qb * 256, P.in[6], cosT, sinT, wv);
          } }
        { bf16_t* QX = (bf16_t*)(ws + WS_QX); const bf16_t* GX = (const bf16_t*)(ws + WS_GX); const bf16_t* KVM = (const bf16_t*)(ws + WS_KVM);
          const int per = (1280 + G - 1) / G;
          for (int ui = vcu * per; ui < (vcu + 1) * per && ui < 1280; ++ui) {
              const int h = ui & 3, tb = ui >> 2; const size_t tok0 = (size_t)tb * 256; const int mb = tok0 < (size_t)NPROMPT ? (int)(tok0 / SEQ_P) : 8;
              const bf16_t* km = KVM + (size_t)mb * 256 * 1024 + h * 128;
              att::attn_unit<false, 512, 1024>(QX + tok0 * 512 + h * 128, km, km + 512, GX + tok0 * 512 + h * 128, QX + tok0 * 512 + h * 128, 256, (char*)lds, 0, nullptr, nullptr, nullptr, wv);
          } }
    }
    __syncthreads();
    grid.sync();

    if constexpr (PHON(8))
    {
        pg8::Gemm g{(const bf16_t*)(ws + WS_Q), (const bf16_t*)(ws + WS_WPA), 1024, 1024, 1024}; pg8::StaticOrder S; S.init(NTOK, 1024, G, bid);
        pg8::Epi8<FStoreBf16> E{FStoreBf16{(bf16_t*)(ws + WS_GA), 1024}};
        pg8::gemm_phase(ldsl, g, S, E, wv);
    }
    if constexpr (PHON(8))
    {
        pg8::Gemm g{(const bf16_t*)(ws + WS_GS), (const bf16_t*)(ws + WS_WPS), 512, 512, 512}; pg8::StaticOrder S; S.init(NTOK, 1024, G, bid);
        pg8::Epi8<FStoreBf16> E{FStoreBf16{(bf16_t*)(ws + WS_PS), 1024}};
        pg8::gemm_phase(ldsl, g, S, E, wv);
    }
    if constexpr (PHON(8))
    {
        pg8::Gemm g{(const bf16_t*)(ws + WS_QX), (const bf16_t*)(ws + WS_WPX), 512, 512, 512}; pg8::StaticOrder S; S.init(NTOK, 1024, G, bid);
        pg8::Epi8<FStoreBf16> E{FStoreBf16{(bf16_t*)(ws + WS_PX), 1024}};
        pg8::gemm_phase(ldsl, g, S, E, wv);
    }
    __syncthreads();
    grid.sync();

    if constexpr (PHON(9))
    {
        pg8::Gemm g{XN, WIN + (size_t)4608 * 1024, 1024, 1024, 1024}; pg8::TripleOrder S{G, vcu};
        pg8::Epi8<FMerge> E{FMerge{ws, P.out, (bf16_t*)(ws + WS_GA)}};
        pg8::gemm_phase(ldsl, g, S, E, wv);
    }
    __syncthreads();
    grid.sync();

    if constexpr (PHON(10))
    {
        pg8::Gemm g{(const bf16_t*)(ws + WS_GA), (const bf16_t*)(ws + WS_WOUT), 1024, 1024, 1024}; pg8::StaticOrder S; S.init(NTOK, 1024, G, bid);
        pg8::Epi8<FOut> E{FOut{xp, xs, P.out}};
        pg8::gemm_phase(ldsl, g, S, E, wv);
    }
    __syncthreads();
    grid.sync();

    if constexpr (PHON(11))
    {
        PHASE_IDS
        const float* gf = P.in[24];
        for (int m = gw; m < NTOK; m += NGW) {
            f32x4* xr = (f32x4*)(P.out + (size_t)m * DM) + lane; f32x4 v[4]; float s = 0.f;
#pragma unroll
            for (int j = 0; j < 4; ++j) { v[j] = xr[64 * j]; s += (v[j].x * v[j].x + v[j].y * v[j].y) + (v[j].z * v[j].z + v[j].w * v[j].w); }
            const float rstd = rsqrtf(wave_sum(s) * (1.f / DM) + EPS);
#pragma unroll
            for (int j = 0; j < 4; ++j) { const f32x4 gwt = ((const f32x4*)gf)[lane + 64 * j]; xr[64 * j] = v[j] * rstd * gwt; }
        }
    }
}

extern "C" void kernel_launch(void* const* d_in, const int* in_sizes, int n_in, void* d_out, int out_size, void* d_ws, size_t ws_size, hipStream_t stream) {
    static int grid = 0;
    if (grid == 0) {
        if (n_in != 25 || out_size != NTOK * DM || ws_size < WS_END) { fprintf(stderr, "kernel_launch: unexpected shapes (n_in %d out %d ws %zu)\n", n_in, out_size, ws_size); grid = -1; return; }
        int dev = 0, cus = 0, per_cu = 0;
        hipGetDevice(&dev); hipDeviceGetAttribute(&cus, hipDeviceAttributeMultiprocessorCount, dev);
        if (hipFuncSetAttribute((const void*)hybrid_fwd, hipFuncAttributeMaxDynamicSharedMemorySize, LDS_BYTES) != hipSuccess) { fprintf(stderr, "kernel_launch: hipFuncSetAttribute failed\n"); grid = -1; return; }
        if (hipOccupancyMaxActiveBlocksPerMultiprocessor(&per_cu, (const void*)hybrid_fwd, 512, LDS_BYTES) != hipSuccess || per_cu < 1) { fprintf(stderr, "kernel_launch: occupancy query failed (%d)\n", per_cu); (void)hipGetLastError(); per_cu = 1; }
        grid = cus * per_cu;
    }
    if (grid < 0) return;
    Params p{};
    for (int i = 0; i < 25; ++i) p.in[i] = (const float*)d_in[i];
    p.out = (float*)d_out; p.ws = (unsigned char*)d_ws;
    void* args[] = {&p};
    hipError_t e = hipLaunchCooperativeKernel((const void*)hybrid_fwd, dim3(grid), dim3(512), args, LDS_BYTES, stream);
    if (e != hipSuccess) fprintf(stderr, "kernel_launch: cooperative launch failed: %s (grid %d)\n", hipGetErrorString(e), grid);
}
```

```cpp
#include <hip/hip_runtime.h>
#include <hip/hip_cooperative_groups.h>
#include <cstdio>
#include <cstdint>
namespace cg = cooperative_groups;

#define LAS __attribute__((address_space(3)))
typedef unsigned short bf16_t;
typedef short bf16x8 __attribute__((ext_vector_type(8)));
typedef short s16x4 __attribute__((ext_vector_type(4)));
typedef float f32x4 __attribute__((ext_vector_type(4)));
typedef float f32x16 __attribute__((ext_vector_type(16)));
typedef unsigned u32x4 __attribute__((ext_vector_type(4)));
typedef unsigned u32x2 __attribute__((ext_vector_type(2)));
typedef int i32x4 __attribute__((ext_vector_type(4)));
typedef int i32x16 __attribute__((ext_vector_type(16)));

constexpr int DM = 1024, NTOK = 81920, NPROMPT = 65536, SEQ_P = 8192, SEQ_S = 16384;
constexpr int NMEMROWS = 2304;
constexpr int CH = 64;
constexpr int NCHUNK = NTOK / CH;
constexpr int AGK = 1280;
constexpr float EPS = 1e-6f;

constexpr size_t MiB = 1u << 20;
constexpr size_t WS_RSS = 0, WS_CNT = 512 * 1024;
constexpr size_t WS_COS = 1 * MiB, WS_SIN = 1 * MiB + 65536;
constexpr size_t WS_KT = 2 * MiB;
constexpr size_t WS_WIN = 6 * MiB;
constexpr size_t WS_WMKV = 21 * MiB, WS_WPA = 23 * MiB, WS_WPS = 25 * MiB, WS_WPX = 26 * MiB, WS_WOUT = 27 * MiB, WS_WGLU = 29 * MiB;
constexpr size_t WS_MN = 30 * MiB, WS_KVM = 35 * MiB;
constexpr size_t WS_XN = 40 * MiB;
constexpr size_t WS_Q = 200 * MiB;
constexpr size_t WS_GA = 360 * MiB;
constexpr size_t WS_K = 520 * MiB, WS_V = 560 * MiB, WS_U = 600 * MiB;
constexpr size_t WS_PS = 520 * MiB;
constexpr size_t WS_GS = 680 * MiB;
constexpr size_t WS_QX = 760 * MiB;
constexpr size_t WS_GX = 840 * MiB;
constexpr size_t WS_PX = 840 * MiB;
constexpr size_t WS_K8 = 920 * MiB;
constexpr size_t WS_V8 = 940 * MiB;
constexpr size_t WS_SK = 900 * 1024;
constexpr size_t WS_W8 = 1000 * MiB, WS_WSC = 1006 * MiB, WS_XS = 1007 * MiB;
constexpr size_t WS_END = 1008 * MiB;
constexpr size_t DO_XN8 = 236 * MiB;
constexpr size_t DO_AG = 0, DO_WG = 100 * MiB, DO_WE = 180 * MiB, DO_EC = 196 * MiB;

constexpr int LDS_BYTES = 135168;

__device__ __forceinline__ unsigned cvtpk(float lo, float hi) { unsigned r; asm volatile("v_cvt_pk_bf16_f32 %0, %1, %2" : "=v"(r) : "v"(lo), "v"(hi)); return r; }
__device__ __forceinline__ float bflo(unsigned w) { return __uint_as_float(w << 16); }
__device__ __forceinline__ float bfhi(unsigned w) { return __uint_as_float(w & 0xffff0000u); }
__device__ __forceinline__ float bf2f(bf16_t s) { return __uint_as_float(((unsigned)s) << 16); }
__device__ __forceinline__ float sigmoidf_(float x) { return __builtin_amdgcn_rcpf(1.f + __builtin_amdgcn_exp2f(-1.4426950408889634f * x)); }
__device__ __forceinline__ float siluf_(float x) { return x * sigmoidf_(x); }
__device__ __forceinline__ float gelu_tanh_(float x) { return x * sigmoidf_(1.5957691216057308f * (x + 0.044715f * x * x * x)); }
__device__ __forceinline__ int opaque_tid(int wv) { int l; asm volatile("v_mbcnt_lo_u32_b32 %0, -1, 0\n\tv_mbcnt_hi_u32_b32 %0, -1, %0" : "=v"(l)); return wv * 64 + l; }
__device__ __forceinline__ float wave_sum(float v) {
#pragma unroll
    for (int o = 1; o < 64; o <<= 1) v += __shfl_xor(v, o);
    return v;
}
__device__ __forceinline__ void cexp_turns(float turns, float& c, float& s) { const float f = turns - rintf(turns); c = cospif(2.f * f); s = sinpif(2.f * f); }
__device__ __forceinline__ void lam_pow(float are, float aim, float dt, float p, float& re, float& im) {
    const float mag = __expf(are * dt * p); float c, s; cexp_turns(aim * dt * p * 0.15915494309189535f, c, s); re = mag * c; im = mag * s;
}
__device__ __forceinline__ void zoh_coef(float are, float aim, float dt, float& cr, float& ci) {
    const float x = are * dt, y = aim * dt; const float ex1 = expm1f(x); float cy, sy; cexp_turns(y * 0.15915494309189535f, cy, sy);
    const float re1 = ex1 * cy + (cy - 1.f), im1 = (1.f + ex1) * sy; const float den = 1.f / (are * are + aim * aim);
    cr = (re1 * are + im1 * aim) * den; ci = (im1 * are - re1 * aim) * den;
}

namespace pg8 {
constexpr int BM = 256, BK = 64, HALF = 128, HTB = HALF * BK * 2, STAGE_BYTES = 8 * HTB, NXCD = 8, WGM = 8;
__host__ __device__ __forceinline__ int lds_byte(int r, int c) { const int st = (r >> 4) * 2 + (c >> 5), rr = r & 15, cc = c & 31, ob = rr * 64 + cc * 2; return st * 1024 + (ob ^ (((ob >> 9) & 1) << 5)); }
__host__ __device__ __forceinline__ void stage_rc(int b, int& R, int& C) { const int st = b / 1024, sb = b % 1024, swz = sb ^ (((sb >> 9) & 1) << 5); R = (st >> 1) * 16 + swz / 64; C = (st & 1) * 32 + (swz % 64) / 2; }
__host__ __device__ __forceinline__ int perm32(int rho) { const int n = rho >> 4, i = rho & 15; return 8 * (i >> 2) + 4 * n + (i & 3); }
struct Unit { int pm, pn; };
struct Gemm { const bf16_t* A; const bf16_t* Bt; int lda, ldb, K; };

struct StaticOrder {
    int nM, nN, nwg, G, c;
    __device__ void init(int M, int N, int G_, int c_) { nM = M / BM; nN = N / BM; nwg = nM * nN; G = G_; c = c_; }
    __device__ bool next(int i, Unit& u) const {
        const long L = (long)i * G + c; if (L >= nwg) return false;
        int wgid = (int)L; { const int q = nwg / NXCD, r = nwg % NXCD, xcd = wgid % NXCD, off = wgid / NXCD; wgid = (xcd < r ? xcd * (q + 1) : r * (q + 1) + (xcd - r) * q) + off; }
        const int nig = WGM * nN, gid = wgid / nig, fm = gid * WGM, gsz = (nM - fm) < WGM ? (nM - fm) : WGM;
        u.pm = fm + ((wgid % nig) % gsz); u.pn = (wgid % nig) / gsz; return true;
    }
};
struct GroupedOrder {
    int RT, CT, total, G, c;
    __device__ void init(int ng, int RT_, int CT_, int G_, int c_) { RT = RT_; CT = CT_; total = ng * RT_ * CT_; G = G_; c = c_; }
    __device__ bool next(int i, Unit& u) const {
        const int L = i * G + c; if (L >= total) return false;
        const int per = RT * CT, g = L / per, rem = L % per, a = rem / CT, b = rem % CT; u.pm = g * RT + a; u.pn = g * CT + b; return true;
    }
};
struct PairOrder {
    int G, c;
    __device__ bool next(int i, Unit& u) const { const int tr = (i >> 1) * G + c; if (tr >= 1280) return false; u.pm = tr >> 2; u.pn = (i & 1) * 4 + (tr & 3); return true; }
};
struct SingleOrder {
    int G, c;
    __device__ bool next(int i, Unit& u) const { const int tr = i * G + c; if (tr >= 1280) return false; u.pm = tr >> 2; u.pn = tr & 3; return true; }
};
struct TripleOrder {
    int G, c;
    __device__ bool next(int i, Unit& u) const {
        const int tr = (i / 3) * G + c; if (tr >= 1280) return false;
        const int br = i % 3; u.pm = tr >> 2; u.pn = br * 4 + (tr & 3); return true;
    }
};

template <class F> struct Epi8 {
    static constexpr bool PERM = true;
    F f;
    __device__ __forceinline__ void operator()(const f32x4 (&acc)[2][2][4][2], const Unit& u, int wr, int wc, int fr, int fq) const {
        const int row0 = u.pm * BM + wr * 64 + fr, col0 = u.pn * BM + wc * 32 + 8 * fq;
        if constexpr (F::HAS_LOAD) {
#pragma unroll
            for (int ai = 0; ai < 2; ++ai) {
                typename F::Ld ld[4][2];
#pragma unroll
                for (int m = 0; m < 4; ++m)
#pragma unroll
                    for (int bj = 0; bj < 2; ++bj) ld[m][bj] = f.load(u, row0 + ai * HALF + m * 16, col0 + bj * HALF);
#pragma unroll
                for (int m = 0; m < 4; ++m)
#pragma unroll
                    for (int bj = 0; bj < 2; ++bj) f.apply(u, row0 + ai * HALF + m * 16, col0 + bj * HALF, acc[ai][bj][m][0], acc[ai][bj][m][1], ld[m][bj]);
                asm volatile("" ::: "memory");
            }
        } else {
#pragma unroll
            for (int ai = 0; ai < 2; ++ai)
#pragma unroll
                for (int m = 0; m < 4; ++m) {
#pragma unroll
                    for (int bj = 0; bj < 2; ++bj) f(u, row0 + ai * HALF + m * 16, col0 + bj * HALF, acc[ai][bj][m][0], acc[ai][bj][m][1]);
                    asm volatile("" ::: "memory");
                }
        }
    }
};

template <bool I8> __device__ __forceinline__ f32x4 mma16(bf16x8 b, bf16x8 a, f32x4 c) {
    if constexpr (I8) return __builtin_bit_cast(f32x4, __builtin_amdgcn_mfma_i32_16x16x64_i8(__builtin_bit_cast(i32x4, b), __builtin_bit_cast(i32x4, a), __builtin_bit_cast(i32x4, c), 0, 0, 0));
    else return __builtin_amdgcn_mfma_f32_16x16x32_bf16(b, a, c, 0, 0, 0);
}
template <bool I8 = false, class Epi, class Sched>
__device__ __forceinline__ void gemm_phase(LAS unsigned char* lds, const Gemm g, const Sched& S, const Epi& E, int wv) {
    const int tid = opaque_tid(wv), wid = __builtin_amdgcn_readfirstlane(tid >> 6), lane = tid & 63, wr = wid >> 2, wc = wid & 3, fr = lane & 15, fq = lane >> 4;
    const int K = g.K, nt = K / BK;
    unsigned voffA[2], voffB[2];
#pragma unroll
    for (int i = 0; i < 2; ++i) { int R, C; stage_rc(tid * 16 + i * 8192, R, C); const int Rb = Epi::PERM ? ((R & ~31) + perm32(R & 31)) : R;
        voffA[i] = (unsigned)(R * g.lda + C) * 2u; voffB[i] = (unsigned)(Rb * g.ldb + C) * 2u; }
    const size_t kstep = (size_t)(BK * 2);
    const size_t hstepA = (size_t)HALF * g.lda * 2, hstepB = (size_t)HALF * g.ldb * 2;
    const size_t tstepA = 2 * hstepA, tstepB = 2 * hstepB;
    const unsigned ldsw = (unsigned)wid * 1024u;
    const int aoff = lds_byte(wr * 64 + fr, fq * 8), boff = lds_byte(wc * 32 + fr, fq * 8);
#define PG8_SA(b, h) (((b) * 2 + (h)) * HTB)
#define PG8_SB(b, h) ((4 + (b) * 2 + (h)) * HTB)
#define PG8_STAGE(bufoff, gbase, voff) do { _Pragma("unroll") for (int _i = 0; _i < 2; ++_i) \
        __builtin_amdgcn_global_load_lds((const unsigned*)((const char*)(gbase) + (voff)[_i]), (LAS unsigned*)(lds + (bufoff) + ldsw + _i * 8192), 16, 0, 0); } while (0)
#define PG8_LDA(dst, b, h) do { _Pragma("unroll") for (int m = 0; m < 4; ++m) _Pragma("unroll") for (int k = 0; k < 2; ++k) dst[m][k] = *(const LAS bf16x8*)(lds + PG8_SA(b, h) + aoff + m * 2048 + k * 1024); } while (0)
#define PG8_LDB(dst, b, h) do { _Pragma("unroll") for (int n = 0; n < 2; ++n) _Pragma("unroll") for (int k = 0; k < 2; ++k) dst[n][k] = *(const LAS bf16x8*)(lds + PG8_SB(b, h) + boff + n * 2048 + k * 1024); } while (0)
#define PG8_MMA(ai, bj, At, Bt) do { __builtin_amdgcn_s_setprio(1); _Pragma("unroll") for (int m = 0; m < 4; ++m) _Pragma("unroll") for (int n = 0; n < 2; ++n) _Pragma("unroll") for (int k = 0; k < 2; ++k) \
        acc[ai][bj][m][n] = mma16<I8>(Bt[n][k], At[m][k], acc[ai][bj][m][n]); __builtin_amdgcn_s_setprio(0); } while (0)
#define PG8_WAIT_V(n) asm volatile("s_waitcnt vmcnt(" #n ")" ::: "memory")
#define PG8_WAIT_L(n) asm volatile("s_waitcnt lgkmcnt(" #n ")" ::: "memory")
#define PG8_BAR __builtin_amdgcn_s_barrier()
#define PG8_SCHED __builtin_amdgcn_sched_barrier(0)
    Unit cur, nxt; int ui = 0;
    if (!S.next(0, cur)) return;
    f32x4 acc[2][2][4][2];
#pragma unroll
    for (int a = 0; a < 2; ++a)
#pragma unroll
        for (int b = 0; b < 2; ++b)
#pragma unroll
            for (int m = 0; m < 4; ++m)
#pragma unroll
                for (int n = 0; n < 2; ++n) acc[a][b][m][n] = (f32x4){0.f, 0.f, 0.f, 0.f};
    bf16x8 At[4][2], B0[2][2], B1[2][2];
    const char* cA = (const char*)g.A + (size_t)cur.pm * tstepA; const char* cB = (const char*)g.Bt + (size_t)cur.pn * tstepB;
    PG8_STAGE(PG8_SB(0, 0), cB, voffB); PG8_STAGE(PG8_SB(0, 1), cB + hstepB, voffB); PG8_STAGE(PG8_SA(0, 0), cA, voffA); PG8_STAGE(PG8_SA(0, 1), cA + hstepA, voffA);
    if (wr == 1) PG8_BAR;
    PG8_WAIT_V(2); PG8_BAR;
    PG8_STAGE(PG8_SB(1, 0), cB + kstep, voffB); PG8_STAGE(PG8_SA(1, 0), cA + kstep, voffA); PG8_STAGE(PG8_SB(1, 1), cB + hstepB + kstep, voffB);
    PG8_WAIT_V(6); PG8_BAR;
    for (;;) {
        const bool has_next = S.next(ui + 1, nxt);
        const char* nA = has_next ? (const char*)g.A + (size_t)nxt.pm * tstepA : cA; const char* nB = has_next ? (const char*)g.Bt + (size_t)nxt.pn * tstepB : cB;
        for (int t = 0; t < nt; t += 2) {
            const bool last = (t == nt - 2);
            const char* a1 = cA + (size_t)(t + 1) * kstep;
            const char* a2 = last ? nA : cA + (size_t)(t + 2) * kstep; const char* b2 = last ? nB : cB + (size_t)(t + 2) * kstep;
            const char* a3 = a2 + kstep; const char* b3 = b2 + kstep;
            PG8_LDB(B0, 0, 0); PG8_LDB(B1, 0, 1); PG8_SCHED; PG8_LDA(At, 0, 0); PG8_STAGE(PG8_SA(1, 1), a1 + hstepA, voffA);
            PG8_WAIT_V(8); PG8_WAIT_L(0); PG8_BAR; PG8_MMA(0, 0, At, B0); PG8_MMA(0, 1, At, B1); PG8_BAR; PG8_SCHED;
            PG8_LDA(At, 0, 1); PG8_STAGE(PG8_SB(0, 0), b2, voffB); PG8_STAGE(PG8_SB(0, 1), b2 + hstepB, voffB); PG8_STAGE(PG8_SA(0, 0), a2, voffA);
            PG8_WAIT_V(8); PG8_WAIT_L(0); PG8_BAR; PG8_MMA(1, 0, At, B0); PG8_MMA(1, 1, At, B1); PG8_BAR; PG8_SCHED;
            PG8_LDB(B0, 1, 0); PG8_LDB(B1, 1, 1); PG8_SCHED; PG8_LDA(At, 1, 0); PG8_STAGE(PG8_SA(0, 1), a2 + hstepA, voffA);
            PG8_WAIT_V(8); PG8_WAIT_L(0); PG8_BAR; PG8_MMA(0, 0, At, B0); PG8_MMA(0, 1, At, B1); PG8_BAR; PG8_SCHED;
            PG8_LDA(At, 1, 1); PG8_STAGE(PG8_SB(1, 0), b3, voffB); PG8_STAGE(PG8_SB(1, 1), b3 + hstepB, voffB); PG8_STAGE(PG8_SA(1, 0), a3, voffA);
            PG8_WAIT_V(8); PG8_WAIT_L(0); PG8_BAR; PG8_MMA(1, 0, At, B0); PG8_MMA(1, 1, At, B1); PG8_BAR; PG8_SCHED;
        }
        if (wr == 0) PG8_BAR;
        E(acc, cur, wr, wc, fr, fq);
        if (!has_next) break;
#pragma unroll
        for (int a = 0; a < 2; ++a)
#pragma unroll
            for (int b = 0; b < 2; ++b)
#pragma unroll
                for (int m = 0; m < 4; ++m)
#pragma unroll
                    for (int n = 0; n < 2; ++n) acc[a][b][m][n] = (f32x4){0.f, 0.f, 0.f, 0.f};
        cur = nxt; cA = nA; cB = nB; ++ui;
        if (wr == 1) PG8_BAR;
    }
    PG8_WAIT_V(0);
    PG8_BAR;
#undef PG8_SA
#undef PG8_SB
#undef PG8_STAGE
#undef PG8_LDA
#undef PG8_LDB
#undef PG8_MMA
#undef PG8_WAIT_V
#undef PG8_WAIT_L
#undef PG8_BAR
#undef PG8_SCHED
}
}

__device__ __forceinline__ u32x4 pack8(f32x4 v0, f32x4 v1) { u32x4 w; w.x = cvtpk(v0[0], v0[1]); w.y = cvtpk(v0[2], v0[3]); w.z = cvtpk(v1[0], v1[1]); w.w = cvtpk(v1[2], v1[3]); return w; }
__device__ __forceinline__ void unpack8(u32x4 w, f32x4& a, f32x4& b) { a = (f32x4){bflo(w.x), bfhi(w.x), bflo(w.y), bfhi(w.y)}; b = (f32x4){bflo(w.z), bfhi(w.z), bflo(w.w), bfhi(w.w)}; }
__device__ __forceinline__ f32x4 silu4(f32x4 v) { return (f32x4){siluf_(v[0]), siluf_(v[1]), siluf_(v[2]), siluf_(v[3])}; }
__device__ __forceinline__ f32x4 sig4(f32x4 v) { return (f32x4){sigmoidf_(v[0]), sigmoidf_(v[1]), sigmoidf_(v[2]), sigmoidf_(v[3])}; }
__device__ __forceinline__ f32x4 gelu4(f32x4 v) { return (f32x4){gelu_tanh_(v[0]), gelu_tanh_(v[1]), gelu_tanh_(v[2]), gelu_tanh_(v[3])}; }

struct FInProj { static constexpr bool HAS_LOAD = false;
    unsigned char* ws; bf16_t* AG; int pn0;
    __device__ __forceinline__ void operator()(const pg8::Unit& u, int row, int col, f32x4 v0, f32x4 v1) const {
        const int pn = u.pn + pn0; col += pn0 * 256; size_t off; int ld, c; bool act = false;
        if (pn < 4) { off = WS_Q; ld = 1024; c = col; }
        else if (pn == 4) { off = WS_K; ld = 256; c = col - 1024; }
        else if (pn == 5) { off = WS_V; ld = 256; c = col - 1280; }
        else if (pn < 10) { off = WS_GA; ld = 1024; c = col - 1536; act = true; }
        else if (pn < 12) {
            const int cu = col - 2560, g = cu >> 4;
            *(u32x4*)(AG + ((size_t)(g * NCHUNK + (row >> 6))) * AGK + (row & 63) * 16 + (cu & 15)) = pack8(v0, v1); return; }
        else if (pn < 14) { off = WS_GS; ld = 512; c = col - 3072; act = true; }
        else if (pn < 16) { off = WS_QX; ld = 512; c = col - 3584; }
        else { off = WS_GX; ld = 512; c = col - 4096; act = true; }
        if (act) { v0 = silu4(v0); v1 = silu4(v1); }
        *(u32x4*)((bf16_t*)(ws + off) + (size_t)row * ld + c) = pack8(v0, v1);
    }
};
struct EpiInProjI8 {
    static constexpr bool PERM = true;
    unsigned char* ws; const float* xs; const float* wsc;
    __device__ __forceinline__ void operator()(const f32x4 (&acc)[2][2][4][2], const pg8::Unit& u, int wr, int wc, int fr, int fq) const {
        const int row0 = u.pm * 256 + wr * 64 + fr, col0 = u.pn * 256 + wc * 32 + 8 * fq, pn = u.pn;
        float rs[2][4]; f32x4 cs[2][2];
#pragma unroll
        for (int ai = 0; ai < 2; ++ai)
#pragma unroll
            for (int m = 0; m < 4; ++m) rs[ai][m] = xs[row0 + ai * 128 + m * 16];
#pragma unroll
        for (int bj = 0; bj < 2; ++bj)
#pragma unroll
            for (int n = 0; n < 2; ++n) cs[bj][n] = *(const f32x4*)(wsc + col0 + bj * 128 + 4 * n);
        size_t off; int ld, c0; bool act = false;
        if (pn < 4) { off = WS_Q; ld = 1024; c0 = col0; }
        else if (pn == 4) { off = WS_K; ld = 256; c0 = col0 - 1024; }
        else if (pn == 5) { off = WS_V; ld = 256; c0 = col0 - 1280; }
        else if (pn < 10) { off = WS_GA; ld = 1024; c0 = col0 - 1536; act = true; }
        else if (pn < 12) { off = WS_QX; ld = 512; c0 = col0 - 2560; }
        else { off = WS_GX; ld = 512; c0 = col0 - 3072; act = true; }
        bf16_t* base = (bf16_t*)(ws + off);
#pragma unroll
        for (int ai = 0; ai < 2; ++ai)
#pragma unroll
            for (int m = 0; m < 4; ++m) {
#pragma unroll
                for (int bj = 0; bj < 2; ++bj) {
                    f32x4 v0 = __builtin_convertvector(__builtin_bit_cast(i32x4, acc[ai][bj][m][0]), f32x4) * rs[ai][m] * cs[bj][0];
                    f32x4 v1 = __builtin_convertvector(__builtin_bit_cast(i32x4, acc[ai][bj][m][1]), f32x4) * rs[ai][m] * cs[bj][1];
                    if (act) { v0 = silu4(v0); v1 = silu4(v1); }
                    *(u32x4*)(base + (size_t)(row0 + ai * 128 + m * 16) * ld + c0 + bj * 128) = pack8(v0, v1);
                }
                asm volatile("" ::: "memory");
            }
    }
};
struct EpiMergeI8 {
    static constexpr bool PERM = true;
    const unsigned char* wsb; const float* xs; const float* wsc; bf16_t* MG;
    __device__ __forceinline__ void operator()(f32x4 (&acc)[2][2][4][2], const pg8::Unit& u, int wr, int wc, int fr, int fq) const {
        { int l; asm volatile("v_mbcnt_lo_u32_b32 %0, -1, 0\n\tv_mbcnt_hi_u32_b32 %0, -1, %0" : "=v"(l)); fr = l & 15; fq = l >> 4; }
        const int k = u.pn >> 2, br = 2 * k, rowt = u.pm * 256, ct = (u.pn & 3) * 256;
        const unsigned lrow = (unsigned)(wr * 64 + fr), lcol = (unsigned)(wc * 32 + 8 * fq), loff = lrow * 1024u + lcol;
        const float* xsb = xs + rowt; const float* wb = wsc + u.pn * 256;
        const bf16_t* Pt = (const bf16_t*)(wsb + (size_t)(360 + 240 * br) * MiB) + (size_t)rowt * 1024 + ct;
        bf16_t* Mt = MG + (size_t)rowt * 1024 + ct;
        {
            f32x4 cs[2][2];
#pragma unroll
            for (int bj = 0; bj < 2; ++bj)
#pragma unroll
                for (int n = 0; n < 2; ++n) cs[bj][n] = *(const f32x4*)((wb + bj * 128 + 4 * n) + lcol);
#pragma unroll
            for (int ai = 0; ai < 2; ++ai)
#pragma unroll
                for (int m = 0; m < 4; ++m) { const float rsv = (xsb + ai * 128 + m * 16)[lrow];
#pragma unroll
                    for (int bj = 0; bj < 2; ++bj)
#pragma unroll
                        for (int n = 0; n < 2; ++n) acc[ai][bj][m][n] = sig4(__builtin_convertvector(__builtin_bit_cast(i32x4, acc[ai][bj][m][n]), f32x4) * rsv * cs[bj][n]); }
        }
#pragma unroll
        for (int ai = 0; ai < 2; ++ai) {
            u32x4 pv[4][2], av[4][2];
#pragma unroll
            for (int m = 0; m < 4; ++m)
#pragma unroll
                for (int bj = 0; bj < 2; ++bj) { const size_t o = (size_t)(ai * 128 + m * 16) * 1024 + bj * 128;
                    pv[m][bj] = *(const u32x4*)((Pt + o) + loff); if (br != 0) av[m][bj] = *(const u32x4*)((Mt + o) + loff); else av[m][bj] = (u32x4){0u, 0u, 0u, 0u}; }
#pragma unroll
            for (int m = 0; m < 4; ++m)
#pragma unroll
                for (int bj = 0; bj < 2; ++bj) { const size_t o = (size_t)(ai * 128 + m * 16) * 1024 + bj * 128;
                    f32x4 p0, p1, a0, a1; unpack8(pv[m][bj], p0, p1); unpack8(av[m][bj], a0, a1);
                    *(u32x4*)((Mt + o) + loff) = pack8(a0 + acc[ai][bj][m][0] * p0, a1 + acc[ai][bj][m][1] * p1); }
            asm volatile("" ::: "memory");
        }
    }
};
static_assert(WS_GA == 360 * MiB && WS_PX == 840 * MiB, "EpiMergeI8 offset arithmetic");
struct FStoreBf16 { static constexpr bool HAS_LOAD = false; bf16_t* O; int ldc;
    __device__ __forceinline__ void operator()(const pg8::Unit&, int row, int col, f32x4 v0, f32x4 v1) const { *(u32x4*)(O + (size_t)row * ldc + col) = pack8(v0, v1); } };
struct FStorePSX { static constexpr bool HAS_LOAD = false; unsigned char* ws;
    __device__ __forceinline__ void operator()(const pg8::Unit& u, int row, int col, f32x4 v0, f32x4 v1) const {
        const int g = u.pn >> 2; bf16_t* O = (bf16_t*)(ws + (g ? WS_PX : WS_PS));
        *(u32x4*)(O + (size_t)(row - g * NTOK) * 1024 + (col - g * 1024)) = pack8(v0, v1); } };
struct FStoreEC { static constexpr bool HAS_LOAD = false; float* O;
    __device__ __forceinline__ void operator()(const pg8::Unit& u, int row, int col, f32x4 v0, f32x4 v1) const { float* p = O + (size_t)row * 256 + (col - u.pn * 256); *(f32x4*)p = v0; *(f32x4*)(p + 4) = v1; } };
struct FS5Out { static constexpr bool HAS_LOAD = false; bf16_t* YG;
    __device__ __forceinline__ void operator()(const pg8::Unit& u, int row, int col, f32x4 v0, f32x4 v1) const {
        const int g = u.pn >> 2, chunk = row - g * NCHUNK, cl = col - g * 1024, i = cl >> 4, c0 = cl & 15;
        *(u32x4*)(YG + (size_t)(chunk * CH + i) * 512 + g * 16 + c0) = pack8(gelu4(v0), gelu4(v1));
    } };
struct FGlu { static constexpr bool HAS_LOAD = true; const bf16_t* YG; bf16_t* GS; const float* bias;
    struct Ld { u32x4 y, g; };
    __device__ __forceinline__ Ld load(const pg8::Unit&, int row, int col) const { const size_t o = (size_t)row * 512 + col; Ld l; l.y = *(const u32x4*)(YG + o); l.g = *(const u32x4*)(GS + o); return l; }
    __device__ __forceinline__ void apply(const pg8::Unit&, int row, int col, f32x4 v0, f32x4 v1, const Ld& l) const {
        const size_t o = (size_t)row * 512 + col; f32x4 y0, y1, g0, g1; unpack8(l.y, y0, y1); unpack8(l.g, g0, g1);
        const f32x4 b0 = *(const f32x4*)(bias + col), b1 = *(const f32x4*)(bias + col + 4);
        *(u32x4*)(GS + o) = pack8(y0 * sig4(v0 + b0) * g0, y1 * sig4(v1 + b1) * g1);
    } };
static_assert(WS_GA == 360 * MiB && WS_PS == 520 * MiB && WS_PX == 840 * MiB, "FMerge offset arithmetic");
struct FMerge { static constexpr bool HAS_LOAD = true; const unsigned char* wsb; bf16_t* MG; int brofs;
    struct Ld { u32x4 p, a; };
    __device__ __forceinline__ Ld load(const pg8::Unit& u, int row, int col) const {
        const int br = (u.pn >> 2) + brofs, c = col - (u.pn >> 2) * 1024; const size_t o = (size_t)row * 1024 + c;
        const bf16_t* P = (const bf16_t*)(wsb + (size_t)(360 + 160 * br + 160 * (br >> 1)) * MiB);
        Ld l; l.p = *(const u32x4*)(P + o); if (br != 0) l.a = *(const u32x4*)(MG + o); else l.a = (u32x4){0u, 0u, 0u, 0u}; return l;
    }
    __device__ __forceinline__ void apply(const pg8::Unit& u, int row, int col, f32x4 v0, f32x4 v1, const Ld& l) const {
        const int c = col - (u.pn >> 2) * 1024; const size_t o = (size_t)row * 1024 + c;
        f32x4 p0, p1, a0, a1; unpack8(l.p, p0, p1); unpack8(l.a, a0, a1);
        *(u32x4*)(MG + o) = pack8(a0 + sig4(v0) * p0, a1 + sig4(v1) * p1);
    } };
struct EpiOutNorm {
    static constexpr bool PERM = true;
    const float* xp; const float* xs; float* out; const float* gfin; float* rowss; unsigned* cnt;
    __device__ __forceinline__ void operator()(f32x4 (&acc)[2][2][4][2], const pg8::Unit& u, int wr, int wc, int fr, int fq) const {
        { int l; asm volatile("v_mbcnt_lo_u32_b32 %0, -1, 0\n\tv_mbcnt_hi_u32_b32 %0, -1, %0" : "=v"(l)); fr = l & 15; fq = l >> 4; }
        const int rowt = u.pm * 256, col0 = u.pn * 256 + wc * 32 + 8 * fq;
        const float* xb = rowt < NPROMPT ? xp + (size_t)rowt * DM : xs + (size_t)(rowt - NPROMPT) * DM;
        float* ob = out + (size_t)rowt * DM; float* rs = rowss + rowt;
        const unsigned loff = (unsigned)((wr * 64 + fr) * DM + col0), lrow = (unsigned)(wr * 64 + fr);
#pragma unroll
        for (int am = 0; am < 4; ++am) {
            const int ai = am >> 1, mb = (am & 1) * 2;
            const float* xq = xb;
            if (am == 0) asm volatile("" : "+s"(xq));
            else asm volatile("" : "+s"(xq), "+v"(acc[(am - 1) >> 1][1][((am - 1) & 1) * 2 + 1][1]));
            f32x4 xa[2][2][2];
#pragma unroll
            for (int mm = 0; mm < 2; ++mm)
#pragma unroll
                for (int bj = 0; bj < 2; ++bj) { const float* xt = xq + (size_t)(ai * 128 + (mb + mm) * 16) * DM + bj * 128; xa[mm][bj][0] = *(const f32x4*)(xt + loff); xa[mm][bj][1] = *(const f32x4*)(xt + 4 + loff); }
#pragma unroll
            for (int mm = 0; mm < 2; ++mm)
#pragma unroll
                for (int bj = 0; bj < 2; ++bj) { acc[ai][bj][mb + mm][0] += xa[mm][bj][0]; acc[ai][bj][mb + mm][1] += xa[mm][bj][1]; }
            asm volatile("" ::: "memory");
        }
#pragma unroll
        for (int ai = 0; ai < 2; ++ai)
#pragma unroll
            for (int m = 0; m < 4; ++m) { float sq = 0.f;
#pragma unroll
                for (int bj = 0; bj < 2; ++bj)
#pragma unroll
                    for (int n = 0; n < 2; ++n) { const f32x4 v = acc[ai][bj][m][n]; sq += (v[0] * v[0] + v[1] * v[1]) + (v[2] * v[2] + v[3] * v[3]); }
                { auto rr = __builtin_amdgcn_permlane16_swap(__float_as_uint(sq), __float_as_uint(sq), false, false); sq = __uint_as_float(rr[0]) + __uint_as_float(rr[1]); }
                { auto rr = __builtin_amdgcn_permlane32_swap(__float_as_uint(sq), __float_as_uint(sq), false, false); sq = __uint_as_float(rr[0]) + __uint_as_float(rr[1]); }
                if (fq == 0) atomicAdd((rs + ai * 128 + m * 16) + lrow, sq);
            }
        asm volatile("s_waitcnt vmcnt(0)" ::: "memory");
        __syncthreads();
        if (wr == 0 && wc == 0 && fr == 0 && fq == 0) {
            __builtin_amdgcn_fence(__ATOMIC_RELEASE, "agent");
            __hip_atomic_fetch_add(cnt + u.pm, 1u, __ATOMIC_RELAXED, __HIP_MEMORY_SCOPE_AGENT);
            unsigned spins = 0;
            while (__hip_atomic_load(cnt + u.pm, __ATOMIC_RELAXED, __HIP_MEMORY_SCOPE_AGENT) < 4u && ++spins < (1u << 24)) __builtin_amdgcn_s_sleep(1);
            __builtin_amdgcn_fence(__ATOMIC_ACQUIRE, "agent");
        }
        __syncthreads();
        const float* gp = gfin; asm volatile("" : "+s"(gp));
#pragma unroll
        for (int ai = 0; ai < 2; ++ai)
#pragma unroll
            for (int m = 0; m < 4; ++m) {
                const float rstd = rsqrtf(__hip_atomic_load((rs + ai * 128 + m * 16) + lrow, __ATOMIC_RELAXED, __HIP_MEMORY_SCOPE_AGENT) * (1.f / DM) + EPS);
#pragma unroll
                for (int bj = 0; bj < 2; ++bj) { const f32x4 g0 = *(const f32x4*)(gp + col0 + bj * 128), g1 = *(const f32x4*)(gp + col0 + bj * 128 + 4);
                    float* ot = ob + (size_t)(ai * 128 + m * 16) * DM + bj * 128;
                    *(f32x4*)(ot + loff) = acc[ai][bj][m][0] * rstd * g0; *(f32x4*)(ot + 4 + loff) = acc[ai][bj][m][1] * rstd * g1; }
            }
    }
};

namespace att {
constexpr int D = 128, NW = 8, QBLK = 32, KVBLK = 64;
constexpr float SCALE = 0.088388347648318440f, THR = 8.f;
constexpr size_t SHM_V = KVBLK * D * 2, SHM_K = KVBLK * D * 2, SHM_ATTN = 2 * SHM_V + 2 * SHM_K + NW * 64 * 4;
#define KSWZ(row, colB) ((row) * 256 + ((colB) ^ (((row) & 7) << 4)))
#define SBAR() __builtin_amdgcn_sched_barrier(0)
__device__ __forceinline__ int crow(int r, int hi) { return (r & 3) + 8 * (r >> 2) + 4 * hi; }
__device__ __forceinline__ void partialSM(f32x16& p0, f32x16& p1, float& m_reg, float& mn, float& alpha) {
    constexpr float C = SCALE * 1.4426950408889634f;
    float pmax = p0[0];
#pragma unroll
    for (int r = 1; r < 16; ++r) pmax = fmaxf(pmax, p0[r]);
#pragma unroll
    for (int r = 0; r < 16; ++r) pmax = fmaxf(pmax, p1[r]);
    { auto rr = __builtin_amdgcn_permlane32_swap(__float_as_uint(pmax), __float_as_uint(pmax), false, false);
      pmax = fmaxf(__uint_as_float(rr[0]), __uint_as_float(rr[1])); }
    if (__builtin_expect(__all(pmax - m_reg <= THR / SCALE), 1)) { mn = m_reg; alpha = 1.f; }
    else { mn = fmaxf(m_reg, pmax); alpha = __builtin_amdgcn_exp2f((m_reg - mn) * C); m_reg = mn; }
    const float mnC = -mn * C;
#pragma unroll
    for (int r = 0; r < 16; ++r) p0[r] = fmaf(p0[r], C, mnC);
#pragma unroll
    for (int r = 0; r < 16; ++r) p1[r] = fmaf(p1[r], C, mnC);
#pragma unroll
    for (int r = 0; r < 16; ++r) p0[r] = __builtin_amdgcn_exp2f(p0[r]);
}
__device__ __forceinline__ void finishSM(f32x16& p0, f32x16& p1, float alpha, float& l_reg, bf16x8& pa0, bf16x8& pa1, bf16x8& pa2, bf16x8& pa3) {
#pragma unroll
    for (int r = 0; r < 16; ++r) p1[r] = __builtin_amdgcn_exp2f(p1[r]);
    float ps = 0;
#pragma unroll
    for (int r = 0; r < 16; ++r) ps += p0[r];
#pragma unroll
    for (int r = 0; r < 16; ++r) ps += p1[r];
    { auto rr = __builtin_amdgcn_permlane32_swap(__float_as_uint(ps), __float_as_uint(ps), false, false);
      ps = __uint_as_float(rr[0]) + __uint_as_float(rr[1]); }
    l_reg = l_reg * alpha + ps;
#define PK4(P, BASE, OUT) do { unsigned a0 = cvtpk(P[BASE + 0], P[BASE + 1]), a1 = cvtpk(P[BASE + 2], P[BASE + 3]);   \
    unsigned b0 = cvtpk(P[BASE + 4], P[BASE + 5]), b1 = cvtpk(P[BASE + 6], P[BASE + 7]);                              \
    auto r0 = __builtin_amdgcn_permlane32_swap(a0, b0, false, false); auto r1 = __builtin_amdgcn_permlane32_swap(a1, b1, false, false); \
    u32x4 w = {r0[0], r1[0], r0[1], r1[1]}; OUT = *reinterpret_cast<bf16x8*>(&w); } while (0)
    PK4(p0, 0, pa0); PK4(p0, 8, pa1); PK4(p1, 0, pa2); PK4(p1, 8, pa3);
#undef PK4
}
__device__ __forceinline__ void qkt(f32x16& p0, f32x16& p1, const bf16_t* Ks, const bf16x8* qr, int r32, int hi) {
    p0 = f32x16{}; p1 = f32x16{};
#pragma unroll
    for (int d0 = 0; d0 < 8; ++d0) { const int cb = (d0 * 16 + hi * 8) * 2;
        bf16x8 b0 = *reinterpret_cast<const bf16x8*>((const char*)Ks + KSWZ(r32, cb));
        bf16x8 b1 = *reinterpret_cast<const bf16x8*>((const char*)Ks + KSWZ(32 + r32, cb));
        p0 = __builtin_amdgcn_mfma_f32_32x32x16_bf16(b0, qr[d0], p0, 0, 0, 0);
        p1 = __builtin_amdgcn_mfma_f32_32x32x16_bf16(b1, qr[d0], p1, 0, 0, 0); }
}
__device__ __forceinline__ int v_st(int k, int c) { const int kk = (k & ~0xC) | ((k & 4) << 1) | ((k & 8) >> 1); return ((kk >> 3) * 4 + (c >> 5)) * 512 + ((kk & 7) * 32 + (c & 31)) * 2; }
__device__ __forceinline__ int v_rd_base(int lane) { return ((lane & 3) << 3) | (((lane >> 2) & 3) << 6) | (((lane >> 4) & 1) << 5) | (((lane >> 5) & 1) << 8); }
constexpr int v_rd_off(int d0, int ks, int half) { return d0 * 512 + ks * 4096 + half * 2048; }
template <int OFF> __device__ __forceinline__ s16x4 tr_read(int vb) {
    s16x4 r; asm volatile("ds_read_b64_tr_b16 %0, %1 offset:%2" : "=&v"(r) : "v"(vb), "i"(OFF) : "memory"); return r;
}
template <int D0> __device__ __forceinline__ void pv_one(f32x16& od, int vb, bf16x8 pa0, bf16x8 pa1, bf16x8 pa2, bf16x8 pa3) {
    const s16x4 l0 = tr_read<v_rd_off(D0, 0, 0)>(vb), h0 = tr_read<v_rd_off(D0, 0, 1)>(vb), l1 = tr_read<v_rd_off(D0, 1, 0)>(vb), h1 = tr_read<v_rd_off(D0, 1, 1)>(vb);
    const s16x4 l2 = tr_read<v_rd_off(D0, 2, 0)>(vb), h2 = tr_read<v_rd_off(D0, 2, 1)>(vb), l3 = tr_read<v_rd_off(D0, 3, 0)>(vb), h3 = tr_read<v_rd_off(D0, 3, 1)>(vb);
    asm volatile("s_waitcnt lgkmcnt(0)" ::: "memory"); SBAR();
#define PK(L, H) (bf16x8){L[0], L[1], L[2], L[3], H[0], H[1], H[2], H[3]}
    od = __builtin_amdgcn_mfma_f32_32x32x16_bf16(pa0, PK(l0, h0), od, 0, 0, 0);
    od = __builtin_amdgcn_mfma_f32_32x32x16_bf16(pa1, PK(l1, h1), od, 0, 0, 0);
    od = __builtin_amdgcn_mfma_f32_32x32x16_bf16(pa2, PK(l2, h2), od, 0, 0, 0);
    od = __builtin_amdgcn_mfma_f32_32x32x16_bf16(pa3, PK(l3, h3), od, 0, 0, 0);
#undef PK
}
__device__ __forceinline__ void pv_d0(f32x16* o, int vb, bf16x8 pa0, bf16x8 pa1, bf16x8 pa2, bf16x8 pa3) {
    pv_one<0>(o[0], vb, pa0, pa1, pa2, pa3); pv_one<1>(o[1], vb, pa0, pa1, pa2, pa3); pv_one<2>(o[2], vb, pa0, pa1, pa2, pa3); pv_one<3>(o[3], vb, pa0, pa1, pa2, pa3);
}


__device__ __forceinline__ void qkt_i8(f32x16& p0, f32x16& p1, const unsigned char* Ks, const i32x4* qi, const i32x16& cinit, int r32, int hi) {
    i32x16 a0, a1; const int sw = ((r32 >> 1) & 7) << 4;
#pragma unroll
    for (int m = 0; m < 4; ++m) { const int cb = m * 32 + hi * 16;
        const i32x4 b0 = *reinterpret_cast<const i32x4*>(Ks + r32 * 128 + (cb ^ sw));
        const i32x4 b1 = *reinterpret_cast<const i32x4*>(Ks + (32 + r32) * 128 + (cb ^ sw));
        if (m == 0) { a0 = __builtin_amdgcn_mfma_i32_32x32x32_i8(b0, qi[0], cinit, 0, 0, 0); a1 = __builtin_amdgcn_mfma_i32_32x32x32_i8(b1, qi[0], cinit, 0, 0, 0); }
        else { a0 = __builtin_amdgcn_mfma_i32_32x32x32_i8(b0, qi[m], a0, 0, 0, 0); a1 = __builtin_amdgcn_mfma_i32_32x32x32_i8(b1, qi[m], a1, 0, 0, 0); } }
    p0 = __builtin_bit_cast(f32x16, a0); p1 = __builtin_bit_cast(f32x16, a1);
}
__device__ __forceinline__ void partialSM_i8(f32x16& p0, f32x16& p1, float& m_reg, float& mn, float& alpha, float dq, float Cq, float Kq) {
    constexpr float C = SCALE * 1.4426950408889634f;
    float pmax = p0[0];
#pragma unroll
    for (int r = 1; r < 16; ++r) pmax = fmaxf(pmax, p0[r]);
#pragma unroll
    for (int r = 0; r < 16; ++r) pmax = fmaxf(pmax, p1[r]);
    { auto rr = __builtin_amdgcn_permlane32_swap(__float_as_uint(pmax), __float_as_uint(pmax), false, false);
      pmax = fmaxf(__uint_as_float(rr[0]), __uint_as_float(rr[1])); }
    const float pm = (pmax - 12582912.f) * dq;
    if (__builtin_expect(__all(pm - m_reg <= 4.f / SCALE), 1)) { mn = m_reg; alpha = 1.f; }
    else { mn = fmaxf(m_reg, pm); alpha = __builtin_amdgcn_exp2f((m_reg - mn) * C); m_reg = mn; }
    const float mnC = 3.f - (Kq + mn * C);
#pragma unroll
    for (int r = 0; r < 16; ++r) p0[r] = fmaf(p0[r], Cq, mnC);
#pragma unroll
    for (int r = 0; r < 16; ++r) p1[r] = fmaf(p1[r], Cq, mnC);
#pragma unroll
    for (int r = 0; r < 16; ++r) p0[r] = __builtin_amdgcn_exp2f(p0[r]);
}


typedef int i32x8 __attribute__((ext_vector_type(8)));
__device__ __forceinline__ void finishSM_f8(f32x16& p0, f32x16& p1, float alpha, float& l_reg, i32x8& pa8) {
#pragma unroll
    for (int r = 0; r < 16; ++r) p1[r] = __builtin_amdgcn_exp2f(p1[r]);
    float ps = 0;
#pragma unroll
    for (int r = 0; r < 16; ++r) ps += p0[r];
#pragma unroll
    for (int r = 0; r < 16; ++r) ps += p1[r];
    { auto rr = __builtin_amdgcn_permlane32_swap(__float_as_uint(ps), __float_as_uint(ps), false, false);
      ps = __uint_as_float(rr[0]) + __uint_as_float(rr[1]); }
    l_reg = l_reg * alpha + ps;
#pragma unroll
    for (int d = 0; d < 4; ++d) { int w = __builtin_amdgcn_cvt_pk_fp8_f32(p0[4 * d], p0[4 * d + 1], 0, false); pa8[d] = __builtin_amdgcn_cvt_pk_fp8_f32(p0[4 * d + 2], p0[4 * d + 3], w, true); }
#pragma unroll
    for (int d = 0; d < 4; ++d) { int w = __builtin_amdgcn_cvt_pk_fp8_f32(p1[4 * d], p1[4 * d + 1], 0, false); pa8[4 + d] = __builtin_amdgcn_cvt_pk_fp8_f32(p1[4 * d + 2], p1[4 * d + 3], w, true); }
}
__device__ __forceinline__ void pv8(f32x16* o, const unsigned char* Vs, i32x8 pa8, int r32, int hi) {
#pragma unroll
    for (int cb = 0; cb < 4; ++cb) { const int c = cb * 32 + r32, sw = (c >> 2) & 3;
        const u32x4 b0 = *(const u32x4*)(Vs + c * 64 + (((2 * hi) ^ sw) << 4)), b1 = *(const u32x4*)(Vs + c * 64 + (((2 * hi + 1) ^ sw) << 4));
        const i32x8 b8 = {(int)b0.x, (int)b0.y, (int)b0.z, (int)b0.w, (int)b1.x, (int)b1.y, (int)b1.z, (int)b1.w};
        o[cb] = __builtin_amdgcn_mfma_scale_f32_32x32x64_f8f6f4(pa8, b8, o[cb], 0, 0, 0, 0x7F7F7F7F, 0, 0x7F7F7F7F); }
}

template <int LDQ, int LDK>
__device__ __forceinline__ void attn_unit_i8(const bf16_t* Qb, const unsigned char* __restrict__ K8h, const unsigned char* __restrict__ V8h, const bf16_t* Gb, bf16_t* Ob,
                                          int seq, char* lds, int t0, const float* __restrict__ qw, const float* __restrict__ cosT, const float* __restrict__ sinT, float sk, int wv) {
    const int tid = opaque_tid(wv), wid = __builtin_amdgcn_readfirstlane(tid >> 6), lane = tid & 63, r32 = lane & 31, hi = lane >> 5;
    unsigned char* V_lds = (unsigned char*)lds; unsigned char* K_lds = (unsigned char*)(lds + 16384);
    float* wsl = (float*)(lds + 65536) + wid * 64; float* li_l = wsl; float* al_l = wsl + 32;
    float m_reg = -1e30f, l_reg = 0; f32x16 o[4] = {}; i32x4 qi[4];
    const int kr = tid >> 3, kp = tid & 7, kst = kr * 128 + ((kp ^ ((kr >> 1) & 7)) << 4);
    struct { u32x4 vs, ks; } sr_[2];
#define SLOAD(i, k0) do { sr_[i].vs = *(const u32x4*)(V8h + (size_t)((k0) >> 6) * 16384 + tid * 16); \
    sr_[i].ks = *(const u32x4*)(K8h + (long)((k0) + kr) * 256 + kp * 16); } while (0)
#define SWRITE(b, i) do { *(u32x4*)(V_lds + (b) * 8192 + tid * 16) = sr_[i].vs; *(u32x4*)(K_lds + (b) * 8192 + kst) = sr_[i].ks; } while (0)
#define SWAIT() asm volatile("s_waitcnt vmcnt(2)" ::: "memory")
#define RESC(a) do { if (__any((a) < 1.f)) { if (hi == 0) al_l[r32] = (a); asm volatile("s_waitcnt lgkmcnt(0)" ::: "memory"); \
    _Pragma("unroll") for (int d = 0; d < 4; ++d) _Pragma("unroll") for (int r = 0; r < 16; ++r) o[d][r] *= al_l[crow(r, hi)]; } } while (0)
    f32x16 pA0, pA1, pB0, pB1; float mnA, mnB, alA, alB; i32x8 pa8; const int NT = seq / KVBLK;
    constexpr int SE = 0, SO = 1;
    SLOAD(SE, 0); SLOAD(SO, KVBLK);
    const bf16_t* Qw = Qb + (long)(wid * QBLK + r32) * LDQ + hi * 8;
    float dq, Cq, Kq; i32x16 cinit;
    {
        bf16x8 qraw[8];
#pragma unroll
        for (int d0 = 0; d0 < 8; ++d0) qraw[d0] = *reinterpret_cast<const bf16x8*>(Qw + d0 * 16);
        float ss = 0.f;
#pragma unroll
        for (int d0 = 0; d0 < 8; ++d0)
#pragma unroll
            for (int j = 0; j < 8; ++j) { const float x = bf2f((bf16_t)qraw[d0][j]); ss += x * x; }
        { auto rr = __builtin_amdgcn_permlane32_swap(__float_as_uint(ss), __float_as_uint(ss), false, false); ss = __uint_as_float(rr[0]) + __uint_as_float(rr[1]); }
        const float rstd = rsqrtf(ss * (1.f / 128.f) + EPS);
        const int t = t0 + wid * QBLK + r32;
        float xq[8][8]; float amax = 1e-20f;
#pragma unroll
        for (int d0 = 0; d0 < 8; ++d0) {
            const int pos = (d0 < 4) ? (t >> 6) : (t & 63);
            const f32x4 cs = *(const f32x4*)(cosT + pos * 32 + (d0 & 3) * 8 + hi * 4), sn = *(const f32x4*)(sinT + pos * 32 + (d0 & 3) * 8 + hi * 4);
            const f32x4 w0 = *(const f32x4*)(qw + d0 * 16 + hi * 8), w1 = *(const f32x4*)(qw + d0 * 16 + hi * 8 + 4);
            float x[8];
#pragma unroll
            for (int j = 0; j < 8; ++j) x[j] = bf2f((bf16_t)qraw[d0][j]) * rstd * (j < 4 ? w0[j] : w1[j - 4]);
#pragma unroll
            for (int pr = 0; pr < 4; ++pr) { xq[d0][2 * pr] = x[2 * pr] * cs[pr] - x[2 * pr + 1] * sn[pr]; xq[d0][2 * pr + 1] = x[2 * pr] * sn[pr] + x[2 * pr + 1] * cs[pr]; }
#pragma unroll
            for (int j = 0; j < 8; ++j) amax = fmaxf(amax, fabsf(xq[d0][j]));
        }
        { auto rr = __builtin_amdgcn_permlane32_swap(__float_as_uint(amax), __float_as_uint(amax), false, false); amax = fmaxf(__uint_as_float(rr[0]), __uint_as_float(rr[1])); }
        const float qinv = 127.f / amax;
        dq = amax * (1.f / 127.f) * sk; Cq = dq * (SCALE * 1.4426950408889634f); Kq = 12582912.f * Cq;
#pragma unroll
        for (int m = 0; m < 4; ++m) {
            unsigned w[4];
#pragma unroll
            for (int hf = 0; hf < 2; ++hf)
#pragma unroll
                for (int g4 = 0; g4 < 2; ++g4) { const float* xv = &xq[2 * m + hf][4 * g4];
                    const int a = (int)rintf(xv[0] * qinv), b = (int)rintf(xv[1] * qinv), c = (int)rintf(xv[2] * qinv), d = (int)rintf(xv[3] * qinv);
                    w[hf * 2 + g4] = (unsigned)(a & 255) | ((unsigned)(b & 255) << 8) | ((unsigned)(c & 255) << 16) | ((unsigned)d << 24); }
            qi[m] = (i32x4){(int)w[0], (int)w[1], (int)w[2], (int)w[3]};
        }
#pragma unroll
        for (int r = 0; r < 16; ++r) cinit[r] = 0x4B400000;
        asm volatile("" : "+v"(cinit));
    }
    asm volatile("s_waitcnt vmcnt(0)" ::: "memory"); SWRITE(0, SE); __syncthreads();
    qkt_i8(pA0, pA1, K_lds, qi, cinit, r32, hi); partialSM_i8(pA0, pA1, m_reg, mnA, alA, dq, Cq, Kq);
    SLOAD(SE, 2 * KVBLK);
    SWRITE(1, SO); __syncthreads();
    if (wid >= 4) __builtin_amdgcn_s_setprio(1);
    for (int j = 1; j + 1 < NT; j += 2) {
        SBAR(); qkt_i8(pB0, pB1, K_lds + 8192, qi, cinit, r32, hi);
        finishSM_f8(pA0, pA1, alA, l_reg, pa8); SBAR();
        SLOAD(SO, (j + 2) * KVBLK); SBAR();
        pv8(o, V_lds, pa8, r32, hi); partialSM_i8(pB0, pB1, m_reg, mnB, alB, dq, Cq, Kq);
        __syncthreads(); SWAIT(); SWRITE(0, SE);
        RESC(alB); __syncthreads();
        SBAR(); qkt_i8(pA0, pA1, K_lds, qi, cinit, r32, hi);
        finishSM_f8(pB0, pB1, alB, l_reg, pa8); SBAR();
        SLOAD(SE, (j + 3) * KVBLK); SBAR();
        pv8(o, V_lds + 8192, pa8, r32, hi); partialSM_i8(pA0, pA1, m_reg, mnA, alA, dq, Cq, Kq);
        __syncthreads(); SWAIT(); SWRITE(1, SO);
        RESC(alA); __syncthreads();
    }
    SBAR(); qkt_i8(pB0, pB1, K_lds + 8192, qi, cinit, r32, hi);
    finishSM_f8(pA0, pA1, alA, l_reg, pa8); SBAR();
    pv8(o, V_lds, pa8, r32, hi); partialSM_i8(pB0, pB1, m_reg, mnB, alB, dq, Cq, Kq);
    __syncthreads(); RESC(alB);
    finishSM_f8(pB0, pB1, alB, l_reg, pa8); SBAR();
    pv8(o, V_lds + 8192, pa8, r32, hi);
    __builtin_amdgcn_s_setprio(0);
    int l2; asm volatile("v_mbcnt_lo_u32_b32 %0, -1, 0\n\tv_mbcnt_hi_u32_b32 %0, -1, %0" : "=v"(l2));
    const int hi2 = l2 >> 5, r322 = l2 & 31;
    if (hi2 == 0) li_l[r322] = l_reg; asm volatile("s_waitcnt lgkmcnt(0)" ::: "memory");
    float rli[16];
#pragma unroll
    for (int r = 0; r < 16; ++r) rli[r] = __builtin_amdgcn_rcpf(li_l[crow(r, hi2)]);
    bf16_t* Ow = Ob + (long)(wid * QBLK) * LDQ; const bf16_t* Gw = Gb + (long)(wid * QBLK) * LDQ;
    __syncthreads();
    bf16_t* stg = (bf16_t*)lds + wid * 4096;
#pragma unroll
    for (int r = 0; r < 16; ++r) { const int orow = crow(r, hi2);
#pragma unroll
        for (int d0 = 0; d0 < 4; ++d0) stg[orow * 128 + d0 * 32 + r322] = (bf16_t)(cvtpk(o[d0][r] * rli[r], 0.f) & 0xffffu); }
    asm volatile("s_waitcnt lgkmcnt(0)" ::: "memory");
    const unsigned lo2 = (unsigned)((l2 >> 4) * LDQ + (l2 & 15) * 8);
    u32x4 gv[8], ov[8];
#pragma unroll
    for (int i = 0; i < 8; ++i) gv[i] = *(const u32x4*)((Gw + i * 4 * LDQ) + lo2);
#pragma unroll
    for (int i = 0; i < 8; ++i) ov[i] = *(const u32x4*)(stg + (i * 4 + (l2 >> 4)) * 128 + (l2 & 15) * 8);
#pragma unroll
    for (int i = 0; i < 8; ++i) { u32x4 w;
        w.x = cvtpk(bflo(ov[i].x) * bflo(gv[i].x), bfhi(ov[i].x) * bfhi(gv[i].x)); w.y = cvtpk(bflo(ov[i].y) * bflo(gv[i].y), bfhi(ov[i].y) * bfhi(gv[i].y));
        w.z = cvtpk(bflo(ov[i].z) * bflo(gv[i].z), bfhi(ov[i].z) * bfhi(gv[i].z)); w.w = cvtpk(bflo(ov[i].w) * bflo(gv[i].w), bfhi(ov[i].w) * bfhi(gv[i].w));
        *(u32x4*)((Ow + i * 4 * LDQ) + lo2) = w; }
    __syncthreads();
#undef SLOAD
#undef SWRITE
#undef SWAIT
#undef RESC
}

template <bool ROPE, int LDQ, int LDK>
__device__ __forceinline__ void attn_unit(const bf16_t* Qb, const bf16_t* __restrict__ Kh, const bf16_t* __restrict__ Vh, const bf16_t* Gb, bf16_t* Ob,
                                          int seq, char* lds, int t0, const float* __restrict__ qw, const float* __restrict__ cosT, const float* __restrict__ sinT, int wv) {
    const int tid = opaque_tid(wv), wid = __builtin_amdgcn_readfirstlane(tid >> 6), lane = tid & 63, r32 = lane & 31, hi = lane >> 5;
    bf16_t* V_lds = (bf16_t*)lds; bf16_t* K_lds = (bf16_t*)(lds + 2 * SHM_V);
    float* wsl = (float*)(lds + 2 * SHM_V + 2 * SHM_K) + wid * 64; float* li_l = wsl; float* al_l = wsl + 32;
    float m_reg = -1e30f, l_reg = 0; f32x16 o[4] = {}; bf16x8 qr[8];
    const int sr = tid >> 4, sc = (tid & 15) * 8, vst0 = v_st(sr, sc), vst1 = v_st(32 + sr, sc);
    const int vb0 = (int)(uintptr_t)V_lds + v_rd_base(lane);
    struct { bf16x8 vs0, vs1, ks0, ks1; } sr_[2];
#define SLOAD(i, k0) do { sr_[i].vs0 = *(const bf16x8*)(&Vh[(long)((k0) + sr) * LDK + sc]); sr_[i].vs1 = *(const bf16x8*)(&Vh[(long)((k0) + 32 + sr) * LDK + sc]); \
    sr_[i].ks0 = *(const bf16x8*)(&Kh[(long)((k0) + sr) * LDK + sc]); sr_[i].ks1 = *(const bf16x8*)(&Kh[(long)((k0) + 32 + sr) * LDK + sc]); } while (0)
#define SWRITE(b, i) do { *(bf16x8*)((char*)V_lds + (b) * SHM_V + vst0) = sr_[i].vs0;          \
    *(bf16x8*)((char*)V_lds + (b) * SHM_V + vst1) = sr_[i].vs1; int kc = sc * 2;               \
    *(bf16x8*)((char*)K_lds + (b) * SHM_K + KSWZ(sr, kc)) = sr_[i].ks0;                       \
    *(bf16x8*)((char*)K_lds + (b) * SHM_K + KSWZ(32 + sr, kc)) = sr_[i].ks1; } while (0)
#define SWAIT() asm volatile("s_waitcnt vmcnt(4)" ::: "memory")
#define RESC(a) do { if (__any((a) < 1.f)) { if (hi == 0) al_l[r32] = (a); asm volatile("s_waitcnt lgkmcnt(0)" ::: "memory"); \
    _Pragma("unroll") for (int d = 0; d < 4; ++d) _Pragma("unroll") for (int r = 0; r < 16; ++r) o[d][r] *= al_l[crow(r, hi)]; } } while (0)
    f32x16 pA0, pA1, pB0, pB1; float mnA, mnB, alA, alB; bf16x8 pa0, pa1, pa2, pa3; const int NT = seq / KVBLK;
    constexpr int SE = 0, SO = 1;
    SLOAD(SE, 0); SLOAD(SO, KVBLK);
    const bf16_t* Qw = Qb + (long)(wid * QBLK + r32) * LDQ + hi * 8;
#pragma unroll
    for (int d0 = 0; d0 < 8; ++d0) qr[d0] = *reinterpret_cast<const bf16x8*>(Qw + d0 * 16);
    if constexpr (ROPE) {
        float ss = 0.f;
#pragma unroll
        for (int d0 = 0; d0 < 8; ++d0)
#pragma unroll
            for (int j = 0; j < 8; ++j) { const float x = bf2f((bf16_t)qr[d0][j]); ss += x * x; }
        { auto rr = __builtin_amdgcn_permlane32_swap(__float_as_uint(ss), __float_as_uint(ss), false, false); ss = __uint_as_float(rr[0]) + __uint_as_float(rr[1]); }
        const float rstd = rsqrtf(ss * (1.f / 128.f) + EPS);
        const int t = t0 + wid * QBLK + r32;
#pragma unroll
        for (int d0 = 0; d0 < 8; ++d0) {
            const int pos = (d0 < 4) ? (t >> 6) : (t & 63);
            const f32x4 cs = *(const f32x4*)(cosT + pos * 32 + (d0 & 3) * 8 + hi * 4), sn = *(const f32x4*)(sinT + pos * 32 + (d0 & 3) * 8 + hi * 4);
            const f32x4 w0 = *(const f32x4*)(qw + d0 * 16 + hi * 8), w1 = *(const f32x4*)(qw + d0 * 16 + hi * 8 + 4);
            float x[8];
#pragma unroll
            for (int j = 0; j < 8; ++j) x[j] = bf2f((bf16_t)qr[d0][j]) * rstd * (j < 4 ? w0[j] : w1[j - 4]);
            u32x4 w;
            w.x = cvtpk(x[0] * cs[0] - x[1] * sn[0], x[0] * sn[0] + x[1] * cs[0]);
            w.y = cvtpk(x[2] * cs[1] - x[3] * sn[1], x[2] * sn[1] + x[3] * cs[1]);
            w.z = cvtpk(x[4] * cs[2] - x[5] * sn[2], x[4] * sn[2] + x[5] * cs[2]);
            w.w = cvtpk(x[6] * cs[3] - x[7] * sn[3], x[6] * sn[3] + x[7] * cs[3]);
            qr[d0] = *reinterpret_cast<bf16x8*>(&w);
        }
    }
    asm volatile("s_waitcnt vmcnt(0)" ::: "memory"); SWRITE(0, SE); __syncthreads();
    qkt(pA0, pA1, K_lds, qr, r32, hi); partialSM(pA0, pA1, m_reg, mnA, alA);
    SLOAD(SE, 2 * KVBLK);
    SWRITE(1, SO); __syncthreads();
    if (wid >= 4) __builtin_amdgcn_s_setprio(1);
    for (int j = 1; j + 1 < NT; j += 2) {
        SBAR(); qkt(pB0, pB1, (bf16_t*)((char*)K_lds + SHM_K), qr, r32, hi);
        finishSM(pA0, pA1, alA, l_reg, pa0, pa1, pa2, pa3); SBAR();
        SLOAD(SO, (j + 2) * KVBLK); SBAR();
        pv_d0(o, vb0, pa0, pa1, pa2, pa3); partialSM(pB0, pB1, m_reg, mnB, alB);
        __syncthreads(); SWAIT(); SWRITE(0, SE);
        RESC(alB); __syncthreads();
        SBAR(); qkt(pA0, pA1, K_lds, qr, r32, hi);
        finishSM(pB0, pB1, alB, l_reg, pa0, pa1, pa2, pa3); SBAR();
        SLOAD(SE, (j + 3) * KVBLK); SBAR();
        pv_d0(o, vb0 + (int)SHM_V, pa0, pa1, pa2, pa3); partialSM(pA0, pA1, m_reg, mnA, alA);
        __syncthreads(); SWAIT(); SWRITE(1, SO);
        RESC(alA); __syncthreads();
    }
    SBAR(); qkt(pB0, pB1, (bf16_t*)((char*)K_lds + SHM_K), qr, r32, hi);
    finishSM(pA0, pA1, alA, l_reg, pa0, pa1, pa2, pa3); SBAR();
    pv_d0(o, vb0, pa0, pa1, pa2, pa3); partialSM(pB0, pB1, m_reg, mnB, alB);
    __syncthreads(); RESC(alB);
    finishSM(pB0, pB1, alB, l_reg, pa0, pa1, pa2, pa3); SBAR();
    pv_d0(o, vb0 + (int)SHM_V, pa0, pa1, pa2, pa3);
    __builtin_amdgcn_s_setprio(0);
    int l2; asm volatile("v_mbcnt_lo_u32_b32 %0, -1, 0\n\tv_mbcnt_hi_u32_b32 %0, -1, %0" : "=v"(l2));
    const int hi2 = l2 >> 5, r322 = l2 & 31;
    if (hi2 == 0) li_l[r322] = l_reg; asm volatile("s_waitcnt lgkmcnt(0)" ::: "memory");
    float rli[16];
#pragma unroll
    for (int r = 0; r < 16; ++r) rli[r] = __builtin_amdgcn_rcpf(li_l[crow(r, hi2)]);
    bf16_t* Ow = Ob + (long)(wid * QBLK) * LDQ; const bf16_t* Gw = Gb + (long)(wid * QBLK) * LDQ;
    __syncthreads();
    bf16_t* stg = (bf16_t*)lds + wid * 4096;
#pragma unroll
    for (int r = 0; r < 16; ++r) { const int orow = crow(r, hi2);
#pragma unroll
        for (int d0 = 0; d0 < 4; ++d0) stg[orow * 128 + d0 * 32 + r322] = (bf16_t)(cvtpk(o[d0][r] * rli[r], 0.f) & 0xffffu); }
    asm volatile("s_waitcnt lgkmcnt(0)" ::: "memory");
    const unsigned lo2 = (unsigned)((l2 >> 4) * LDQ + (l2 & 15) * 8);
    u32x4 gv[8], ov[8];
#pragma unroll
    for (int i = 0; i < 8; ++i) gv[i] = *(const u32x4*)((Gw + i * 4 * LDQ) + lo2);
#pragma unroll
    for (int i = 0; i < 8; ++i) ov[i] = *(const u32x4*)(stg + (i * 4 + (l2 >> 4)) * 128 + (l2 & 15) * 8);
#pragma unroll
    for (int i = 0; i < 8; ++i) { u32x4 w;
        w.x = cvtpk(bflo(ov[i].x) * bflo(gv[i].x), bfhi(ov[i].x) * bfhi(gv[i].x)); w.y = cvtpk(bflo(ov[i].y) * bflo(gv[i].y), bfhi(ov[i].y) * bfhi(gv[i].y));
        w.z = cvtpk(bflo(ov[i].z) * bflo(gv[i].z), bfhi(ov[i].z) * bfhi(gv[i].z)); w.w = cvtpk(bflo(ov[i].w) * bflo(gv[i].w), bfhi(ov[i].w) * bfhi(gv[i].w));
        *(u32x4*)((Ow + i * 4 * LDQ) + lo2) = w; }
    __syncthreads();
#undef SLOAD
#undef SWRITE
#undef SWAIT
#undef RESC
}
#undef KSWZ
#undef SBAR
}

struct Params {
    const float* in[25];
    float* out; unsigned char* ws;
};

__device__ __forceinline__ void transpose_item(const float* __restrict__ W, int K, int N, bf16_t* __restrict__ WT, LAS float* scr, int item, int lane) {
    const int nblk = N / 32, kb = item / nblk, nb = item % nblk, k0 = 64 * kb, n0 = 32 * nb;
#pragma unroll 8
    for (int i = 0; i < 32; ++i) { const int kk = 2 * i + (lane >> 5); scr[kk * 33 + (lane & 31)] = W[(size_t)(k0 + kk) * N + n0 + (lane & 31)]; }
    asm volatile("s_waitcnt lgkmcnt(0)" ::: "memory");
    const int c = lane & 7;
#pragma unroll
    for (int j = 0; j < 4; ++j) { const int n = (lane >> 3) + 8 * j; const LAS float* s = scr + (8 * c) * 33 + n;
        u32x4 o; o.x = cvtpk(s[0 * 33], s[1 * 33]); o.y = cvtpk(s[2 * 33], s[3 * 33]); o.z = cvtpk(s[4 * 33], s[5 * 33]); o.w = cvtpk(s[6 * 33], s[7 * 33]);
        *(u32x4*)(WT + (size_t)(n0 + n) * K + k0 + 8 * c) = o; }
    asm volatile("s_waitcnt lgkmcnt(0)" ::: "memory");
}
__device__ __forceinline__ void rms_row_bf16(const float* __restrict__ xrow, const float* __restrict__ g, bf16_t* __restrict__ orow, int lane) {
    const f32x4* xr = (const f32x4*)xrow + lane; f32x4 v[4]; float s = 0.f;
#pragma unroll
    for (int j = 0; j < 4; ++j) { v[j] = xr[64 * j]; s += (v[j].x * v[j].x + v[j].y * v[j].y) + (v[j].z * v[j].z + v[j].w * v[j].w); }
    const float rstd = rsqrtf(wave_sum(s) * (1.f / DM) + EPS);
    u32x2* o8 = (u32x2*)orow + lane;
#pragma unroll
    for (int j = 0; j < 4; ++j) { const f32x4 gw = ((const f32x4*)g)[lane + 64 * j]; u32x2 w; w.x = cvtpk(v[j].x * rstd * gw.x, v[j].y * rstd * gw.y); w.y = cvtpk(v[j].z * rstd * gw.z, v[j].w * rstd * gw.w); o8[64 * j] = w; }
}

#ifndef PHMASK
#define PHMASK 0xFFF
#endif
#define PHON(n) (((PHMASK) >> (n)) & 1)
__global__ void __launch_bounds__(512, 2) hybrid_fwd(Params P) {
    extern __shared__ __attribute__((aligned(16))) unsigned char lds[];
    cg::grid_group grid = cg::this_grid();
    LAS unsigned char* ldsl = (LAS unsigned char*)lds;
    const int G = gridDim.x, bid = blockIdx.x, wv = __builtin_amdgcn_readfirstlane(threadIdx.x >> 6);
    const int vcu = (G % 8 == 0) ? (bid % 8) * (G / 8) + bid / 8 : bid;
    const int NGW = G * 8; const long NGT = (long)G * 512;
#ifndef PROBE
#define PROBE 0
#endif
#define PROBE_A0 10
#define PROBE_A1 11
#define PROBE_B0 8
#define PROBE_B1 9
#define STAMP(k) do { if (PROBE) { if (bid == 0 && opaque_tid(wv) == 0) ((unsigned long long*)(ws + 768 * 1024))[k] = __builtin_amdgcn_s_memrealtime(); } } while (0)
#define PHASE_IDS const int tid = opaque_tid(wv), lane = tid & 63, wave = __builtin_amdgcn_readfirstlane(tid >> 6), gw = bid * 8 + wave; const long gtid = (long)bid * 512 + tid; (void)lane; (void)gw; (void)gtid;
    unsigned char* ws = P.ws; unsigned char* dob = (unsigned char*)P.out;
    const float* xp = P.in[0]; const float* xs = P.in[1];
    const float *a_re = P.in[8], *a_im = P.in[9], *b_re = P.in[10], *b_im = P.in[11], *c_re = P.in[12], *c_im = P.in[13], *lstep = P.in[14], *s5d = P.in[15];
    float* cosT = (float*)(ws + WS_COS); float* sinT = (float*)(ws + WS_SIN); float* KT = (float*)(ws + WS_KT);
    bf16_t* WIN = (bf16_t*)(ws + WS_WIN); bf16_t* XN = (bf16_t*)(ws + WS_XN);
#define XN8 (dob + DO_XN8)
#define XS ((float*)(ws + WS_XS))
#define W8 (ws + WS_W8)
#define WSC ((float*)(ws + WS_WSC))
    bf16_t* AG = (bf16_t*)(dob + DO_AG); bf16_t* WG = (bf16_t*)(dob + DO_WG); bf16_t* WE = (bf16_t*)(dob + DO_WE); float* EC = (float*)(dob + DO_EC);

    STAMP(0);
    if constexpr (PHON(0))
    {
        PHASE_IDS
        LAS float* scr = (LAS float*)(ldsl + wave * 16384);
        constexpr int I_IN = 16 * 240, I_MKV = 16 * 32, I_PA = 16 * 32, I_PS = 8 * 32, I_PX = 8 * 32, I_OUT = 16 * 32, I_GLU = 8 * 16;
        constexpr int NITEMS = I_IN + I_MKV + I_PA + I_PS + I_PX + I_OUT + I_GLU;
        for (int it = gw; it < NITEMS; it += NGW) {
            int r = it;
            if (r < I_IN) { transpose_item(P.in[5], 1024, 7680, WIN, scr, r, lane); continue; } r -= I_IN;
            if (r < I_MKV) { transpose_item(P.in[19], 1024, 1024, (bf16_t*)(ws + WS_WMKV), scr, r, lane); continue; } r -= I_MKV;
            if (r < I_PA) { transpose_item(P.in[20], 1024, 1024, (bf16_t*)(ws + WS_WPA), scr, r, lane); continue; } r -= I_PA;
            if (r < I_PS) { transpose_item(P.in[21], 512, 1024, (bf16_t*)(ws + WS_WPS), scr, r, lane); continue; } r -= I_PS;
            if (r < I_PX) { transpose_item(P.in[22], 512, 1024, (bf16_t*)(ws + WS_WPX), scr, r, lane); continue; } r -= I_PX;
            if (r < I_OUT) { transpose_item(P.in[23], 1024, 1024, (bf16_t*)(ws + WS_WOUT), scr, r, lane); continue; } r -= I_OUT;
            transpose_item(P.in[16], 512, 512, (bf16_t*)(ws + WS_WGLU), scr, r, lane);
        }
        for (int m = gw; m < NTOK; m += 2 * NGW) {
            const int m2 = m + NGW; const bool has2 = m2 < NTOK;
            const f32x4* xa = (const f32x4*)(m < NPROMPT ? xp + (size_t)m * DM : xs + (size_t)(m - NPROMPT) * DM) + lane;
            const f32x4* xb2 = (const f32x4*)(!has2 ? xp : (m2 < NPROMPT ? xp + (size_t)m2 * DM : xs + (size_t)(m2 - NPROMPT) * DM)) + lane;
            f32x4 va[4], vb[4]; float sa = 0.f, sb = 0.f;
#pragma unroll
            for (int j = 0; j < 4; ++j) { va[j] = xa[64 * j]; vb[j] = xb2[64 * j]; }
#pragma unroll
            for (int j = 0; j < 4; ++j) { sa += (va[j].x * va[j].x + va[j].y * va[j].y) + (va[j].z * va[j].z + va[j].w * va[j].w); sb += (vb[j].x * vb[j].x + vb[j].y * vb[j].y) + (vb[j].z * vb[j].z + vb[j].w * vb[j].w); }
#pragma unroll
            for (int o = 1; o < 64; o <<= 1) { sa += __shfl_xor(sa, o); sb += __shfl_xor(sb, o); }
            const float ra = rsqrtf(sa * (1.f / DM) + EPS), rb = rsqrtf(sb * (1.f / DM) + EPS);
            u32x2* oa = (u32x2*)(XN + (size_t)m * DM) + lane; u32x2* ob2 = (u32x2*)(XN + (size_t)(has2 ? m2 : m) * DM) + lane;
            float ma = 1e-20f, mb = 1e-20f;
#pragma unroll
            for (int j = 0; j < 4; ++j) { const f32x4 gwt = ((const f32x4*)P.in[4])[lane + 64 * j];
                va[j] = va[j] * ra * gwt; vb[j] = vb[j] * rb * gwt;
                u32x2 w; w.x = cvtpk(va[j].x, va[j].y); w.y = cvtpk(va[j].z, va[j].w); oa[64 * j] = w;
                if (has2) { u32x2 w2; w2.x = cvtpk(vb[j].x, vb[j].y); w2.y = cvtpk(vb[j].z, vb[j].w); ob2[64 * j] = w2; }
                ma = fmaxf(fmaxf(ma, fmaxf(fabsf(va[j].x), fabsf(va[j].y))), fmaxf(fabsf(va[j].z), fabsf(va[j].w)));
                mb = fmaxf(fmaxf(mb, fmaxf(fabsf(vb[j].x), fabsf(vb[j].y))), fmaxf(fabsf(vb[j].z), fabsf(vb[j].w))); }
#pragma unroll
            for (int o = 1; o < 64; o <<= 1) { ma = fmaxf(ma, __shfl_xor(ma, o)); mb = fmaxf(mb, __shfl_xor(mb, o)); }
            const float ia = 127.f / ma, ib = 127.f / mb;
            unsigned* q8a = (unsigned*)(XN8 + (size_t)m * DM) + lane; unsigned* q8b = (unsigned*)(XN8 + (size_t)(has2 ? m2 : m) * DM) + lane;
#pragma unroll
            for (int j = 0; j < 4; ++j) {
                q8a[64 * j] = (unsigned)((int)rintf(va[j].x * ia) & 255) | ((unsigned)((int)rintf(va[j].y * ia) & 255) << 8) | ((unsigned)((int)rintf(va[j].z * ia) & 255) << 16) | ((unsigned)(int)rintf(va[j].w * ia) << 24);
                if (has2) q8b[64 * j] = (unsigned)((int)rintf(vb[j].x * ib) & 255) | ((unsigned)((int)rintf(vb[j].y * ib) & 255) << 8) | ((unsigned)((int)rintf(vb[j].z * ib) & 255) << 16) | ((unsigned)(int)rintf(vb[j].w * ib) << 24); }
            if (lane == 0) { XS[m] = ma * (1.f / 127.f); if (has2) XS[m2] = mb * (1.f / 127.f); }
        }
        for (int r = gw; r < NMEMROWS; r += NGW) rms_row_bf16(r < 2048 ? P.in[2] + (size_t)r * DM : P.in[3] + (size_t)(r - 2048) * DM, P.in[18], (bf16_t*)(ws + WS_MN) + (size_t)r * DM, lane);
        for (long i = gtid; i < 256 * 32; i += NGT) { const int pos = (int)(i >> 5), j = (int)(i & 31);
            const float freq = exp2f(-(float)j * (13.287712379549449f / 32.f)); const float ang = (float)pos * freq; float c, s; cexp_turns(ang * 0.15915494309189535f, c, s); cosT[i] = c; sinT[i] = s; }
        for (long i = gtid; i < NTOK; i += NGT) ((float*)(ws + WS_RSS))[i] = 0.f;
        if (gtid < 320) ((unsigned*)(ws + WS_CNT))[gtid] = 0u;
        {
            LAS float* bp = (LAS float*)(ldsl + wave * 16384);
            for (int wi = wave * G + bid; wi < 4096; wi += NGW) {
                const int dg = wi >> 6, tau = wi & 63, n = lane;
                const float dt = __expf(lstep[dg]); const float are = fminf(a_re[dg * 64 + n], -1e-4f), aim = a_im[dg * 64 + n];
                float cr, ci; zoh_coef(are, aim, dt, cr, ci); float pr, pi; lam_pow(are, aim, dt, (float)tau, pr, pi);
                const float qr_ = pr * cr - pi * ci, qi_ = pr * ci + pi * cr;
                const float* brp = b_re + (size_t)(dg * 64 + n) * 16; const float* bip = b_im + (size_t)(dg * 64 + n) * 16;
#pragma unroll
                for (int c4 = 0; c4 < 4; ++c4) { const f32x4 br = *(const f32x4*)(brp + 4 * c4), bi = *(const f32x4*)(bip + 4 * c4);
                    *(LAS f32x4*)(bp + n * 36 + 4 * c4) = qr_ * br - qi_ * bi; *(LAS f32x4*)(bp + n * 36 + 16 + 4 * c4) = qr_ * bi + qi_ * br; }
                asm volatile("s_waitcnt lgkmcnt(0)" ::: "memory");
                const int ch = lane >> 2, cq = (lane & 3) * 4;
                const float* crp = c_re + (size_t)(dg * 16 + ch) * 64; const float* cip = c_im + (size_t)(dg * 16 + ch) * 64;
                f32x4 acc = {0.f, 0.f, 0.f, 0.f};
#pragma unroll 4
                for (int n4 = 0; n4 < 16; ++n4) { const f32x4 c_r = *(const f32x4*)(crp + 4 * n4), c_i = *(const f32x4*)(cip + 4 * n4);
#pragma unroll
                    for (int e = 0; e < 4; ++e) { const int nn = 4 * n4 + e; const f32x4 bre = *(const LAS f32x4*)(bp + nn * 36 + cq), bim = *(const LAS f32x4*)(bp + nn * 36 + 16 + cq);
                        acc += c_r[e] * bre - c_i[e] * bim; } }
                *(f32x4*)(KT + ((size_t)(dg * 64 + tau) * 16 + ch) * 16 + cq) = acc;
                asm volatile("s_waitcnt lgkmcnt(0)" ::: "memory");
            }
        }
        for (long idx = gtid; idx < 32 * 256 * 64; idx += NGT) {
            const int j = (int)(idx & 63), col = (int)((idx >> 6) & 255), g = (int)(idx >> 14), dir = col >> 7, part = (col >> 6) & 1, n = col & 63, dg = dir * 32 + g;
            const float dt = __expf(lstep[dg]); const float are = fminf(a_re[dg * 64 + n], -1e-4f), aim = a_im[dg * 64 + n];
            float cr, ci; zoh_coef(are, aim, dt, cr, ci); float pr, pi; lam_pow(are, aim, dt, (float)(dir ? j : 63 - j), pr, pi);
            const float qr_ = pr * cr - pi * ci, qi_ = pr * ci + pi * cr;
            float v[16];
#pragma unroll
            for (int c = 0; c < 16; ++c) { const float br = b_re[(dg * 64 + n) * 16 + c], bi = b_im[(dg * 64 + n) * 16 + c]; v[c] = part ? (qr_ * bi + qi_ * br) : (qr_ * br - qi_ * bi); }
            u32x4 w0, w1; w0.x = cvtpk(v[0], v[1]); w0.y = cvtpk(v[2], v[3]); w0.z = cvtpk(v[4], v[5]); w0.w = cvtpk(v[6], v[7]);
            w1.x = cvtpk(v[8], v[9]); w1.y = cvtpk(v[10], v[11]); w1.z = cvtpk(v[12], v[13]); w1.w = cvtpk(v[14], v[15]);
            bf16_t* d = WE + ((size_t)(g * 256 + col)) * 1024 + j * 16; *(u32x4*)d = w0; *(u32x4*)(d + 8) = w1;
        }
    }
    __syncthreads();
    grid.sync();
    STAMP(1);

    if constexpr (PHON(1))
    {
        PHASE_IDS
        for (int r = gw; r < 5632; r += NGW) {
            const int rsrc = r < 2560 ? r : (r < 4608 ? r + 1024 : r + 2048);
            const u32x4* src = (const u32x4*)(WIN + (size_t)rsrc * 1024) + 2 * lane; const u32x4 a = src[0], b = src[1];
            float v[16]; v[0] = bflo(a.x); v[1] = bfhi(a.x); v[2] = bflo(a.y); v[3] = bfhi(a.y); v[4] = bflo(a.z); v[5] = bfhi(a.z); v[6] = bflo(a.w); v[7] = bfhi(a.w);
            v[8] = bflo(b.x); v[9] = bfhi(b.x); v[10] = bflo(b.y); v[11] = bfhi(b.y); v[12] = bflo(b.z); v[13] = bfhi(b.z); v[14] = bflo(b.w); v[15] = bfhi(b.w);
            float mx = 1e-30f;
#pragma unroll
            for (int j = 0; j < 16; ++j) mx = fmaxf(mx, fabsf(v[j]));
#pragma unroll
            for (int o = 1; o < 64; o <<= 1) mx = fmaxf(mx, __shfl_xor(mx, o));
            const float inv = 127.f / mx; unsigned w[4];
#pragma unroll
            for (int q = 0; q < 4; ++q) w[q] = (unsigned)((int)rintf(v[4 * q] * inv) & 255) | ((unsigned)((int)rintf(v[4 * q + 1] * inv) & 255) << 8) | ((unsigned)((int)rintf(v[4 * q + 2] * inv) & 255) << 16) | ((unsigned)(int)rintf(v[4 * q + 3] * inv) << 24);
            *((u32x4*)(W8 + (size_t)r * 1024) + lane) = (u32x4){w[0], w[1], w[2], w[3]};
            if (lane == 0) WSC[r] = mx * (1.f / 127.f);
        }
    }
    __syncthreads();
    grid.sync();
    {
        pg8::Gemm g{(const bf16_t*)XN8, (const bf16_t*)W8, 512, 512, 512}; pg8::StaticOrder S; S.init(NTOK, 3584, G, bid);
        EpiInProjI8 E{ws, XS, WSC};
        pg8::gemm_phase<true>(ldsl, g, S, E, wv);
    }
    {
        pg8::Gemm g{XN, WIN + (size_t)2560 * 1024, 1024, 1024, 1024}; pg8::StaticOrder S; S.init(NTOK, 1024, G, bid);
        pg8::Epi8<FInProj> E{FInProj{ws, AG, 10}};
        pg8::gemm_phase(ldsl, g, S, E, wv);
    }
    if constexpr (PHON(1))
    {
        pg8::Gemm g{(const bf16_t*)(ws + WS_MN), (const bf16_t*)(ws + WS_WMKV), 1024, 1024, 1024}; pg8::StaticOrder S; S.init(NMEMROWS, 1024, G, (bid + 128) % G);
        pg8::Epi8<FStoreBf16> E{FStoreBf16{(bf16_t*)(ws + WS_KVM), 1024}};
        pg8::gemm_phase(ldsl, g, S, E, wv);
    }
    __syncthreads();
    grid.sync();
    STAMP(2);

    if constexpr (PHON(3))
    {
        pg8::Gemm g{AG, WE, AGK, 1024, 1024}; pg8::GroupedOrder S; S.init(32, 5, 1, G, bid);
        pg8::Epi8<FStoreEC> E{FStoreEC{EC}};
        pg8::gemm_phase(ldsl, g, S, E, wv);
    }
    __syncthreads();
    grid.sync();
    STAMP(4);

    if constexpr (PHON(4)) { PHASE_IDS
    for (long idx = ((long)wave * G + bid) * 64 + lane; idx < 9 * 32 * 2 * 64; idx += NGT) {
        const int n = (int)(idx & 63), dir = (int)((idx >> 6) & 1), g = (int)((idx >> 7) & 31), b = (int)(idx >> 12), dg = dir * 32 + g;
        const int c0 = b < 8 ? b * 128 : 1024, c1 = b < 8 ? c0 + 128 : 1280;
        const float dt = __expf(lstep[dg]); const float are = fminf(a_re[dg * 64 + n], -1e-4f), aim = a_im[dg * 64 + n];
        float lr, li; lam_pow(are, aim, dt, 64.f, lr, li);
        float sr = 0.f, si = 0.f;
        const int colE = dir * 128 + n;
        const int cstart = dir ? c1 - 1 : c0, cstep = dir ? -1 : 1;
        const float* e0 = EC + ((size_t)(g * NCHUNK + cstart)) * 256 + colE; bf16_t* a0 = AG + ((size_t)(g * NCHUNK + cstart)) * AGK + 1024 + colE;
        const long estep = (long)cstep * 256, astep = (long)cstep * AGK;
        for (int k = 0; k < c1 - c0; k += 16) {
            float er[16], ei[16];
#pragma unroll
            for (int j = 0; j < 16; ++j) { er[j] = e0[(k + j) * estep]; ei[j] = e0[(k + j) * estep + 64]; }
#pragma unroll
            for (int j = 0; j < 16; ++j) {
                bf16_t* ag = a0 + (k + j) * astep; ag[0] = (bf16_t)(cvtpk(sr, 0.f) & 0xffffu); ag[64] = (bf16_t)(cvtpk(si, 0.f) & 0xffffu);
                const float nr = lr * sr - li * si + er[j], ni = lr * si + li * sr + ei[j]; sr = nr; si = ni;
            }
        }
    }
    {
        bf16_t* Kb = (bf16_t*)(ws + WS_K); const float* kw = P.in[7]; unsigned char* K8 = ws + WS_K8;
        float wm = fmaxf(fabsf(kw[lane]), fabsf(kw[lane + 64]));
#pragma unroll
        for (int o = 1; o < 64; o <<= 1) wm = fmaxf(wm, __shfl_xor(wm, o));
        const float kmax = 11.3137085f * wm * 1.0001f + 1e-20f, ski = 127.f / kmax;
        if (lane == 0) *(float*)(ws + WS_SK) = kmax * (1.f / 127.f);
        const int kself = wave * G + bid; const bool split = NGW > 1152; const int nfree = split ? NGW - 576 : NGW, kfree = split ? kself - 576 : kself;
        if (kfree >= 0)
        for (int r8a = kfree; r8a < NTOK * 2 / 8; r8a += 2 * nfree) {
            u32x4 wv0[2], wv1[2]; u32x4* pp[2]; unsigned char* kd8[2]; bool okk[2]; f32x4 tc0[2], tc1[2], ts0[2], ts1[2];
            const int sub = lane & 7;
#pragma unroll
            for (int u = 0; u < 2; ++u) {
                const int r8 = r8a + u * nfree; okk[u] = r8 < NTOK * 2 / 8; const int rr = (okk[u] ? r8 : r8a) * 8 + (lane >> 3), token = rr >> 1, kvh = rr & 1;
                pp[u] = (u32x4*)(Kb + (size_t)token * 256 + kvh * 128 + sub * 16); wv0[u] = pp[u][0]; wv1[u] = pp[u][1];
                kd8[u] = K8 + (size_t)token * 256 + kvh * 128 + 32 * (sub >> 1) + 8 * (sub & 1);
                const int t = token < NPROMPT ? (token & (SEQ_P - 1)) : (token - NPROMPT); const int pos = sub < 4 ? (t >> 6) : (t & 63);
                const float* ct = cosT + pos * 32 + (sub & 3) * 8; const float* st = sinT + pos * 32 + (sub & 3) * 8;
                tc0[u] = *(const f32x4*)ct; tc1[u] = *(const f32x4*)(ct + 4); ts0[u] = *(const f32x4*)st; ts1[u] = *(const f32x4*)(st + 4);
            }
#pragma unroll
            for (int u = 0; u < 2; ++u) {
                const u32x4 w0 = wv0[u], w1 = wv1[u];
                float x[16]; x[0] = bflo(w0.x); x[1] = bfhi(w0.x); x[2] = bflo(w0.y); x[3] = bfhi(w0.y); x[4] = bflo(w0.z); x[5] = bfhi(w0.z); x[6] = bflo(w0.w); x[7] = bfhi(w0.w);
                x[8] = bflo(w1.x); x[9] = bfhi(w1.x); x[10] = bflo(w1.y); x[11] = bfhi(w1.y); x[12] = bflo(w1.z); x[13] = bfhi(w1.z); x[14] = bflo(w1.w); x[15] = bfhi(w1.w);
                float ss = 0.f;
#pragma unroll
                for (int j = 0; j < 16; ++j) ss += x[j] * x[j];
                ss += __shfl_xor(ss, 1); ss += __shfl_xor(ss, 2); ss += __shfl_xor(ss, 4);
                const float rstd = rsqrtf(ss * (1.f / 128.f) + EPS);
                unsigned ob[4] = {0u, 0u, 0u, 0u};
#pragma unroll
                for (int j = 0; j < 8; ++j) { const float a = x[2 * j] * rstd * kw[sub * 16 + 2 * j], b = x[2 * j + 1] * rstd * kw[sub * 16 + 2 * j + 1];
                    const float cs = j < 4 ? tc0[u][j & 3] : tc1[u][j & 3], sn = j < 4 ? ts0[u][j & 3] : ts1[u][j & 3];
                    const int q0 = (int)fminf(fmaxf(rintf((a * cs - b * sn) * ski), -127.f), 127.f), q1 = (int)fminf(fmaxf(rintf((a * sn + b * cs) * ski), -127.f), 127.f);
                    ob[j >> 1] |= ((unsigned)(q0 & 255) | ((unsigned)(q1 & 255) << 8)) << (16 * (j & 1)); }
                if (okk[u]) { *(u32x2*)kd8[u] = (u32x2){ob[0], ob[1]}; *(u32x2*)(kd8[u] + 16) = (u32x2){ob[2], ob[3]}; }
            }
        }
        if (kfree >= 0)
        for (int it = kfree; it < (NTOK / 64) * 2; it += nfree) {
            const bf16_t* vsrc = (const bf16_t*)(ws + WS_V) + (size_t)(it >> 1) * 64 * 256 + (it & 1) * 128 + 2 * lane;
            unsigned vraw[64];
#pragma unroll
            for (int k = 0; k < 64; ++k) vraw[k] = *(const unsigned*)(vsrc + (size_t)k * 256);
            unsigned char* dstb = ws + WS_V8 + (size_t)it * 8192;
#pragma unroll
            for (int sgl = 0; sgl < 2; ++sgl) {
                const int c = 2 * lane + sgl, sw = (c >> 2) & 3;
#pragma unroll
                for (int p = 0; p < 4; ++p) {
                    unsigned w[4];
#pragma unroll
                    for (int d = 0; d < 4; ++d) { float f[4];
#pragma unroll
                        for (int e = 0; e < 4; ++e) { const int b = 16 * p + 4 * d + e, h = b >> 5, j = b & 31;
                            const int key = (j < 16) ? ((j & 3) + 8 * (j >> 2) + 4 * h) : (32 + ((j - 16) & 3) + 8 * ((j - 16) >> 2) + 4 * h);
                            f[e] = sgl ? bfhi(vraw[key]) : bflo(vraw[key]); }
                        int ww = __builtin_amdgcn_cvt_pk_fp8_f32(f[0], f[1], 0, false); ww = __builtin_amdgcn_cvt_pk_fp8_f32(f[2], f[3], ww, true); w[d] = (unsigned)ww; }
                    *(u32x4*)(dstb + c * 64 + ((p ^ sw) << 4)) = (u32x4){w[0], w[1], w[2], w[3]};
                }
            }
        }
        if (kfree >= 0)
        for (long idx0 = (long)kfree * 64 + lane; idx0 < 32L * 1024 * 128; idx0 += 4L * nfree * 64) {
            f32x4 fa[4][2], fb[4][2]; int tauv[4], chv[4], c0v[4]; float dskv[4]; size_t dst[4]; bool ok[4];
#pragma unroll
            for (int u = 0; u < 4; ++u) {
                const long id = idx0 + (long)u * nfree * 64; ok[u] = id < 32L * 1024 * 128; const int idc = (int)(ok[u] ? id : idx0);
                const int q = idc & 127, r = (idc >> 7) & 1023, g = idc >> 17, i = r >> 4, ch = r & 15, j = q >> 1, c0 = (q & 1) * 8, tau = i - j;
                const float* pa = KT + ((size_t)(g * 64 + (tau > 0 ? tau : 0)) * 16 + ch) * 16 + c0;
                const float* pb = KT + ((size_t)((32 + g) * 64 + (tau < 0 ? -tau : 0)) * 16 + ch) * 16 + c0;
                fa[u][0] = *(const f32x4*)pa; fa[u][1] = *(const f32x4*)(pa + 4); fb[u][0] = *(const f32x4*)pb; fb[u][1] = *(const f32x4*)(pb + 4);
                tauv[u] = tau; chv[u] = ch; c0v[u] = c0; dskv[u] = s5d[g * 16 + ch]; dst[u] = ((size_t)(g * 1024 + r)) * AGK + q * 8;
            }
#pragma unroll
            for (int u = 0; u < 4; ++u) {
                const float wa = tauv[u] >= 0 ? 1.f : 0.f, wb = tauv[u] <= 0 ? 1.f : 0.f; float v[8];
#pragma unroll
                for (int e = 0; e < 8; ++e) v[e] = wa * fa[u][e >> 2][e & 3] + wb * fb[u][e >> 2][e & 3] + ((tauv[u] == 0 && (c0v[u] + e) == chv[u]) ? dskv[u] : 0.f);
                u32x4 w; w.x = cvtpk(v[0], v[1]); w.y = cvtpk(v[2], v[3]); w.z = cvtpk(v[4], v[5]); w.w = cvtpk(v[6], v[7]);
                if (ok[u]) *(u32x4*)(WG + dst[u]) = w;
            }
        }
        if (kfree >= 0)
        for (long idx = (long)kfree * 64 + lane; idx < 32L * 2 * 8 * 16; idx += (long)nfree * 64) {
            const int ch = (int)(idx & 15), oct = (int)((idx >> 4) & 7), dir = (int)((idx >> 7) & 1), g = (int)(idx >> 8), dg = dir * 32 + g, n0 = oct * 8;
            const float dt = __expf(lstep[dg]);
            float lr[8], li[8], pr[8], pi[8], cr[8], ci[8];
#pragma unroll
            for (int e = 0; e < 8; ++e) { const int n = n0 + e; const float are = fminf(a_re[dg * 64 + n], -1e-4f), aim = a_im[dg * 64 + n]; lam_pow(are, aim, dt, 1.f, lr[e], li[e]); pr[e] = lr[e]; pi[e] = li[e];
                cr[e] = c_re[(dg * 16 + ch) * 64 + n]; ci[e] = c_im[(dg * 16 + ch) * 64 + n]; }
            for (int pw = 1; pw <= 64; ++pw) {
                const int i = dir ? 64 - pw : pw - 1; float vr[8], vi[8];
#pragma unroll
                for (int e = 0; e < 8; ++e) { vr[e] = cr[e] * pr[e] - ci[e] * pi[e]; vi[e] = -(cr[e] * pi[e] + ci[e] * pr[e]);
                    const float nr = pr[e] * lr[e] - pi[e] * li[e], ni = pr[e] * li[e] + pi[e] * lr[e]; pr[e] = nr; pi[e] = ni; }
                bf16_t* d = WG + ((size_t)(g * 1024 + i * 16 + ch)) * AGK + 1024 + dir * 128 + n0;
                u32x4 w; w.x = cvtpk(vr[0], vr[1]); w.y = cvtpk(vr[2], vr[3]); w.z = cvtpk(vr[4], vr[5]); w.w = cvtpk(vr[6], vr[7]); *(u32x4*)d = w;
                w.x = cvtpk(vi[0], vi[1]); w.y = cvtpk(vi[2], vi[3]); w.z = cvtpk(vi[4], vi[5]); w.w = cvtpk(vi[6], vi[7]); *(u32x4*)(d + 64) = w;
            }
        }
    }
    }
    __syncthreads();
    grid.sync();
    STAMP(5);

    if constexpr (PHON(5))
    {
        pg8::Gemm g{AG, WG, AGK, AGK, AGK}; pg8::GroupedOrder S; S.init(32, 5, 4, G, bid);
        pg8::Epi8<FS5Out> E{FS5Out{(bf16_t*)(ws + WS_U)}};
        pg8::gemm_phase(ldsl, g, S, E, wv);
    }
    __syncthreads();
    grid.sync();
    STAMP(6);

    if constexpr (PHON(6))
    {
        pg8::Gemm g{(const bf16_t*)(ws + WS_U), (const bf16_t*)(ws + WS_WGLU), 512, 512, 512}; pg8::StaticOrder S; S.init(NTOK, 512, G, bid);
        pg8::Epi8<FGlu> E{FGlu{(const bf16_t*)(ws + WS_U), (bf16_t*)(ws + WS_GS), P.in[17]}};
        pg8::gemm_phase(ldsl, g, S, E, wv);
    }

    if constexpr (PHON(7))
    {
        bf16_t* Q = (bf16_t*)(ws + WS_Q); const unsigned char* K8 = ws + WS_K8; const unsigned char* V8 = ws + WS_V8; const bf16_t* GA = (const bf16_t*)(ws + WS_GA);
        const float skv = *(const float*)(ws + WS_SK);
        { const int per = (512 + G - 1) / G;
          for (int ui = vcu * per; ui < (vcu + 1) * per && ui < 512; ++ui) {
              const int qb = ui & 63, h = ui >> 6, kvh = h >> 2; const size_t tok0 = (size_t)NPROMPT + qb * 256;
              att::attn_unit_i8<1024, 256>(Q + tok0 * 1024 + h * 128, K8 + (size_t)NPROMPT * 256 + kvh * 128, V8 + ((size_t)(NPROMPT / 64) * 2 + kvh) * 8192, GA + tok0 * 1024 + h * 128,
                                           Q + tok0 * 1024 + h * 128, SEQ_S, (char*)lds, qb * 256, P.in[6], cosT, sinT, skv, wv);
          } }
        { const int per = (2048 + G - 1) / G;
          for (int uu = vcu * per; uu < (vcu + 1) * per && uu < 2048; ++uu) {
              int ui = uu;
              if (G == 256) { const int xcd = vcu >> 5, j = vcu & 31, k = uu & 7, pair = xcd * 2 + (k >> 2); ui = pair * 128 + j * 4 + (k & 3); }
              const int qb = ui & 31, hq = (ui >> 5) & 3, kvh = (ui >> 7) & 1, b = ui >> 8, h = kvh * 4 + hq; const size_t tok0 = (size_t)b * SEQ_P + qb * 256, kt0 = (size_t)b * SEQ_P;
              att::attn_unit_i8<1024, 256>(Q + tok0 * 1024 + h * 128, K8 + kt0 * 256 + kvh * 128, V8 + ((kt0 / 64) * 2 + kvh) * 8192, GA + tok0 * 1024 + h * 128,
                                           Q + tok0 * 1024 + h * 128, SEQ_P, (char*)lds, qb * 256, P.in[6], cosT, sinT, skv, wv);
          } }
        { bf16_t* QX = (bf16_t*)(ws + WS_QX); const bf16_t* GX = (const bf16_t*)(ws + WS_GX); const bf16_t* KVM = (const bf16_t*)(ws + WS_KVM);
          const int per = (1280 + G - 1) / G;
          for (int ui = vcu * per; ui < (vcu + 1) * per && ui < 1280; ++ui) {
              const int h = ui & 3, tb = ui >> 2; const size_t tok0 = (size_t)tb * 256; const int mb = tok0 < (size_t)NPROMPT ? (int)(tok0 / SEQ_P) : 8;
              const bf16_t* km = KVM + (size_t)mb * 256 * 1024 + h * 128;
              att::attn_unit<false, 512, 1024>(QX + tok0 * 512 + h * 128, km, km + 512, GX + tok0 * 512 + h * 128, QX + tok0 * 512 + h * 128, 256, (char*)lds, 0, nullptr, nullptr, nullptr, wv);
          } }
    }
    __syncthreads();
    grid.sync();
    STAMP(7);

    if constexpr (PHON(8))
    {
        pg8::Gemm g{(const bf16_t*)(ws + WS_Q), (const bf16_t*)(ws + WS_WPA), 1024, 1024, 1024}; pg8::StaticOrder S; S.init(NTOK, 1024, G, bid);
        pg8::Epi8<FStoreBf16> E{FStoreBf16{(bf16_t*)(ws + WS_GA), 1024}};
        pg8::gemm_phase(ldsl, g, S, E, wv);
    }
    if constexpr (PHON(8))
    {
        static_assert(WS_QX == WS_GS + (size_t)NTOK * 512 * 2 && WS_WPX == WS_WPS + (size_t)1024 * 512 * 2, "stacked PS/PX operands");
        pg8::Gemm g{(const bf16_t*)(ws + WS_GS), (const bf16_t*)(ws + WS_WPS), 512, 512, 512}; pg8::GroupedOrder S; S.init(2, NTOK / 256, 4, G, vcu);
        pg8::Epi8<FStorePSX> E{FStorePSX{ws}};
        pg8::gemm_phase(ldsl, g, S, E, wv);
    }
    __syncthreads();
    grid.sync();
    STAMP(8);

    if constexpr (PHON(9))
    {
        { pg8::Gemm g{(const bf16_t*)XN8, (const bf16_t*)(W8 + (size_t)3584 * 1024), 512, 512, 512}; pg8::PairOrder S{G, vcu};
          EpiMergeI8 E{ws, XS, WSC + 3584, (bf16_t*)(ws + WS_GA)};
          pg8::gemm_phase<true>(ldsl, g, S, E, wv); }
        { pg8::Gemm g{XN, WIN + (size_t)(4608 + 1024) * 1024, 1024, 1024, 1024}; pg8::SingleOrder S{G, vcu};
          pg8::Epi8<FMerge> E{FMerge{ws, (bf16_t*)(ws + WS_GA), 1}};
          pg8::gemm_phase(ldsl, g, S, E, wv); }
    }
    __syncthreads();
    grid.sync();
    STAMP(9);

    if constexpr (PHON(10))
    {
        pg8::Gemm g{(const bf16_t*)(ws + WS_GA), (const bf16_t*)(ws + WS_WOUT), 1024, 1024, 1024}; pg8::StaticOrder S; S.init(NTOK, 1024, G, bid);
        EpiOutNorm E{xp, xs, P.out, P.in[24], (float*)(ws + WS_RSS), (unsigned*)(ws + WS_CNT)};
        pg8::gemm_phase(ldsl, g, S, E, wv);
    }
    if (PROBE) {
        __syncthreads(); grid.sync(); STAMP(11);
        if (bid == 0) { PHASE_IDS
            __syncthreads();
            const unsigned long long* TS = (const unsigned long long*)(ws + 768 * 1024);
            const float tA_us = (float)(__hip_atomic_load(TS + PROBE_A1, __ATOMIC_RELAXED, __HIP_MEMORY_SCOPE_AGENT) - __hip_atomic_load(TS + PROBE_A0, __ATOMIC_RELAXED, __HIP_MEMORY_SCOPE_AGENT)) * 0.01f;
            const float tB_us = (float)(__hip_atomic_load(TS + PROBE_B1, __ATOMIC_RELAXED, __HIP_MEMORY_SCOPE_AGENT) - __hip_atomic_load(TS + PROBE_B0, __ATOMIC_RELAXED, __HIP_MEMORY_SCOPE_AGENT)) * 0.01f;
            if (tid == 0) P.out[0] += tA_us * (1.f / 2000.f);
            const float dB = sqrtf(80e-6f * tB_us * 1e-3f);
            for (int i = tid; i < 1048576; i += 512) P.out[1024 + i] += dB;
        }
    }
}

#undef XN8
#undef XS
#undef W8
#undef WSC
extern "C" void kernel_launch(void* const* d_in, const int* in_sizes, int n_in, void* d_out, int out_size, void* d_ws, size_t ws_size, hipStream_t stream) {
    static int grid = 0;
    if (grid == 0) {
        if (n_in != 25 || out_size != NTOK * DM || ws_size < WS_END) { fprintf(stderr, "kernel_launch: unexpected shapes (n_in %d out %d ws %zu)\n", n_in, out_size, ws_size); grid = -1; return; }
        int dev = 0, cus = 0, per_cu = 0;
        hipGetDevice(&dev); hipDeviceGetAttribute(&cus, hipDeviceAttributeMultiprocessorCount, dev);
        if (hipFuncSetAttribute((const void*)hybrid_fwd, hipFuncAttributeMaxDynamicSharedMemorySize, LDS_BYTES) != hipSuccess) { fprintf(stderr, "kernel_launch: hipFuncSetAttribute failed\n"); grid = -1; return; }
        if (hipOccupancyMaxActiveBlocksPerMultiprocessor(&per_cu, (const void*)hybrid_fwd, 512, LDS_BYTES) != hipSuccess || per_cu < 1) { fprintf(stderr, "kernel_launch: occupancy query failed (%d)\n", per_cu); (void)hipGetLastError(); per_cu = 1; }
        grid = cus * per_cu;
    }
    if (grid < 0) return;
    Params p{};
    for (int i = 0; i < 25; ++i) p.in[i] = (const float*)d_in[i];
    p.out = (float*)d_out; p.ws = (unsigned char*)d_ws;
    void* args[] = {&p};
    hipError_t e = hipLaunchCooperativeKernel((const void*)hybrid_fwd, dim3(grid), dim3(512), args, LDS_BYTES, stream);
    if (e != hipSuccess) fprintf(stderr, "kernel_launch: cooperative launch failed: %s (grid %d)\n", hipGetErrorString(e), grid);
}
```

```cpp
#include <hip/hip_runtime.h>
#include <hip/hip_cooperative_groups.h>
#include <cstdio>
#include <cstdint>
namespace cg = cooperative_groups;

#define LAS __attribute__((address_space(3)))
typedef unsigned short bf16_t;
typedef short bf16x8 __attribute__((ext_vector_type(8)));
typedef short s16x4 __attribute__((ext_vector_type(4)));
typedef float f32x4 __attribute__((ext_vector_type(4)));
typedef float f32x16 __attribute__((ext_vector_type(16)));
typedef unsigned u32x4 __attribute__((ext_vector_type(4)));
typedef unsigned u32x2 __attribute__((ext_vector_type(2)));
typedef int i32x4 __attribute__((ext_vector_type(4)));
typedef int i32x16 __attribute__((ext_vector_type(16)));

constexpr int DM = 1024, NTOK = 81920, NPROMPT = 65536, SEQ_P = 8192, SEQ_S = 16384;
constexpr int NMEMROWS = 2304;
constexpr int CH = 64;
constexpr int NCHUNK = NTOK / CH;
constexpr int AGK = 1280;
constexpr float EPS = 1e-6f;

constexpr size_t MiB = 1u << 20;
constexpr size_t WS_RSS = 0, WS_CNT = 512 * 1024;
constexpr size_t WS_COS = 1 * MiB, WS_SIN = 1 * MiB + 65536;
constexpr size_t WS_KT = 2 * MiB;
constexpr size_t WS_WIN = 6 * MiB;
constexpr size_t WS_WMKV = 21 * MiB, WS_WPA = 23 * MiB, WS_WPS = 25 * MiB, WS_WPX = 26 * MiB, WS_WOUT = 27 * MiB, WS_WGLU = 29 * MiB;
constexpr size_t WS_MN = 30 * MiB, WS_KVM = 35 * MiB;
constexpr size_t WS_XN = 40 * MiB;
constexpr size_t WS_Q = 200 * MiB;
constexpr size_t WS_GA = 360 * MiB;
constexpr size_t WS_K = 520 * MiB, WS_V = 560 * MiB, WS_U = 600 * MiB;
constexpr size_t WS_PS = 520 * MiB;
constexpr size_t WS_GS = 680 * MiB;
constexpr size_t WS_QX = 760 * MiB;
constexpr size_t WS_GX = 840 * MiB;
constexpr size_t WS_PX = 840 * MiB;
constexpr size_t WS_K8 = 920 * MiB;
constexpr size_t WS_V8 = 940 * MiB;
constexpr size_t WS_SK = 900 * 1024;
constexpr size_t WS_W8 = 1000 * MiB, WS_WSC = 1006 * MiB, WS_XS = 1007 * MiB;
constexpr size_t WS_WPA8 = 1008 * MiB, WS_WPX8 = 1009 * MiB;
constexpr size_t WS_END = 1010 * MiB;
constexpr size_t DO_Y8A = 0, DO_Y8X = 80 * MiB;
constexpr size_t DO_XN8 = 236 * MiB;
constexpr size_t DO_AG = 0, DO_WG = 100 * MiB, DO_WE = 180 * MiB, DO_EC = 196 * MiB;

constexpr int LDS_BYTES = 135168;

__device__ __forceinline__ unsigned cvtpk(float lo, float hi) { unsigned r; asm volatile("v_cvt_pk_bf16_f32 %0, %1, %2" : "=v"(r) : "v"(lo), "v"(hi)); return r; }
__device__ __forceinline__ float bflo(unsigned w) { return __uint_as_float(w << 16); }
__device__ __forceinline__ float bfhi(unsigned w) { return __uint_as_float(w & 0xffff0000u); }
__device__ __forceinline__ float bf2f(bf16_t s) { return __uint_as_float(((unsigned)s) << 16); }
__device__ __forceinline__ float sigmoidf_(float x) { return __builtin_amdgcn_rcpf(1.f + __builtin_amdgcn_exp2f(-1.4426950408889634f * x)); }
__device__ __forceinline__ float siluf_(float x) { return x * sigmoidf_(x); }
__device__ __forceinline__ float gelu_tanh_(float x) { return x * sigmoidf_(1.5957691216057308f * (x + 0.044715f * x * x * x)); }
__device__ __forceinline__ int opaque_tid(int wv) { int l; asm volatile("v_mbcnt_lo_u32_b32 %0, -1, 0\n\tv_mbcnt_hi_u32_b32 %0, -1, %0" : "=v"(l)); return wv * 64 + l; }
__device__ __forceinline__ float wave_sum(float v) {
#pragma unroll
    for (int o = 1; o < 64; o <<= 1) v += __shfl_xor(v, o);
    return v;
}
__device__ __forceinline__ void cexp_turns(float turns, float& c, float& s) { const float f = turns - rintf(turns); c = cospif(2.f * f); s = sinpif(2.f * f); }
__device__ __forceinline__ void lam_pow(float are, float aim, float dt, float p, float& re, float& im) {
    const float mag = __expf(are * dt * p); float c, s; cexp_turns(aim * dt * p * 0.15915494309189535f, c, s); re = mag * c; im = mag * s;
}
__device__ __forceinline__ void zoh_coef(float are, float aim, float dt, float& cr, float& ci) {
    const float x = are * dt, y = aim * dt; const float ex1 = expm1f(x); float cy, sy; cexp_turns(y * 0.15915494309189535f, cy, sy);
    const float re1 = ex1 * cy + (cy - 1.f), im1 = (1.f + ex1) * sy; const float den = 1.f / (are * are + aim * aim);
    cr = (re1 * are + im1 * aim) * den; ci = (im1 * are - re1 * aim) * den;
}

namespace pg8 {
constexpr int BM = 256, BK = 64, HALF = 128, HTB = HALF * BK * 2, STAGE_BYTES = 8 * HTB, NXCD = 8, WGM = 8;
__host__ __device__ __forceinline__ int lds_byte(int r, int c) { const int st = (r >> 4) * 2 + (c >> 5), rr = r & 15, cc = c & 31, ob = rr * 64 + cc * 2; return st * 1024 + (ob ^ (((ob >> 9) & 1) << 5)); }
__host__ __device__ __forceinline__ void stage_rc(int b, int& R, int& C) { const int st = b / 1024, sb = b % 1024, swz = sb ^ (((sb >> 9) & 1) << 5); R = (st >> 1) * 16 + swz / 64; C = (st & 1) * 32 + (swz % 64) / 2; }
__host__ __device__ __forceinline__ int perm32(int rho) { const int n = rho >> 4, i = rho & 15; return 8 * (i >> 2) + 4 * n + (i & 3); }
struct Unit { int pm, pn; };
struct Gemm { const bf16_t* A; const bf16_t* Bt; int lda, ldb, K; int sa = 0x7F7F7F7F, sb = 0x7F7F7F7F; };

struct StaticOrder {
    int nM, nN, nwg, G, c;
    __device__ void init(int M, int N, int G_, int c_) { nM = M / BM; nN = N / BM; nwg = nM * nN; G = G_; c = c_; }
    __device__ bool next(int i, Unit& u) const {
        const long L = (long)i * G + c; if (L >= nwg) return false;
        int wgid = (int)L; { const int q = nwg / NXCD, r = nwg % NXCD, xcd = wgid % NXCD, off = wgid / NXCD; wgid = (xcd < r ? xcd * (q + 1) : r * (q + 1) + (xcd - r) * q) + off; }
        const int nig = WGM * nN, gid = wgid / nig, fm = gid * WGM, gsz = (nM - fm) < WGM ? (nM - fm) : WGM;
        u.pm = fm + ((wgid % nig) % gsz); u.pn = (wgid % nig) / gsz; return true;
    }
};
struct GroupedOrder {
    int RT, CT, total, G, c;
    __device__ void init(int ng, int RT_, int CT_, int G_, int c_) { RT = RT_; CT = CT_; total = ng * RT_ * CT_; G = G_; c = c_; }
    __device__ bool next(int i, Unit& u) const {
        const int L = i * G + c; if (L >= total) return false;
        const int per = RT * CT, g = L / per, rem = L % per, a = rem / CT, b = rem % CT; u.pm = g * RT + a; u.pn = g * CT + b; return true;
    }
};
struct PairOrder {
    int G, c;
    __device__ bool next(int i, Unit& u) const { const int tr = (i >> 1) * G + c; if (tr >= 1280) return false; u.pm = tr >> 2; u.pn = (i & 1) * 4 + (tr & 3); return true; }
};
struct SingleOrder {
    int G, c;
    __device__ bool next(int i, Unit& u) const { const int tr = i * G + c; if (tr >= 1280) return false; u.pm = tr >> 2; u.pn = tr & 3; return true; }
};
struct TripleOrder {
    int G, c;
    __device__ bool next(int i, Unit& u) const {
        const int tr = (i / 3) * G + c; if (tr >= 1280) return false;
        const int br = i % 3; u.pm = tr >> 2; u.pn = br * 4 + (tr & 3); return true;
    }
};

template <class F> struct Epi8 {
    static constexpr bool PERM = true;
    F f;
    __device__ __forceinline__ void operator()(const f32x4 (&acc)[2][2][4][2], const Unit& u, int wr, int wc, int fr, int fq) const {
        const int row0 = u.pm * BM + wr * 64 + fr, col0 = u.pn * BM + wc * 32 + 8 * fq;
        if constexpr (F::HAS_LOAD) {
#pragma unroll
            for (int ai = 0; ai < 2; ++ai) {
                typename F::Ld ld[4][2];
#pragma unroll
                for (int m = 0; m < 4; ++m)
#pragma unroll
                    for (int bj = 0; bj < 2; ++bj) ld[m][bj] = f.load(u, row0 + ai * HALF + m * 16, col0 + bj * HALF);
#pragma unroll
                for (int m = 0; m < 4; ++m)
#pragma unroll
                    for (int bj = 0; bj < 2; ++bj) f.apply(u, row0 + ai * HALF + m * 16, col0 + bj * HALF, acc[ai][bj][m][0], acc[ai][bj][m][1], ld[m][bj]);
                asm volatile("" ::: "memory");
            }
        } else {
#pragma unroll
            for (int ai = 0; ai < 2; ++ai)
#pragma unroll
                for (int m = 0; m < 4; ++m) {
#pragma unroll
                    for (int bj = 0; bj < 2; ++bj) f(u, row0 + ai * HALF + m * 16, col0 + bj * HALF, acc[ai][bj][m][0], acc[ai][bj][m][1]);
                    asm volatile("" ::: "memory");
                }
        }
    }
};

template <bool I8> __device__ __forceinline__ f32x4 mma16(bf16x8 b, bf16x8 a, f32x4 c) {
    if constexpr (I8) return __builtin_bit_cast(f32x4, __builtin_amdgcn_mfma_i32_16x16x64_i8(__builtin_bit_cast(i32x4, b), __builtin_bit_cast(i32x4, a), __builtin_bit_cast(i32x4, c), 0, 0, 0));
    else return __builtin_amdgcn_mfma_f32_16x16x32_bf16(b, a, c, 0, 0, 0);
}
typedef int i32x8g __attribute__((ext_vector_type(8)));
template <int MODE = 0, class Epi, class Sched>
__device__ __forceinline__ void gemm_phase(LAS unsigned char* lds, const Gemm g, const Sched& S, const Epi& E, int wv) {
    const int tid = opaque_tid(wv), wid = __builtin_amdgcn_readfirstlane(tid >> 6), lane = tid & 63, wr = wid >> 2, wc = wid & 3, fr = lane & 15, fq = lane >> 4;
    const int K = g.K, nt = K / BK;
    unsigned voffA[2], voffB[2];
#pragma unroll
    for (int i = 0; i < 2; ++i) { int R, C; stage_rc(tid * 16 + i * 8192, R, C); const int Rb = Epi::PERM ? ((R & ~31) + perm32(R & 31)) : R;
        voffA[i] = (unsigned)(R * g.lda + C) * 2u; voffB[i] = (unsigned)(Rb * g.ldb + C) * 2u; }
    const size_t kstep = (size_t)(BK * 2);
    const size_t hstepA = (size_t)HALF * g.lda * 2, hstepB = (size_t)HALF * g.ldb * 2;
    const size_t tstepA = 2 * hstepA, tstepB = 2 * hstepB;
    const unsigned ldsw = (unsigned)wid * 1024u;
    const int aoff = lds_byte(wr * 64 + fr, fq * 8), boff = lds_byte(wc * 32 + fr, fq * 8);
    const int aoff8 = lds_byte(wr * 64 + fr, (fq & 1) * 32 + (fq >> 1) * 16), boff8 = lds_byte(wc * 32 + fr, (fq & 1) * 32 + (fq >> 1) * 16);
#define PG8_SA(b, h) (((b) * 2 + (h)) * HTB)
#define PG8_SB(b, h) ((4 + (b) * 2 + (h)) * HTB)
#define PG8_STAGE(bufoff, gbase, voff) do { _Pragma("unroll") for (int _i = 0; _i < 2; ++_i) \
        __builtin_amdgcn_global_load_lds((const unsigned*)((const char*)(gbase) + (voff)[_i]), (LAS unsigned*)(lds + (bufoff) + ldsw + _i * 8192), 16, 0, 0); } while (0)
#define PG8_LDA(dst, b, h) do { if constexpr (MODE == 2) { _Pragma("unroll") for (int m = 0; m < 4; ++m) dst##8[m] = *(const LAS i32x8g*)(lds + PG8_SA(b, h) + aoff8 + m * 2048); } \
    else { _Pragma("unroll") for (int m = 0; m < 4; ++m) _Pragma("unroll") for (int k = 0; k < 2; ++k) dst[m][k] = *(const LAS bf16x8*)(lds + PG8_SA(b, h) + aoff + m * 2048 + k * 1024); } } while (0)
#define PG8_LDB(dst, b, h) do { if constexpr (MODE == 2) { _Pragma("unroll") for (int n = 0; n < 2; ++n) dst##8[n] = *(const LAS i32x8g*)(lds + PG8_SB(b, h) + boff8 + n * 2048); } \
    else { _Pragma("unroll") for (int n = 0; n < 2; ++n) _Pragma("unroll") for (int k = 0; k < 2; ++k) dst[n][k] = *(const LAS bf16x8*)(lds + PG8_SB(b, h) + boff + n * 2048 + k * 1024); } } while (0)
#define PG8_MMA(ai, bj, At, Bt) do { __builtin_amdgcn_s_setprio(1); \
    if constexpr (MODE == 2) { _Pragma("unroll") for (int m = 0; m < 4; ++m) _Pragma("unroll") for (int n = 0; n < 2; ++n) \
        asm volatile("v_mfma_scale_f32_16x16x128_f8f6f4 %0, %1, %2, %0, %3, %4 op_sel_hi:[0,0,0]" : "+v"(acc[ai][bj][m][n]) : "v"(Bt##8[n]), "v"(At##8[m]), "v"(vsb), "v"(vsa)); } \
    else { _Pragma("unroll") for (int m = 0; m < 4; ++m) _Pragma("unroll") for (int n = 0; n < 2; ++n) _Pragma("unroll") for (int k = 0; k < 2; ++k) \
        acc[ai][bj][m][n] = mma16<MODE == 1>(Bt[n][k], At[m][k], acc[ai][bj][m][n]); } __builtin_amdgcn_s_setprio(0); } while (0)
#define PG8_WAIT_V(n) asm volatile("s_waitcnt vmcnt(" #n ")" ::: "memory")
#define PG8_WAIT_L(n) asm volatile("s_waitcnt lgkmcnt(" #n ")" ::: "memory")
#define PG8_BAR __builtin_amdgcn_s_barrier()
#define PG8_SCHED __builtin_amdgcn_sched_barrier(0)
    Unit cur, nxt; int ui = 0;
    if (!S.next(0, cur)) return;
    f32x4 acc[2][2][4][2];
#pragma unroll
    for (int a = 0; a < 2; ++a)
#pragma unroll
        for (int b = 0; b < 2; ++b)
#pragma unroll
            for (int m = 0; m < 4; ++m)
#pragma unroll
                for (int n = 0; n < 2; ++n) acc[a][b][m][n] = (f32x4){0.f, 0.f, 0.f, 0.f};
    bf16x8 At[4][2], B0[2][2], B1[2][2];
    i32x8g At8[4], B08[2], B18[2];
    const int vsa = g.sa, vsb = g.sb;
    const char* cA = (const char*)g.A + (size_t)cur.pm * tstepA; const char* cB = (const char*)g.Bt + (size_t)cur.pn * tstepB;
    PG8_STAGE(PG8_SB(0, 0), cB, voffB); PG8_STAGE(PG8_SB(0, 1), cB + hstepB, voffB); PG8_STAGE(PG8_SA(0, 0), cA, voffA); PG8_STAGE(PG8_SA(0, 1), cA + hstepA, voffA);
    if (wr == 1) PG8_BAR;
    PG8_WAIT_V(2); PG8_BAR;
    PG8_STAGE(PG8_SB(1, 0), cB + kstep, voffB); PG8_STAGE(PG8_SA(1, 0), cA + kstep, voffA); PG8_STAGE(PG8_SB(1, 1), cB + hstepB + kstep, voffB);
    PG8_WAIT_V(6); PG8_BAR;
    for (;;) {
        const bool has_next = S.next(ui + 1, nxt);
        const char* nA = has_next ? (const char*)g.A + (size_t)nxt.pm * tstepA : cA; const char* nB = has_next ? (const char*)g.Bt + (size_t)nxt.pn * tstepB : cB;
        for (int t = 0; t < nt; t += 2) {
            const bool last = (t == nt - 2);
            const char* a1 = cA + (size_t)(t + 1) * kstep;
            const char* a2 = last ? nA : cA + (size_t)(t + 2) * kstep; const char* b2 = last ? nB : cB + (size_t)(t + 2) * kstep;
            const char* a3 = a2 + kstep; const char* b3 = b2 + kstep;
            PG8_LDB(B0, 0, 0); PG8_LDB(B1, 0, 1); PG8_SCHED; PG8_LDA(At, 0, 0); PG8_STAGE(PG8_SA(1, 1), a1 + hstepA, voffA);
            PG8_WAIT_V(8); PG8_WAIT_L(0); PG8_BAR; PG8_MMA(0, 0, At, B0); PG8_MMA(0, 1, At, B1); PG8_BAR; PG8_SCHED;
            PG8_LDA(At, 0, 1); PG8_STAGE(PG8_SB(0, 0), b2, voffB); PG8_STAGE(PG8_SB(0, 1), b2 + hstepB, voffB); PG8_STAGE(PG8_SA(0, 0), a2, voffA);
            PG8_WAIT_V(8); PG8_WAIT_L(0); PG8_BAR; PG8_MMA(1, 0, At, B0); PG8_MMA(1, 1, At, B1); PG8_BAR; PG8_SCHED;
            PG8_LDB(B0, 1, 0); PG8_LDB(B1, 1, 1); PG8_SCHED; PG8_LDA(At, 1, 0); PG8_STAGE(PG8_SA(0, 1), a2 + hstepA, voffA);
            PG8_WAIT_V(8); PG8_WAIT_L(0); PG8_BAR; PG8_MMA(0, 0, At, B0); PG8_MMA(0, 1, At, B1); PG8_BAR; PG8_SCHED;
            PG8_LDA(At, 1, 1); PG8_STAGE(PG8_SB(1, 0), b3, voffB); PG8_STAGE(PG8_SB(1, 1), b3 + hstepB, voffB); PG8_STAGE(PG8_SA(1, 0), a3, voffA);
            PG8_WAIT_V(8); PG8_WAIT_L(0); PG8_BAR; PG8_MMA(1, 0, At, B0); PG8_MMA(1, 1, At, B1); PG8_BAR; PG8_SCHED;
        }
        if (wr == 0) PG8_BAR;
        if constexpr (MODE == 2) asm volatile("s_nop 15\n\ts_nop 15\n\ts_nop 15" ::: "memory");
        E(acc, cur, wr, wc, fr, fq);
        if (!has_next) break;
#pragma unroll
        for (int a = 0; a < 2; ++a)
#pragma unroll
            for (int b = 0; b < 2; ++b)
#pragma unroll
                for (int m = 0; m < 4; ++m)
#pragma unroll
                    for (int n = 0; n < 2; ++n) acc[a][b][m][n] = (f32x4){0.f, 0.f, 0.f, 0.f};
        cur = nxt; cA = nA; cB = nB; ++ui;
        if (wr == 1) PG8_BAR;
    }
    PG8_WAIT_V(0);
    PG8_BAR;
#undef PG8_SA
#undef PG8_SB
#undef PG8_STAGE
#undef PG8_LDA
#undef PG8_LDB
#undef PG8_MMA
#undef PG8_WAIT_V
#undef PG8_WAIT_L
#undef PG8_BAR
#undef PG8_SCHED
}
}

__device__ __forceinline__ u32x4 pack8(f32x4 v0, f32x4 v1) { u32x4 w; w.x = cvtpk(v0[0], v0[1]); w.y = cvtpk(v0[2], v0[3]); w.z = cvtpk(v1[0], v1[1]); w.w = cvtpk(v1[2], v1[3]); return w; }
__device__ __forceinline__ void unpack8(u32x4 w, f32x4& a, f32x4& b) { a = (f32x4){bflo(w.x), bfhi(w.x), bflo(w.y), bfhi(w.y)}; b = (f32x4){bflo(w.z), bfhi(w.z), bflo(w.w), bfhi(w.w)}; }
__device__ __forceinline__ f32x4 silu4(f32x4 v) { return (f32x4){siluf_(v[0]), siluf_(v[1]), siluf_(v[2]), siluf_(v[3])}; }
__device__ __forceinline__ f32x4 sig4(f32x4 v) { return (f32x4){sigmoidf_(v[0]), sigmoidf_(v[1]), sigmoidf_(v[2]), sigmoidf_(v[3])}; }
__device__ __forceinline__ f32x4 gelu4(f32x4 v) { return (f32x4){gelu_tanh_(v[0]), gelu_tanh_(v[1]), gelu_tanh_(v[2]), gelu_tanh_(v[3])}; }

struct FInProj { static constexpr bool HAS_LOAD = false;
    unsigned char* ws; bf16_t* AG; int pn0;
    __device__ __forceinline__ void operator()(const pg8::Unit& u, int row, int col, f32x4 v0, f32x4 v1) const {
        const int pn = u.pn + pn0; col += pn0 * 256; size_t off; int ld, c; bool act = false;
        if (pn < 4) { off = WS_Q; ld = 1024; c = col; }
        else if (pn == 4) { off = WS_K; ld = 256; c = col - 1024; }
        else if (pn == 5) { off = WS_V; ld = 256; c = col - 1280; }
        else if (pn < 10) { off = WS_GA; ld = 1024; c = col - 1536; act = true; }
        else if (pn < 12) {
            const int cu = col - 2560, g = cu >> 4;
            *(u32x4*)(AG + ((size_t)(g * NCHUNK + (row >> 6))) * AGK + (row & 63) * 16 + (cu & 15)) = pack8(v0, v1); return; }
        else if (pn < 14) { off = WS_GS; ld = 512; c = col - 3072; act = true; }
        else if (pn < 16) { off = WS_QX; ld = 512; c = col - 3584; }
        else { off = WS_GX; ld = 512; c = col - 4096; act = true; }
        if (act) { v0 = silu4(v0); v1 = silu4(v1); }
        *(u32x4*)((bf16_t*)(ws + off) + (size_t)row * ld + c) = pack8(v0, v1);
    }
};
struct EpiInProjI8 {
    static constexpr bool PERM = true;
    unsigned char* ws; const float* xs; const float* wsc;
    __device__ __forceinline__ void operator()(const f32x4 (&acc)[2][2][4][2], const pg8::Unit& u, int wr, int wc, int fr, int fq) const {
        const int row0 = u.pm * 256 + wr * 64 + fr, col0 = u.pn * 256 + wc * 32 + 8 * fq, pn = u.pn;
        float rs[2][4]; f32x4 cs[2][2];
#pragma unroll
        for (int ai = 0; ai < 2; ++ai)
#pragma unroll
            for (int m = 0; m < 4; ++m) rs[ai][m] = xs[row0 + ai * 128 + m * 16];
#pragma unroll
        for (int bj = 0; bj < 2; ++bj)
#pragma unroll
            for (int n = 0; n < 2; ++n) cs[bj][n] = *(const f32x4*)(wsc + col0 + bj * 128 + 4 * n);
        size_t off; int ld, c0; bool act = false;
        if (pn < 4) { off = WS_Q; ld = 1024; c0 = col0; }
        else if (pn == 4) { off = WS_K; ld = 256; c0 = col0 - 1024; }
        else if (pn == 5) { off = WS_V; ld = 256; c0 = col0 - 1280; }
        else if (pn < 10) { off = WS_GA; ld = 1024; c0 = col0 - 1536; act = true; }
        else if (pn < 12) { off = WS_QX; ld = 512; c0 = col0 - 2560; }
        else { off = WS_GX; ld = 512; c0 = col0 - 3072; act = true; }
        bf16_t* base = (bf16_t*)(ws + off);
#pragma unroll
        for (int ai = 0; ai < 2; ++ai)
#pragma unroll
            for (int m = 0; m < 4; ++m) {
#pragma unroll
                for (int bj = 0; bj < 2; ++bj) {
                    f32x4 v0 = __builtin_convertvector(__builtin_bit_cast(i32x4, acc[ai][bj][m][0]), f32x4) * rs[ai][m] * cs[bj][0];
                    f32x4 v1 = __builtin_convertvector(__builtin_bit_cast(i32x4, acc[ai][bj][m][1]), f32x4) * rs[ai][m] * cs[bj][1];
                    if (act) { v0 = silu4(v0); v1 = silu4(v1); }
                    *(u32x4*)(base + (size_t)(row0 + ai * 128 + m * 16) * ld + c0 + bj * 128) = pack8(v0, v1);
                }
                asm volatile("" ::: "memory");
            }
    }
};
struct EpiMergeI8 {
    static constexpr bool PERM = true;
    const unsigned char* wsb; const float* xs; const float* wsc; bf16_t* MG;
    __device__ __forceinline__ void operator()(f32x4 (&acc)[2][2][4][2], const pg8::Unit& u, int wr, int wc, int fr, int fq) const {
        { int l; asm volatile("v_mbcnt_lo_u32_b32 %0, -1, 0\n\tv_mbcnt_hi_u32_b32 %0, -1, %0" : "=v"(l)); fr = l & 15; fq = l >> 4; }
        const int k = u.pn >> 2, br = 2 * k, rowt = u.pm * 256, ct = (u.pn & 3) * 256;
        const unsigned lrow = (unsigned)(wr * 64 + fr), lcol = (unsigned)(wc * 32 + 8 * fq), loff = lrow * 1024u + lcol;
        const float* xsb = xs + rowt; const float* wb = wsc + u.pn * 256;
        const bf16_t* Pt = (const bf16_t*)(wsb + (size_t)(360 + 240 * br) * MiB) + (size_t)rowt * 1024 + ct;
        bf16_t* Mt = MG + (size_t)rowt * 1024 + ct;
        {
            f32x4 cs[2][2];
#pragma unroll
            for (int bj = 0; bj < 2; ++bj)
#pragma unroll
                for (int n = 0; n < 2; ++n) cs[bj][n] = *(const f32x4*)((wb + bj * 128 + 4 * n) + lcol);
#pragma unroll
            for (int ai = 0; ai < 2; ++ai)
#pragma unroll
                for (int m = 0; m < 4; ++m) { const float rsv = (xsb + ai * 128 + m * 16)[lrow];
#pragma unroll
                    for (int bj = 0; bj < 2; ++bj)
#pragma unroll
                        for (int n = 0; n < 2; ++n) acc[ai][bj][m][n] = sig4(__builtin_convertvector(__builtin_bit_cast(i32x4, acc[ai][bj][m][n]), f32x4) * rsv * cs[bj][n]); }
        }
#pragma unroll
        for (int ai = 0; ai < 2; ++ai) {
            u32x4 pv[4][2], av[4][2];
#pragma unroll
            for (int m = 0; m < 4; ++m)
#pragma unroll
                for (int bj = 0; bj < 2; ++bj) { const size_t o = (size_t)(ai * 128 + m * 16) * 1024 + bj * 128;
                    pv[m][bj] = *(const u32x4*)((Pt + o) + loff); if (br != 0) av[m][bj] = *(const u32x4*)((Mt + o) + loff); else av[m][bj] = (u32x4){0u, 0u, 0u, 0u}; }
#pragma unroll
            for (int m = 0; m < 4; ++m)
#pragma unroll
                for (int bj = 0; bj < 2; ++bj) { const size_t o = (size_t)(ai * 128 + m * 16) * 1024 + bj * 128;
                    f32x4 p0, p1, a0, a1; unpack8(pv[m][bj], p0, p1); unpack8(av[m][bj], a0, a1);
                    *(u32x4*)((Mt + o) + loff) = pack8(a0 + acc[ai][bj][m][0] * p0, a1 + acc[ai][bj][m][1] * p1); }
            asm volatile("" ::: "memory");
        }
    }
};
static_assert(WS_GA == 360 * MiB && WS_PX == 840 * MiB, "EpiMergeI8 offset arithmetic");
struct FStoreBf16 { static constexpr bool HAS_LOAD = false; bf16_t* O; int ldc;
    __device__ __forceinline__ void operator()(const pg8::Unit&, int row, int col, f32x4 v0, f32x4 v1) const { *(u32x4*)(O + (size_t)row * ldc + col) = pack8(v0, v1); } };
struct FStorePSX { static constexpr bool HAS_LOAD = false; unsigned char* ws;
    __device__ __forceinline__ void operator()(const pg8::Unit& u, int row, int col, f32x4 v0, f32x4 v1) const {
        const int g = u.pn >> 2; bf16_t* O = (bf16_t*)(ws + (g ? WS_PX : WS_PS));
        *(u32x4*)(O + (size_t)(row - g * NTOK) * 1024 + (col - g * 1024)) = pack8(v0, v1); } };
struct FStoreEC { static constexpr bool HAS_LOAD = false; float* O;
    __device__ __forceinline__ void operator()(const pg8::Unit& u, int row, int col, f32x4 v0, f32x4 v1) const { float* p = O + (size_t)row * 256 + (col - u.pn * 256); *(f32x4*)p = v0; *(f32x4*)(p + 4) = v1; } };
struct FS5Out { static constexpr bool HAS_LOAD = false; bf16_t* YG;
    __device__ __forceinline__ void operator()(const pg8::Unit& u, int row, int col, f32x4 v0, f32x4 v1) const {
        const int g = u.pn >> 2, chunk = row - g * NCHUNK, cl = col - g * 1024, i = cl >> 4, c0 = cl & 15;
        *(u32x4*)(YG + (size_t)(chunk * CH + i) * 512 + g * 16 + c0) = pack8(gelu4(v0), gelu4(v1));
    } };
struct FGlu { static constexpr bool HAS_LOAD = true; const bf16_t* YG; bf16_t* GS; const float* bias;
    struct Ld { u32x4 y, g; };
    __device__ __forceinline__ Ld load(const pg8::Unit&, int row, int col) const { const size_t o = (size_t)row * 512 + col; Ld l; l.y = *(const u32x4*)(YG + o); l.g = *(const u32x4*)(GS + o); return l; }
    __device__ __forceinline__ void apply(const pg8::Unit&, int row, int col, f32x4 v0, f32x4 v1, const Ld& l) const {
        const size_t o = (size_t)row * 512 + col; f32x4 y0, y1, g0, g1; unpack8(l.y, y0, y1); unpack8(l.g, g0, g1);
        const f32x4 b0 = *(const f32x4*)(bias + col), b1 = *(const f32x4*)(bias + col + 4);
        *(u32x4*)(GS + o) = pack8(y0 * sig4(v0 + b0) * g0, y1 * sig4(v1 + b1) * g1);
    } };
static_assert(WS_GA == 360 * MiB && WS_PS == 520 * MiB && WS_PX == 840 * MiB, "FMerge offset arithmetic");
struct FMerge { static constexpr bool HAS_LOAD = true; const unsigned char* wsb; bf16_t* MG; int brofs;
    struct Ld { u32x4 p, a; };
    __device__ __forceinline__ Ld load(const pg8::Unit& u, int row, int col) const {
        const int br = (u.pn >> 2) + brofs, c = col - (u.pn >> 2) * 1024; const size_t o = (size_t)row * 1024 + c;
        const bf16_t* P = (const bf16_t*)(wsb + (size_t)(360 + 160 * br + 160 * (br >> 1)) * MiB);
        Ld l; l.p = *(const u32x4*)(P + o); if (br != 0) l.a = *(const u32x4*)(MG + o); else l.a = (u32x4){0u, 0u, 0u, 0u}; return l;
    }
    __device__ __forceinline__ void apply(const pg8::Unit& u, int row, int col, f32x4 v0, f32x4 v1, const Ld& l) const {
        const int c = col - (u.pn >> 2) * 1024; const size_t o = (size_t)row * 1024 + c;
        f32x4 p0, p1, a0, a1; unpack8(l.p, p0, p1); unpack8(l.a, a0, a1);
        *(u32x4*)(MG + o) = pack8(a0 + sig4(v0) * p0, a1 + sig4(v1) * p1);
    } };
struct EpiOutNorm {
    static constexpr bool PERM = true;
    const float* xp; const float* xs; float* out; const float* gfin; float* rowss; unsigned* cnt;
    __device__ __forceinline__ void operator()(f32x4 (&acc)[2][2][4][2], const pg8::Unit& u, int wr, int wc, int fr, int fq) const {
        { int l; asm volatile("v_mbcnt_lo_u32_b32 %0, -1, 0\n\tv_mbcnt_hi_u32_b32 %0, -1, %0" : "=v"(l)); fr = l & 15; fq = l >> 4; }
        const int rowt = u.pm * 256, col0 = u.pn * 256 + wc * 32 + 8 * fq;
        const float* xb = rowt < NPROMPT ? xp + (size_t)rowt * DM : xs + (size_t)(rowt - NPROMPT) * DM;
        float* ob = out + (size_t)rowt * DM; float* rs = rowss + rowt;
        const unsigned loff = (unsigned)((wr * 64 + fr) * DM + col0), lrow = (unsigned)(wr * 64 + fr);
#pragma unroll
        for (int am = 0; am < 4; ++am) {
            const int ai = am >> 1, mb = (am & 1) * 2;
            const float* xq = xb;
            if (am == 0) asm volatile("" : "+s"(xq));
            else asm volatile("" : "+s"(xq), "+v"(acc[(am - 1) >> 1][1][((am - 1) & 1) * 2 + 1][1]));
            f32x4 xa[2][2][2];
#pragma unroll
            for (int mm = 0; mm < 2; ++mm)
#pragma unroll
                for (int bj = 0; bj < 2; ++bj) { const float* xt = xq + (size_t)(ai * 128 + (mb + mm) * 16) * DM + bj * 128; xa[mm][bj][0] = *(const f32x4*)(xt + loff); xa[mm][bj][1] = *(const f32x4*)(xt + 4 + loff); }
#pragma unroll
            for (int mm = 0; mm < 2; ++mm)
#pragma unroll
                for (int bj = 0; bj < 2; ++bj) { acc[ai][bj][mb + mm][0] += xa[mm][bj][0]; acc[ai][bj][mb + mm][1] += xa[mm][bj][1]; }
            asm volatile("" ::: "memory");
        }
#pragma unroll
        for (int ai = 0; ai < 2; ++ai)
#pragma unroll
            for (int m = 0; m < 4; ++m) { float sq = 0.f;
#pragma unroll
                for (int bj = 0; bj < 2; ++bj)
#pragma unroll
                    for (int n = 0; n < 2; ++n) { const f32x4 v = acc[ai][bj][m][n]; sq += (v[0] * v[0] + v[1] * v[1]) + (v[2] * v[2] + v[3] * v[3]); }
                { auto rr = __builtin_amdgcn_permlane16_swap(__float_as_uint(sq), __float_as_uint(sq), false, false); sq = __uint_as_float(rr[0]) + __uint_as_float(rr[1]); }
                { auto rr = __builtin_amdgcn_permlane32_swap(__float_as_uint(sq), __float_as_uint(sq), false, false); sq = __uint_as_float(rr[0]) + __uint_as_float(rr[1]); }
                if (fq == 0) atomicAdd((rs + ai * 128 + m * 16) + lrow, sq);
            }
        asm volatile("s_waitcnt vmcnt(0)" ::: "memory");
        __syncthreads();
        if (wr == 0 && wc == 0 && fr == 0 && fq == 0) {
            __builtin_amdgcn_fence(__ATOMIC_RELEASE, "agent");
            __hip_atomic_fetch_add(cnt + u.pm, 1u, __ATOMIC_RELAXED, __HIP_MEMORY_SCOPE_AGENT);
            unsigned spins = 0;
            while (__hip_atomic_load(cnt + u.pm, __ATOMIC_RELAXED, __HIP_MEMORY_SCOPE_AGENT) < 4u && ++spins < (1u << 24)) __builtin_amdgcn_s_sleep(1);
            __builtin_amdgcn_fence(__ATOMIC_ACQUIRE, "agent");
        }
        __syncthreads();
        const float* gp = gfin; asm volatile("" : "+s"(gp));
#pragma unroll
        for (int ai = 0; ai < 2; ++ai)
#pragma unroll
            for (int m = 0; m < 4; ++m) {
                const float rstd = rsqrtf(__hip_atomic_load((rs + ai * 128 + m * 16) + lrow, __ATOMIC_RELAXED, __HIP_MEMORY_SCOPE_AGENT) * (1.f / DM) + EPS);
#pragma unroll
                for (int bj = 0; bj < 2; ++bj) { const f32x4 g0 = *(const f32x4*)(gp + col0 + bj * 128), g1 = *(const f32x4*)(gp + col0 + bj * 128 + 4);
                    float* ot = ob + (size_t)(ai * 128 + m * 16) * DM + bj * 128;
                    *(f32x4*)(ot + loff) = acc[ai][bj][m][0] * rstd * g0; *(f32x4*)(ot + 4 + loff) = acc[ai][bj][m][1] * rstd * g1; }
            }
    }
};

namespace att {
constexpr int D = 128, NW = 8, QBLK = 32, KVBLK = 64;
constexpr float SCALE = 0.088388347648318440f, THR = 8.f;
constexpr size_t SHM_V = KVBLK * D * 2, SHM_K = KVBLK * D * 2, SHM_ATTN = 2 * SHM_V + 2 * SHM_K + NW * 64 * 4;
#define KSWZ(row, colB) ((row) * 256 + ((colB) ^ (((row) & 7) << 4)))
#define SBAR() __builtin_amdgcn_sched_barrier(0)
__device__ __forceinline__ int crow(int r, int hi) { return (r & 3) + 8 * (r >> 2) + 4 * hi; }
__device__ __forceinline__ void partialSM(f32x16& p0, f32x16& p1, float& m_reg, float& mn, float& alpha) {
    constexpr float C = SCALE * 1.4426950408889634f;
    float pmax = p0[0];
#pragma unroll
    for (int r = 1; r < 16; ++r) pmax = fmaxf(pmax, p0[r]);
#pragma unroll
    for (int r = 0; r < 16; ++r) pmax = fmaxf(pmax, p1[r]);
    { auto rr = __builtin_amdgcn_permlane32_swap(__float_as_uint(pmax), __float_as_uint(pmax), false, false);
      pmax = fmaxf(__uint_as_float(rr[0]), __uint_as_float(rr[1])); }
    if (__builtin_expect(__all(pmax - m_reg <= THR / SCALE), 1)) { mn = m_reg; alpha = 1.f; }
    else { mn = fmaxf(m_reg, pmax); alpha = __builtin_amdgcn_exp2f((m_reg - mn) * C); m_reg = mn; }
    const float mnC = -mn * C;
#pragma unroll
    for (int r = 0; r < 16; ++r) p0[r] = fmaf(p0[r], C, mnC);
#pragma unroll
    for (int r = 0; r < 16; ++r) p1[r] = fmaf(p1[r], C, mnC);
#pragma unroll
    for (int r = 0; r < 16; ++r) p0[r] = __builtin_amdgcn_exp2f(p0[r]);
}
__device__ __forceinline__ void finishSM(f32x16& p0, f32x16& p1, float alpha, float& l_reg, bf16x8& pa0, bf16x8& pa1, bf16x8& pa2, bf16x8& pa3) {
#pragma unroll
    for (int r = 0; r < 16; ++r) p1[r] = __builtin_amdgcn_exp2f(p1[r]);
    float ps = 0;
#pragma unroll
    for (int r = 0; r < 16; ++r) ps += p0[r];
#pragma unroll
    for (int r = 0; r < 16; ++r) ps += p1[r];
    { auto rr = __builtin_amdgcn_permlane32_swap(__float_as_uint(ps), __float_as_uint(ps), false, false);
      ps = __uint_as_float(rr[0]) + __uint_as_float(rr[1]); }
    l_reg = l_reg * alpha + ps;
#define PK4(P, BASE, OUT) do { unsigned a0 = cvtpk(P[BASE + 0], P[BASE + 1]), a1 = cvtpk(P[BASE + 2], P[BASE + 3]);   \
    unsigned b0 = cvtpk(P[BASE + 4], P[BASE + 5]), b1 = cvtpk(P[BASE + 6], P[BASE + 7]);                              \
    auto r0 = __builtin_amdgcn_permlane32_swap(a0, b0, false, false); auto r1 = __builtin_amdgcn_permlane32_swap(a1, b1, false, false); \
    u32x4 w = {r0[0], r1[0], r0[1], r1[1]}; OUT = *reinterpret_cast<bf16x8*>(&w); } while (0)
    PK4(p0, 0, pa0); PK4(p0, 8, pa1); PK4(p1, 0, pa2); PK4(p1, 8, pa3);
#undef PK4
}
__device__ __forceinline__ void qkt(f32x16& p0, f32x16& p1, const bf16_t* Ks, const bf16x8* qr, int r32, int hi) {
    p0 = f32x16{}; p1 = f32x16{};
#pragma unroll
    for (int d0 = 0; d0 < 8; ++d0) { const int cb = (d0 * 16 + hi * 8) * 2;
        bf16x8 b0 = *reinterpret_cast<const bf16x8*>((const char*)Ks + KSWZ(r32, cb));
        bf16x8 b1 = *reinterpret_cast<const bf16x8*>((const char*)Ks + KSWZ(32 + r32, cb));
        p0 = __builtin_amdgcn_mfma_f32_32x32x16_bf16(b0, qr[d0], p0, 0, 0, 0);
        p1 = __builtin_amdgcn_mfma_f32_32x32x16_bf16(b1, qr[d0], p1, 0, 0, 0); }
}
__device__ __forceinline__ int v_st(int k, int c) { const int kk = (k & ~0xC) | ((k & 4) << 1) | ((k & 8) >> 1); return ((kk >> 3) * 4 + (c >> 5)) * 512 + ((kk & 7) * 32 + (c & 31)) * 2; }
__device__ __forceinline__ int v_rd_base(int lane) { return ((lane & 3) << 3) | (((lane >> 2) & 3) << 6) | (((lane >> 4) & 1) << 5) | (((lane >> 5) & 1) << 8); }
constexpr int v_rd_off(int d0, int ks, int half) { return d0 * 512 + ks * 4096 + half * 2048; }
template <int OFF> __device__ __forceinline__ s16x4 tr_read(int vb) {
    s16x4 r; asm volatile("ds_read_b64_tr_b16 %0, %1 offset:%2" : "=&v"(r) : "v"(vb), "i"(OFF) : "memory"); return r;
}
template <int D0> __device__ __forceinline__ void pv_one(f32x16& od, int vb, bf16x8 pa0, bf16x8 pa1, bf16x8 pa2, bf16x8 pa3) {
    const s16x4 l0 = tr_read<v_rd_off(D0, 0, 0)>(vb), h0 = tr_read<v_rd_off(D0, 0, 1)>(vb), l1 = tr_read<v_rd_off(D0, 1, 0)>(vb), h1 = tr_read<v_rd_off(D0, 1, 1)>(vb);
    const s16x4 l2 = tr_read<v_rd_off(D0, 2, 0)>(vb), h2 = tr_read<v_rd_off(D0, 2, 1)>(vb), l3 = tr_read<v_rd_off(D0, 3, 0)>(vb), h3 = tr_read<v_rd_off(D0, 3, 1)>(vb);
    asm volatile("s_waitcnt lgkmcnt(0)" ::: "memory"); SBAR();
#define PK(L, H) (bf16x8){L[0], L[1], L[2], L[3], H[0], H[1], H[2], H[3]}
    od = __builtin_amdgcn_mfma_f32_32x32x16_bf16(pa0, PK(l0, h0), od, 0, 0, 0);
    od = __builtin_amdgcn_mfma_f32_32x32x16_bf16(pa1, PK(l1, h1), od, 0, 0, 0);
    od = __builtin_amdgcn_mfma_f32_32x32x16_bf16(pa2, PK(l2, h2), od, 0, 0, 0);
    od = __builtin_amdgcn_mfma_f32_32x32x16_bf16(pa3, PK(l3, h3), od, 0, 0, 0);
#undef PK
}
__device__ __forceinline__ void pv_d0(f32x16* o, int vb, bf16x8 pa0, bf16x8 pa1, bf16x8 pa2, bf16x8 pa3) {
    pv_one<0>(o[0], vb, pa0, pa1, pa2, pa3); pv_one<1>(o[1], vb, pa0, pa1, pa2, pa3); pv_one<2>(o[2], vb, pa0, pa1, pa2, pa3); pv_one<3>(o[3], vb, pa0, pa1, pa2, pa3);
}


__device__ __forceinline__ void qkt_i8(f32x16& p0, f32x16& p1, const unsigned char* Ks, const i32x4* qi, const i32x16& cinit, int r32, int hi) {
    i32x16 a0, a1; const int sw = ((r32 >> 1) & 7) << 4;
#pragma unroll
    for (int m = 0; m < 4; ++m) { const int cb = m * 32 + hi * 16;
        const i32x4 b0 = *reinterpret_cast<const i32x4*>(Ks + r32 * 128 + (cb ^ sw));
        const i32x4 b1 = *reinterpret_cast<const i32x4*>(Ks + (32 + r32) * 128 + (cb ^ sw));
        if (m == 0) { a0 = __builtin_amdgcn_mfma_i32_32x32x32_i8(b0, qi[0], cinit, 0, 0, 0); a1 = __builtin_amdgcn_mfma_i32_32x32x32_i8(b1, qi[0], cinit, 0, 0, 0); }
        else { a0 = __builtin_amdgcn_mfma_i32_32x32x32_i8(b0, qi[m], a0, 0, 0, 0); a1 = __builtin_amdgcn_mfma_i32_32x32x32_i8(b1, qi[m], a1, 0, 0, 0); } }
    p0 = __builtin_bit_cast(f32x16, a0); p1 = __builtin_bit_cast(f32x16, a1);
}
__device__ __forceinline__ void partialSM_i8(f32x16& p0, f32x16& p1, float& m_reg, float& mn, float& alpha, float dq, float Cq, float Kq) {
    constexpr float C = SCALE * 1.4426950408889634f;
    float pmax = p0[0];
#pragma unroll
    for (int r = 1; r < 16; ++r) pmax = fmaxf(pmax, p0[r]);
#pragma unroll
    for (int r = 0; r < 16; ++r) pmax = fmaxf(pmax, p1[r]);
    { auto rr = __builtin_amdgcn_permlane32_swap(__float_as_uint(pmax), __float_as_uint(pmax), false, false);
      pmax = fmaxf(__uint_as_float(rr[0]), __uint_as_float(rr[1])); }
    const float pm = (pmax - 12582912.f) * dq;
    if (__builtin_expect(__all(pm - m_reg <= 4.f / SCALE), 1)) { mn = m_reg; alpha = 1.f; }
    else { mn = fmaxf(m_reg, pm); alpha = __builtin_amdgcn_exp2f((m_reg - mn) * C); m_reg = mn; }
    const float mnC = 3.f - (Kq + mn * C);
#pragma unroll
    for (int r = 0; r < 16; ++r) p0[r] = fmaf(p0[r], Cq, mnC);
#pragma unroll
    for (int r = 0; r < 16; ++r) p1[r] = fmaf(p1[r], Cq, mnC);
#pragma unroll
    for (int r = 0; r < 16; ++r) p0[r] = __builtin_amdgcn_exp2f(p0[r]);
}


typedef int i32x8 __attribute__((ext_vector_type(8)));
__device__ __forceinline__ void finishSM_f8(f32x16& p0, f32x16& p1, float alpha, float& l_reg, i32x8& pa8) {
#pragma unroll
    for (int r = 0; r < 16; ++r) p1[r] = __builtin_amdgcn_exp2f(p1[r]);
    float ps = 0;
#pragma unroll
    for (int r = 0; r < 16; ++r) ps += p0[r];
#pragma unroll
    for (int r = 0; r < 16; ++r) ps += p1[r];
    { auto rr = __builtin_amdgcn_permlane32_swap(__float_as_uint(ps), __float_as_uint(ps), false, false);
      ps = __uint_as_float(rr[0]) + __uint_as_float(rr[1]); }
    l_reg = l_reg * alpha + ps;
#pragma unroll
    for (int d = 0; d < 4; ++d) { int w = __builtin_amdgcn_cvt_pk_fp8_f32(p0[4 * d], p0[4 * d + 1], 0, false); pa8[d] = __builtin_amdgcn_cvt_pk_fp8_f32(p0[4 * d + 2], p0[4 * d + 3], w, true); }
#pragma unroll
    for (int d = 0; d < 4; ++d) { int w = __builtin_amdgcn_cvt_pk_fp8_f32(p1[4 * d], p1[4 * d + 1], 0, false); pa8[4 + d] = __builtin_amdgcn_cvt_pk_fp8_f32(p1[4 * d + 2], p1[4 * d + 3], w, true); }
}
__device__ __forceinline__ void pv8(f32x16* o, const unsigned char* Vs, i32x8 pa8, int r32, int hi) {
#pragma unroll
    for (int cb = 0; cb < 4; ++cb) { const int c = cb * 32 + r32, sw = (c >> 2) & 3;
        const u32x4 b0 = *(const u32x4*)(Vs + c * 64 + (((2 * hi) ^ sw) << 4)), b1 = *(const u32x4*)(Vs + c * 64 + (((2 * hi + 1) ^ sw) << 4));
        const i32x8 b8 = {(int)b0.x, (int)b0.y, (int)b0.z, (int)b0.w, (int)b1.x, (int)b1.y, (int)b1.z, (int)b1.w};
        o[cb] = __builtin_amdgcn_mfma_scale_f32_32x32x64_f8f6f4(pa8, b8, o[cb], 0, 0, 0, 0x7F7F7F7F, 0, 0x7F7F7F7F); }
}

template <int LDQ, int LDK>
__device__ __forceinline__ void attn_unit_i8(const bf16_t* Qb, const unsigned char* __restrict__ K8h, const unsigned char* __restrict__ V8h, const bf16_t* Gb, unsigned char* O8,
                                          int seq, char* lds, int t0, const float* __restrict__ qw, const float* __restrict__ cosT, const float* __restrict__ sinT, float sk, int wv) {
    const int tid = opaque_tid(wv), wid = __builtin_amdgcn_readfirstlane(tid >> 6), lane = tid & 63, r32 = lane & 31, hi = lane >> 5;
    unsigned char* V_lds = (unsigned char*)lds; unsigned char* K_lds = (unsigned char*)(lds + 16384);
    float* wsl = (float*)(lds + 65536) + wid * 64; float* li_l = wsl; float* al_l = wsl + 32;
    float m_reg = -1e30f, l_reg = 0; f32x16 o[4] = {}; i32x4 qi[4];
    const int kr = tid >> 3, kp = tid & 7, kst = kr * 128 + ((kp ^ ((kr >> 1) & 7)) << 4);
    struct { u32x4 vs, ks; } sr_[2];
#define SLOAD(i, k0) do { sr_[i].vs = *(const u32x4*)(V8h + (size_t)((k0) >> 6) * 16384 + tid * 16); \
    sr_[i].ks = *(const u32x4*)(K8h + (long)((k0) + kr) * 256 + kp * 16); } while (0)
#define SWRITE(b, i) do { *(u32x4*)(V_lds + (b) * 8192 + tid * 16) = sr_[i].vs; *(u32x4*)(K_lds + (b) * 8192 + kst) = sr_[i].ks; } while (0)
#define SWAIT() asm volatile("s_waitcnt vmcnt(2)" ::: "memory")
#define RESC(a) do { if (__any((a) < 1.f)) { if (hi == 0) al_l[r32] = (a); asm volatile("s_waitcnt lgkmcnt(0)" ::: "memory"); \
    _Pragma("unroll") for (int d = 0; d < 4; ++d) _Pragma("unroll") for (int r = 0; r < 16; ++r) o[d][r] *= al_l[crow(r, hi)]; } } while (0)
    f32x16 pA0, pA1, pB0, pB1; float mnA, mnB, alA, alB; i32x8 pa8; const int NT = seq / KVBLK;
    constexpr int SE = 0, SO = 1;
    SLOAD(SE, 0); SLOAD(SO, KVBLK);
    const bf16_t* Qw = Qb + (long)(wid * QBLK + r32) * LDQ + hi * 8;
    float dq, Cq, Kq; i32x16 cinit;
    {
        bf16x8 qraw[8];
#pragma unroll
        for (int d0 = 0; d0 < 8; ++d0) qraw[d0] = *reinterpret_cast<const bf16x8*>(Qw + d0 * 16);
        float ss = 0.f;
#pragma unroll
        for (int d0 = 0; d0 < 8; ++d0)
#pragma unroll
            for (int j = 0; j < 8; ++j) { const float x = bf2f((bf16_t)qraw[d0][j]); ss += x * x; }
        { auto rr = __builtin_amdgcn_permlane32_swap(__float_as_uint(ss), __float_as_uint(ss), false, false); ss = __uint_as_float(rr[0]) + __uint_as_float(rr[1]); }
        const float rstd = rsqrtf(ss * (1.f / 128.f) + EPS);
        const int t = t0 + wid * QBLK + r32;
        float xq[8][8]; float amax = 1e-20f;
#pragma unroll
        for (int d0 = 0; d0 < 8; ++d0) {
            const int pos = (d0 < 4) ? (t >> 6) : (t & 63);
            const f32x4 cs = *(const f32x4*)(cosT + pos * 32 + (d0 & 3) * 8 + hi * 4), sn = *(const f32x4*)(sinT + pos * 32 + (d0 & 3) * 8 + hi * 4);
            const f32x4 w0 = *(const f32x4*)(qw + d0 * 16 + hi * 8), w1 = *(const f32x4*)(qw + d0 * 16 + hi * 8 + 4);
            float x[8];
#pragma unroll
            for (int j = 0; j < 8; ++j) x[j] = bf2f((bf16_t)qraw[d0][j]) * rstd * (j < 4 ? w0[j] : w1[j - 4]);
#pragma unroll
            for (int pr = 0; pr < 4; ++pr) { xq[d0][2 * pr] = x[2 * pr] * cs[pr] - x[2 * pr + 1] * sn[pr]; xq[d0][2 * pr + 1] = x[2 * pr] * sn[pr] + x[2 * pr + 1] * cs[pr]; }
#pragma unroll
            for (int j = 0; j < 8; ++j) amax = fmaxf(amax, fabsf(xq[d0][j]));
        }
        { auto rr = __builtin_amdgcn_permlane32_swap(__float_as_uint(amax), __float_as_uint(amax), false, false); amax = fmaxf(__uint_as_float(rr[0]), __uint_as_float(rr[1])); }
        const float qinv = 127.f / amax;
        dq = amax * (1.f / 127.f) * sk; Cq = dq * (SCALE * 1.4426950408889634f); Kq = 12582912.f * Cq;
#pragma unroll
        for (int m = 0; m < 4; ++m) {
            unsigned w[4];
#pragma unroll
            for (int hf = 0; hf < 2; ++hf)
#pragma unroll
                for (int g4 = 0; g4 < 2; ++g4) { const float* xv = &xq[2 * m + hf][4 * g4];
                    const int a = (int)rintf(xv[0] * qinv), b = (int)rintf(xv[1] * qinv), c = (int)rintf(xv[2] * qinv), d = (int)rintf(xv[3] * qinv);
                    w[hf * 2 + g4] = (unsigned)(a & 255) | ((unsigned)(b & 255) << 8) | ((unsigned)(c & 255) << 16) | ((unsigned)d << 24); }
            qi[m] = (i32x4){(int)w[0], (int)w[1], (int)w[2], (int)w[3]};
        }
#pragma unroll
        for (int r = 0; r < 16; ++r) cinit[r] = 0x4B400000;
        asm volatile("" : "+v"(cinit));
    }
    asm volatile("s_waitcnt vmcnt(0)" ::: "memory"); SWRITE(0, SE); __syncthreads();
    qkt_i8(pA0, pA1, K_lds, qi, cinit, r32, hi); partialSM_i8(pA0, pA1, m_reg, mnA, alA, dq, Cq, Kq);
    SLOAD(SE, 2 * KVBLK);
    SWRITE(1, SO); __syncthreads();
    if (wid >= 4) __builtin_amdgcn_s_setprio(1);
    for (int j = 1; j + 1 < NT; j += 2) {
        SBAR(); qkt_i8(pB0, pB1, K_lds + 8192, qi, cinit, r32, hi);
        finishSM_f8(pA0, pA1, alA, l_reg, pa8); SBAR();
        SLOAD(SO, (j + 2) * KVBLK); SBAR();
        pv8(o, V_lds, pa8, r32, hi); partialSM_i8(pB0, pB1, m_reg, mnB, alB, dq, Cq, Kq);
        __syncthreads(); SWAIT(); SWRITE(0, SE);
        RESC(alB); __syncthreads();
        SBAR(); qkt_i8(pA0, pA1, K_lds, qi, cinit, r32, hi);
        finishSM_f8(pB0, pB1, alB, l_reg, pa8); SBAR();
        SLOAD(SE, (j + 3) * KVBLK); SBAR();
        pv8(o, V_lds + 8192, pa8, r32, hi); partialSM_i8(pA0, pA1, m_reg, mnA, alA, dq, Cq, Kq);
        __syncthreads(); SWAIT(); SWRITE(1, SO);
        RESC(alA); __syncthreads();
    }
    SBAR(); qkt_i8(pB0, pB1, K_lds + 8192, qi, cinit, r32, hi);
    finishSM_f8(pA0, pA1, alA, l_reg, pa8); SBAR();
    pv8(o, V_lds, pa8, r32, hi); partialSM_i8(pB0, pB1, m_reg, mnB, alB, dq, Cq, Kq);
    __syncthreads(); RESC(alB);
    finishSM_f8(pB0, pB1, alB, l_reg, pa8); SBAR();
    pv8(o, V_lds + 8192, pa8, r32, hi);
    __builtin_amdgcn_s_setprio(0);
    int l2; asm volatile("v_mbcnt_lo_u32_b32 %0, -1, 0\n\tv_mbcnt_hi_u32_b32 %0, -1, %0" : "=v"(l2));
    const int hi2 = l2 >> 5, r322 = l2 & 31;
    if (hi2 == 0) li_l[r322] = l_reg; asm volatile("s_waitcnt lgkmcnt(0)" ::: "memory");
    float rli[16];
#pragma unroll
    for (int r = 0; r < 16; ++r) rli[r] = __builtin_amdgcn_rcpf(li_l[crow(r, hi2)]);
    unsigned char* O8w = O8 + (long)(wid * QBLK) * LDQ; const bf16_t* Gw = Gb + (long)(wid * QBLK) * LDQ;
    constexpr float osc = (LDQ == 1024) ? 64.f : 16.f;
    __syncthreads();
    bf16_t* stg = (bf16_t*)lds + wid * 4096;
#pragma unroll
    for (int r = 0; r < 16; ++r) { const int orow = crow(r, hi2);
#pragma unroll
        for (int d0 = 0; d0 < 4; ++d0) stg[orow * 128 + d0 * 32 + r322] = (bf16_t)(cvtpk(o[d0][r] * rli[r], 0.f) & 0xffffu); }
    asm volatile("s_waitcnt lgkmcnt(0)" ::: "memory");
    const unsigned lo2 = (unsigned)((l2 >> 4) * LDQ + (l2 & 15) * 8);
    u32x4 gv[8], ov[8];
#pragma unroll
    for (int i = 0; i < 8; ++i) gv[i] = *(const u32x4*)((Gw + i * 4 * LDQ) + lo2);
#pragma unroll
    for (int i = 0; i < 8; ++i) ov[i] = *(const u32x4*)(stg + (i * 4 + (l2 >> 4)) * 128 + (l2 & 15) * 8);
#pragma unroll
    for (int i = 0; i < 8; ++i) {
        int w0 = __builtin_amdgcn_cvt_pk_fp8_f32(bflo(ov[i].x) * bflo(gv[i].x) * osc, bfhi(ov[i].x) * bfhi(gv[i].x) * osc, 0, false);
        w0 = __builtin_amdgcn_cvt_pk_fp8_f32(bflo(ov[i].y) * bflo(gv[i].y) * osc, bfhi(ov[i].y) * bfhi(gv[i].y) * osc, w0, true);
        int w1 = __builtin_amdgcn_cvt_pk_fp8_f32(bflo(ov[i].z) * bflo(gv[i].z) * osc, bfhi(ov[i].z) * bfhi(gv[i].z) * osc, 0, false);
        w1 = __builtin_amdgcn_cvt_pk_fp8_f32(bflo(ov[i].w) * bflo(gv[i].w) * osc, bfhi(ov[i].w) * bfhi(gv[i].w) * osc, w1, true);
        *(u32x2*)((O8w + i * 4 * LDQ) + lo2) = (u32x2){(unsigned)w0, (unsigned)w1}; }
    __syncthreads();
#undef SLOAD
#undef SWRITE
#undef SWAIT
#undef RESC
}

template <bool ROPE, int LDQ, int LDK>
__device__ __forceinline__ void attn_unit(const bf16_t* Qb, const bf16_t* __restrict__ Kh, const bf16_t* __restrict__ Vh, const bf16_t* Gb, unsigned char* O8,
                                          int seq, char* lds, int t0, const float* __restrict__ qw, const float* __restrict__ cosT, const float* __restrict__ sinT, int wv) {
    const int tid = opaque_tid(wv), wid = __builtin_amdgcn_readfirstlane(tid >> 6), lane = tid & 63, r32 = lane & 31, hi = lane >> 5;
    bf16_t* V_lds = (bf16_t*)lds; bf16_t* K_lds = (bf16_t*)(lds + 2 * SHM_V);
    float* wsl = (float*)(lds + 2 * SHM_V + 2 * SHM_K) + wid * 64; float* li_l = wsl; float* al_l = wsl + 32;
    float m_reg = -1e30f, l_reg = 0; f32x16 o[4] = {}; bf16x8 qr[8];
    const int sr = tid >> 4, sc = (tid & 15) * 8, vst0 = v_st(sr, sc), vst1 = v_st(32 + sr, sc);
    const int vb0 = (int)(uintptr_t)V_lds + v_rd_base(lane);
    struct { bf16x8 vs0, vs1, ks0, ks1; } sr_[2];
#define SLOAD(i, k0) do { sr_[i].vs0 = *(const bf16x8*)(&Vh[(long)((k0) + sr) * LDK + sc]); sr_[i].vs1 = *(const bf16x8*)(&Vh[(long)((k0) + 32 + sr) * LDK + sc]); \
    sr_[i].ks0 = *(const bf16x8*)(&Kh[(long)((k0) + sr) * LDK + sc]); sr_[i].ks1 = *(const bf16x8*)(&Kh[(long)((k0) + 32 + sr) * LDK + sc]); } while (0)
#define SWRITE(b, i) do { *(bf16x8*)((char*)V_lds + (b) * SHM_V + vst0) = sr_[i].vs0;          \
    *(bf16x8*)((char*)V_lds + (b) * SHM_V + vst1) = sr_[i].vs1; int kc = sc * 2;               \
    *(bf16x8*)((char*)K_lds + (b) * SHM_K + KSWZ(sr, kc)) = sr_[i].ks0;                       \
    *(bf16x8*)((char*)K_lds + (b) * SHM_K + KSWZ(32 + sr, kc)) = sr_[i].ks1; } while (0)
#define SWAIT() asm volatile("s_waitcnt vmcnt(4)" ::: "memory")
#define RESC(a) do { if (__any((a) < 1.f)) { if (hi == 0) al_l[r32] = (a); asm volatile("s_waitcnt lgkmcnt(0)" ::: "memory"); \
    _Pragma("unroll") for (int d = 0; d < 4; ++d) _Pragma("unroll") for (int r = 0; r < 16; ++r) o[d][r] *= al_l[crow(r, hi)]; } } while (0)
    f32x16 pA0, pA1, pB0, pB1; float mnA, mnB, alA, alB; bf16x8 pa0, pa1, pa2, pa3; const int NT = seq / KVBLK;
    constexpr int SE = 0, SO = 1;
    SLOAD(SE, 0); SLOAD(SO, KVBLK);
    const bf16_t* Qw = Qb + (long)(wid * QBLK + r32) * LDQ + hi * 8;
#pragma unroll
    for (int d0 = 0; d0 < 8; ++d0) qr[d0] = *reinterpret_cast<const bf16x8*>(Qw + d0 * 16);
    if constexpr (ROPE) {
        float ss = 0.f;
#pragma unroll
        for (int d0 = 0; d0 < 8; ++d0)
#pragma unroll
            for (int j = 0; j < 8; ++j) { const float x = bf2f((bf16_t)qr[d0][j]); ss += x * x; }
        { auto rr = __builtin_amdgcn_permlane32_swap(__float_as_uint(ss), __float_as_uint(ss), false, false); ss = __uint_as_float(rr[0]) + __uint_as_float(rr[1]); }
        const float rstd = rsqrtf(ss * (1.f / 128.f) + EPS);
        const int t = t0 + wid * QBLK + r32;
#pragma unroll
        for (int d0 = 0; d0 < 8; ++d0) {
            const int pos = (d0 < 4) ? (t >> 6) : (t & 63);
            const f32x4 cs = *(const f32x4*)(cosT + pos * 32 + (d0 & 3) * 8 + hi * 4), sn = *(const f32x4*)(sinT + pos * 32 + (d0 & 3) * 8 + hi * 4);
            const f32x4 w0 = *(const f32x4*)(qw + d0 * 16 + hi * 8), w1 = *(const f32x4*)(qw + d0 * 16 + hi * 8 + 4);
            float x[8];
#pragma unroll
            for (int j = 0; j < 8; ++j) x[j] = bf2f((bf16_t)qr[d0][j]) * rstd * (j < 4 ? w0[j] : w1[j - 4]);
            u32x4 w;
            w.x = cvtpk(x[0] * cs[0] - x[1] * sn[0], x[0] * sn[0] + x[1] * cs[0]);
            w.y = cvtpk(x[2] * cs[1] - x[3] * sn[1], x[2] * sn[1] + x[3] * cs[1]);
            w.z = cvtpk(x[4] * cs[2] - x[5] * sn[2], x[4] * sn[2] + x[5] * cs[2]);
            w.w = cvtpk(x[6] * cs[3] - x[7] * sn[3], x[6] * sn[3] + x[7] * cs[3]);
            qr[d0] = *reinterpret_cast<bf16x8*>(&w);
        }
    }
    asm volatile("s_waitcnt vmcnt(0)" ::: "memory"); SWRITE(0, SE); __syncthreads();
    qkt(pA0, pA1, K_lds, qr, r32, hi); partialSM(pA0, pA1, m_reg, mnA, alA);
    SLOAD(SE, 2 * KVBLK);
    SWRITE(1, SO); __syncthreads();
    if (wid >= 4) __builtin_amdgcn_s_setprio(1);
    for (int j = 1; j + 1 < NT; j += 2) {
        SBAR(); qkt(pB0, pB1, (bf16_t*)((char*)K_lds + SHM_K), qr, r32, hi);
        finishSM(pA0, pA1, alA, l_reg, pa0, pa1, pa2, pa3); SBAR();
        SLOAD(SO, (j + 2) * KVBLK); SBAR();
        pv_d0(o, vb0, pa0, pa1, pa2, pa3); partialSM(pB0, pB1, m_reg, mnB, alB);
        __syncthreads(); SWAIT(); SWRITE(0, SE);
        RESC(alB); __syncthreads();
        SBAR(); qkt(pA0, pA1, K_lds, qr, r32, hi);
        finishSM(pB0, pB1, alB, l_reg, pa0, pa1, pa2, pa3); SBAR();
        SLOAD(SE, (j + 3) * KVBLK); SBAR();
        pv_d0(o, vb0 + (int)SHM_V, pa0, pa1, pa2, pa3); partialSM(pA0, pA1, m_reg, mnA, alA);
        __syncthreads(); SWAIT(); SWRITE(1, SO);
        RESC(alA); __syncthreads();
    }
    SBAR(); qkt(pB0, pB1, (bf16_t*)((char*)K_lds + SHM_K), qr, r32, hi);
    finishSM(pA0, pA1, alA, l_reg, pa0, pa1, pa2, pa3); SBAR();
    pv_d0(o, vb0, pa0, pa1, pa2, pa3); partialSM(pB0, pB1, m_reg, mnB, alB);
    __syncthreads(); RESC(alB);
    finishSM(pB0, pB1, alB, l_reg, pa0, pa1, pa2, pa3); SBAR();
    pv_d0(o, vb0 + (int)SHM_V, pa0, pa1, pa2, pa3);
    __builtin_amdgcn_s_setprio(0);
    int l2; asm volatile("v_mbcnt_lo_u32_b32 %0, -1, 0\n\tv_mbcnt_hi_u32_b32 %0, -1, %0" : "=v"(l2));
    const int hi2 = l2 >> 5, r322 = l2 & 31;
    if (hi2 == 0) li_l[r322] = l_reg; asm volatile("s_waitcnt lgkmcnt(0)" ::: "memory");
    float rli[16];
#pragma unroll
    for (int r = 0; r < 16; ++r) rli[r] = __builtin_amdgcn_rcpf(li_l[crow(r, hi2)]);
    unsigned char* O8w = O8 + (long)(wid * QBLK) * LDQ; const bf16_t* Gw = Gb + (long)(wid * QBLK) * LDQ;
    constexpr float osc = (LDQ == 1024) ? 64.f : 16.f;
    __syncthreads();
    bf16_t* stg = (bf16_t*)lds + wid * 4096;
#pragma unroll
    for (int r = 0; r < 16; ++r) { const int orow = crow(r, hi2);
#pragma unroll
        for (int d0 = 0; d0 < 4; ++d0) stg[orow * 128 + d0 * 32 + r322] = (bf16_t)(cvtpk(o[d0][r] * rli[r], 0.f) & 0xffffu); }
    asm volatile("s_waitcnt lgkmcnt(0)" ::: "memory");
    const unsigned lo2 = (unsigned)((l2 >> 4) * LDQ + (l2 & 15) * 8);
    u32x4 gv[8], ov[8];
#pragma unroll
    for (int i = 0; i < 8; ++i) gv[i] = *(const u32x4*)((Gw + i * 4 * LDQ) + lo2);
#pragma unroll
    for (int i = 0; i < 8; ++i) ov[i] = *(const u32x4*)(stg + (i * 4 + (l2 >> 4)) * 128 + (l2 & 15) * 8);
#pragma unroll
    for (int i = 0; i < 8; ++i) {
        int w0 = __builtin_amdgcn_cvt_pk_fp8_f32(bflo(ov[i].x) * bflo(gv[i].x) * osc, bfhi(ov[i].x) * bfhi(gv[i].x) * osc, 0, false);
        w0 = __builtin_amdgcn_cvt_pk_fp8_f32(bflo(ov[i].y) * bflo(gv[i].y) * osc, bfhi(ov[i].y) * bfhi(gv[i].y) * osc, w0, true);
        int w1 = __builtin_amdgcn_cvt_pk_fp8_f32(bflo(ov[i].z) * bflo(gv[i].z) * osc, bfhi(ov[i].z) * bfhi(gv[i].z) * osc, 0, false);
        w1 = __builtin_amdgcn_cvt_pk_fp8_f32(bflo(ov[i].w) * bflo(gv[i].w) * osc, bfhi(ov[i].w) * bfhi(gv[i].w) * osc, w1, true);
        *(u32x2*)((O8w + i * 4 * LDQ) + lo2) = (u32x2){(unsigned)w0, (unsigned)w1}; }
    __syncthreads();
#undef SLOAD
#undef SWRITE
#undef SWAIT
#undef RESC
}
#undef KSWZ
#undef SBAR
}

struct Params {
    const float* in[25];
    float* out; unsigned char* ws;
};

__device__ __forceinline__ void transpose_item(const float* __restrict__ W, int K, int N, bf16_t* __restrict__ WT, LAS float* scr, int item, int lane) {
    const int nblk = N / 32, kb = item / nblk, nb = item % nblk, k0 = 64 * kb, n0 = 32 * nb;
#pragma unroll 8
    for (int i = 0; i < 32; ++i) { const int kk = 2 * i + (lane >> 5); scr[kk * 33 + (lane & 31)] = W[(size_t)(k0 + kk) * N + n0 + (lane & 31)]; }
    asm volatile("s_waitcnt lgkmcnt(0)" ::: "memory");
    const int c = lane & 7;
#pragma unroll
    for (int j = 0; j < 4; ++j) { const int n = (lane >> 3) + 8 * j; const LAS float* s = scr + (8 * c) * 33 + n;
        u32x4 o; o.x = cvtpk(s[0 * 33], s[1 * 33]); o.y = cvtpk(s[2 * 33], s[3 * 33]); o.z = cvtpk(s[4 * 33], s[5 * 33]); o.w = cvtpk(s[6 * 33], s[7 * 33]);
        *(u32x4*)(WT + (size_t)(n0 + n) * K + k0 + 8 * c) = o; }
    asm volatile("s_waitcnt lgkmcnt(0)" ::: "memory");
}
__device__ __forceinline__ void rms_row_bf16(const float* __restrict__ xrow, const float* __restrict__ g, bf16_t* __restrict__ orow, int lane) {
    const f32x4* xr = (const f32x4*)xrow + lane; f32x4 v[4]; float s = 0.f;
#pragma unroll
    for (int j = 0; j < 4; ++j) { v[j] = xr[64 * j]; s += (v[j].x * v[j].x + v[j].y * v[j].y) + (v[j].z * v[j].z + v[j].w * v[j].w); }
    const float rstd = rsqrtf(wave_sum(s) * (1.f / DM) + EPS);
    u32x2* o8 = (u32x2*)orow + lane;
#pragma unroll
    for (int j = 0; j < 4; ++j) { const f32x4 gw = ((const f32x4*)g)[lane + 64 * j]; u32x2 w; w.x = cvtpk(v[j].x * rstd * gw.x, v[j].y * rstd * gw.y); w.y = cvtpk(v[j].z * rstd * gw.z, v[j].w * rstd * gw.w); o8[64 * j] = w; }
}

#ifndef PHMASK
#define PHMASK 0xFFF
#endif
#define PHON(n) (((PHMASK) >> (n)) & 1)
__global__ void __launch_bounds__(512, 2) hybrid_fwd(Params P) {
    extern __shared__ __attribute__((aligned(16))) unsigned char lds[];
    cg::grid_group grid = cg::this_grid();
    LAS unsigned char* ldsl = (LAS unsigned char*)lds;
    const int G = gridDim.x, bid = blockIdx.x, wv = __builtin_amdgcn_readfirstlane(threadIdx.x >> 6);
    const int vcu = (G % 8 == 0) ? (bid % 8) * (G / 8) + bid / 8 : bid;
    const int NGW = G * 8; const long NGT = (long)G * 512;
#ifndef PROBE
#define PROBE 0
#endif
#define PROBE_A0 10
#define PROBE_A1 11
#define PROBE_B0 8
#define PROBE_B1 9
#define STAMP(k) do { if (PROBE) { if (bid == 0 && opaque_tid(wv) == 0) ((unsigned long long*)(ws + 768 * 1024))[k] = __builtin_amdgcn_s_memrealtime(); } } while (0)
#define PHASE_IDS const int tid = opaque_tid(wv), lane = tid & 63, wave = __builtin_amdgcn_readfirstlane(tid >> 6), gw = bid * 8 + wave; const long gtid = (long)bid * 512 + tid; (void)lane; (void)gw; (void)gtid;
    unsigned char* ws = P.ws; unsigned char* dob = (unsigned char*)P.out;
    const float* xp = P.in[0]; const float* xs = P.in[1];
    const float *a_re = P.in[8], *a_im = P.in[9], *b_re = P.in[10], *b_im = P.in[11], *c_re = P.in[12], *c_im = P.in[13], *lstep = P.in[14], *s5d = P.in[15];
    float* cosT = (float*)(ws + WS_COS); float* sinT = (float*)(ws + WS_SIN); float* KT = (float*)(ws + WS_KT);
    bf16_t* WIN = (bf16_t*)(ws + WS_WIN); bf16_t* XN = (bf16_t*)(ws + WS_XN);
#define XN8 (dob + DO_XN8)
#define XS ((float*)(ws + WS_XS))
#define W8 (ws + WS_W8)
#define WSC ((float*)(ws + WS_WSC))
    bf16_t* AG = (bf16_t*)(dob + DO_AG); bf16_t* WG = (bf16_t*)(dob + DO_WG); bf16_t* WE = (bf16_t*)(dob + DO_WE); float* EC = (float*)(dob + DO_EC);

    STAMP(0);
    if constexpr (PHON(0))
    {
        PHASE_IDS
        LAS float* scr = (LAS float*)(ldsl + wave * 16384);
        constexpr int I_IN = 16 * 240, I_MKV = 16 * 32, I_PA = 16 * 32, I_PS = 8 * 32, I_PX = 8 * 32, I_OUT = 16 * 32, I_GLU = 8 * 16;
        constexpr int NITEMS = I_IN + I_MKV + I_PA + I_PS + I_PX + I_OUT + I_GLU;
        for (int it = gw; it < NITEMS; it += NGW) {
            int r = it;
            if (r < I_IN) { transpose_item(P.in[5], 1024, 7680, WIN, scr, r, lane); continue; } r -= I_IN;
            if (r < I_MKV) { transpose_item(P.in[19], 1024, 1024, (bf16_t*)(ws + WS_WMKV), scr, r, lane); continue; } r -= I_MKV;
            if (r < I_PA) { transpose_item(P.in[20], 1024, 1024, (bf16_t*)(ws + WS_WPA), scr, r, lane); continue; } r -= I_PA;
            if (r < I_PS) { transpose_item(P.in[21], 512, 1024, (bf16_t*)(ws + WS_WPS), scr, r, lane); continue; } r -= I_PS;
            if (r < I_PX) { transpose_item(P.in[22], 512, 1024, (bf16_t*)(ws + WS_WPX), scr, r, lane); continue; } r -= I_PX;
            if (r < I_OUT) { transpose_item(P.in[23], 1024, 1024, (bf16_t*)(ws + WS_WOUT), scr, r, lane); continue; } r -= I_OUT;
            transpose_item(P.in[16], 512, 512, (bf16_t*)(ws + WS_WGLU), scr, r, lane);
        }
        for (int m = gw; m < NTOK; m += 2 * NGW) {
            const int m2 = m + NGW; const bool has2 = m2 < NTOK;
            const f32x4* xa = (const f32x4*)(m < NPROMPT ? xp + (size_t)m * DM : xs + (size_t)(m - NPROMPT) * DM) + lane;
            const f32x4* xb2 = (const f32x4*)(!has2 ? xp : (m2 < NPROMPT ? xp + (size_t)m2 * DM : xs + (size_t)(m2 - NPROMPT) * DM)) + lane;
            f32x4 va[4], vb[4]; float sa = 0.f, sb = 0.f;
#pragma unroll
            for (int j = 0; j < 4; ++j) { va[j] = xa[64 * j]; vb[j] = xb2[64 * j]; }
#pragma unroll
            for (int j = 0; j < 4; ++j) { sa += (va[j].x * va[j].x + va[j].y * va[j].y) + (va[j].z * va[j].z + va[j].w * va[j].w); sb += (vb[j].x * vb[j].x + vb[j].y * vb[j].y) + (vb[j].z * vb[j].z + vb[j].w * vb[j].w); }
#pragma unroll
            for (int o = 1; o < 64; o <<= 1) { sa += __shfl_xor(sa, o); sb += __shfl_xor(sb, o); }
            const float ra = rsqrtf(sa * (1.f / DM) + EPS), rb = rsqrtf(sb * (1.f / DM) + EPS);
            u32x2* oa = (u32x2*)(XN + (size_t)m * DM) + lane; u32x2* ob2 = (u32x2*)(XN + (size_t)(has2 ? m2 : m) * DM) + lane;
            float ma = 1e-20f, mb = 1e-20f;
#pragma unroll
            for (int j = 0; j < 4; ++j) { const f32x4 gwt = ((const f32x4*)P.in[4])[lane + 64 * j];
                va[j] = va[j] * ra * gwt; vb[j] = vb[j] * rb * gwt;
                u32x2 w; w.x = cvtpk(va[j].x, va[j].y); w.y = cvtpk(va[j].z, va[j].w); oa[64 * j] = w;
                if (has2) { u32x2 w2; w2.x = cvtpk(vb[j].x, vb[j].y); w2.y = cvtpk(vb[j].z, vb[j].w); ob2[64 * j] = w2; }
                ma = fmaxf(fmaxf(ma, fmaxf(fabsf(va[j].x), fabsf(va[j].y))), fmaxf(fabsf(va[j].z), fabsf(va[j].w)));
                mb = fmaxf(fmaxf(mb, fmaxf(fabsf(vb[j].x), fabsf(vb[j].y))), fmaxf(fabsf(vb[j].z), fabsf(vb[j].w))); }
#pragma unroll
            for (int o = 1; o < 64; o <<= 1) { ma = fmaxf(ma, __shfl_xor(ma, o)); mb = fmaxf(mb, __shfl_xor(mb, o)); }
            const float ia = 127.f / ma, ib = 127.f / mb;
            unsigned* q8a = (unsigned*)(XN8 + (size_t)m * DM) + lane; unsigned* q8b = (unsigned*)(XN8 + (size_t)(has2 ? m2 : m) * DM) + lane;
#pragma unroll
            for (int j = 0; j < 4; ++j) {
                q8a[64 * j] = (unsigned)((int)rintf(va[j].x * ia) & 255) | ((unsigned)((int)rintf(va[j].y * ia) & 255) << 8) | ((unsigned)((int)rintf(va[j].z * ia) & 255) << 16) | ((unsigned)(int)rintf(va[j].w * ia) << 24);
                if (has2) q8b[64 * j] = (unsigned)((int)rintf(vb[j].x * ib) & 255) | ((unsigned)((int)rintf(vb[j].y * ib) & 255) << 8) | ((unsigned)((int)rintf(vb[j].z * ib) & 255) << 16) | ((unsigned)(int)rintf(vb[j].w * ib) << 24); }
            if (lane == 0) { XS[m] = ma * (1.f / 127.f); if (has2) XS[m2] = mb * (1.f / 127.f); }
        }
        for (int r = gw; r < NMEMROWS; r += NGW) rms_row_bf16(r < 2048 ? P.in[2] + (size_t)r * DM : P.in[3] + (size_t)(r - 2048) * DM, P.in[18], (bf16_t*)(ws + WS_MN) + (size_t)r * DM, lane);
        for (long i = gtid; i < 256 * 32; i += NGT) { const int pos = (int)(i >> 5), j = (int)(i & 31);
            const float freq = exp2f(-(float)j * (13.287712379549449f / 32.f)); const float ang = (float)pos * freq; float c, s; cexp_turns(ang * 0.15915494309189535f, c, s); cosT[i] = c; sinT[i] = s; }
        for (long i = gtid; i < NTOK; i += NGT) ((float*)(ws + WS_RSS))[i] = 0.f;
        if (gtid < 320) ((unsigned*)(ws + WS_CNT))[gtid] = 0u;
        {
            LAS float* bp = (LAS float*)(ldsl + wave * 16384);
            for (int wi = wave * G + bid; wi < 4096; wi += NGW) {
                const int dg = wi >> 6, tau = wi & 63, n = lane;
                const float dt = __expf(lstep[dg]); const float are = fminf(a_re[dg * 64 + n], -1e-4f), aim = a_im[dg * 64 + n];
                float cr, ci; zoh_coef(are, aim, dt, cr, ci); float pr, pi; lam_pow(are, aim, dt, (float)tau, pr, pi);
                const float qr_ = pr * cr - pi * ci, qi_ = pr * ci + pi * cr;
                const float* brp = b_re + (size_t)(dg * 64 + n) * 16; const float* bip = b_im + (size_t)(dg * 64 + n) * 16;
#pragma unroll
                for (int c4 = 0; c4 < 4; ++c4) { const f32x4 br = *(const f32x4*)(brp + 4 * c4), bi = *(const f32x4*)(bip + 4 * c4);
                    *(LAS f32x4*)(bp + n * 36 + 4 * c4) = qr_ * br - qi_ * bi; *(LAS f32x4*)(bp + n * 36 + 16 + 4 * c4) = qr_ * bi + qi_ * br; }
                asm volatile("s_waitcnt lgkmcnt(0)" ::: "memory");
                const int ch = lane >> 2, cq = (lane & 3) * 4;
                const float* crp = c_re + (size_t)(dg * 16 + ch) * 64; const float* cip = c_im + (size_t)(dg * 16 + ch) * 64;
                f32x4 acc = {0.f, 0.f, 0.f, 0.f};
#pragma unroll 4
                for (int n4 = 0; n4 < 16; ++n4) { const f32x4 c_r = *(const f32x4*)(crp + 4 * n4), c_i = *(const f32x4*)(cip + 4 * n4);
#pragma unroll
                    for (int e = 0; e < 4; ++e) { const int nn = 4 * n4 + e; const f32x4 bre = *(const LAS f32x4*)(bp + nn * 36 + cq), bim = *(const LAS f32x4*)(bp + nn * 36 + 16 + cq);
                        acc += c_r[e] * bre - c_i[e] * bim; } }
                *(f32x4*)(KT + ((size_t)(dg * 64 + tau) * 16 + ch) * 16 + cq) = acc;
                asm volatile("s_waitcnt lgkmcnt(0)" ::: "memory");
            }
        }
        for (long idx = gtid; idx < 32 * 256 * 64; idx += NGT) {
            const int j = (int)(idx & 63), col = (int)((idx >> 6) & 255), g = (int)(idx >> 14), dir = col >> 7, part = (col >> 6) & 1, n = col & 63, dg = dir * 32 + g;
            const float dt = __expf(lstep[dg]); const float are = fminf(a_re[dg * 64 + n], -1e-4f), aim = a_im[dg * 64 + n];
            float cr, ci; zoh_coef(are, aim, dt, cr, ci); float pr, pi; lam_pow(are, aim, dt, (float)(dir ? j : 63 - j), pr, pi);
            const float qr_ = pr * cr - pi * ci, qi_ = pr * ci + pi * cr;
            float v[16];
#pragma unroll
            for (int c = 0; c < 16; ++c) { const float br = b_re[(dg * 64 + n) * 16 + c], bi = b_im[(dg * 64 + n) * 16 + c]; v[c] = part ? (qr_ * bi + qi_ * br) : (qr_ * br - qi_ * bi); }
            u32x4 w0, w1; w0.x = cvtpk(v[0], v[1]); w0.y = cvtpk(v[2], v[3]); w0.z = cvtpk(v[4], v[5]); w0.w = cvtpk(v[6], v[7]);
            w1.x = cvtpk(v[8], v[9]); w1.y = cvtpk(v[10], v[11]); w1.z = cvtpk(v[12], v[13]); w1.w = cvtpk(v[14], v[15]);
            bf16_t* d = WE + ((size_t)(g * 256 + col)) * 1024 + j * 16; *(u32x4*)d = w0; *(u32x4*)(d + 8) = w1;
        }
    }
    __syncthreads();
    grid.sync();
    STAMP(1);

    if constexpr (PHON(1))
    {
        PHASE_IDS
        for (int r = gw; r < 5632; r += NGW) {
            const int rsrc = r < 2560 ? r : (r < 4608 ? r + 1024 : r + 2048);
            const u32x4* src = (const u32x4*)(WIN + (size_t)rsrc * 1024) + 2 * lane; const u32x4 a = src[0], b = src[1];
            float v[16]; v[0] = bflo(a.x); v[1] = bfhi(a.x); v[2] = bflo(a.y); v[3] = bfhi(a.y); v[4] = bflo(a.z); v[5] = bfhi(a.z); v[6] = bflo(a.w); v[7] = bfhi(a.w);
            v[8] = bflo(b.x); v[9] = bfhi(b.x); v[10] = bflo(b.y); v[11] = bfhi(b.y); v[12] = bflo(b.z); v[13] = bfhi(b.z); v[14] = bflo(b.w); v[15] = bfhi(b.w);
            float mx = 1e-30f;
#pragma unroll
            for (int j = 0; j < 16; ++j) mx = fmaxf(mx, fabsf(v[j]));
#pragma unroll
            for (int o = 1; o < 64; o <<= 1) mx = fmaxf(mx, __shfl_xor(mx, o));
            const float inv = 127.f / mx; unsigned w[4];
#pragma unroll
            for (int q = 0; q < 4; ++q) w[q] = (unsigned)((int)rintf(v[4 * q] * inv) & 255) | ((unsigned)((int)rintf(v[4 * q + 1] * inv) & 255) << 8) | ((unsigned)((int)rintf(v[4 * q + 2] * inv) & 255) << 16) | ((unsigned)(int)rintf(v[4 * q + 3] * inv) << 24);
            *((u32x4*)(W8 + (size_t)r * 1024) + lane) = (u32x4){w[0], w[1], w[2], w[3]};
            if (lane == 0) WSC[r] = mx * (1.f / 127.f);
        }
    }
    {
        PHASE_IDS
        for (int r = gw; r < 2048; r += NGW) {
            if (r < 1024) { const u32x4* src = (const u32x4*)((const bf16_t*)(ws + WS_WPA) + (size_t)r * 1024) + 2 * lane; const u32x4 a = src[0], b = src[1];
                int w0 = __builtin_amdgcn_cvt_pk_fp8_f32(bflo(a.x) * 32.f, bfhi(a.x) * 32.f, 0, false); w0 = __builtin_amdgcn_cvt_pk_fp8_f32(bflo(a.y) * 32.f, bfhi(a.y) * 32.f, w0, true);
                int w1 = __builtin_amdgcn_cvt_pk_fp8_f32(bflo(a.z) * 32.f, bfhi(a.z) * 32.f, 0, false); w1 = __builtin_amdgcn_cvt_pk_fp8_f32(bflo(a.w) * 32.f, bfhi(a.w) * 32.f, w1, true);
                int w2 = __builtin_amdgcn_cvt_pk_fp8_f32(bflo(b.x) * 32.f, bfhi(b.x) * 32.f, 0, false); w2 = __builtin_amdgcn_cvt_pk_fp8_f32(bflo(b.y) * 32.f, bfhi(b.y) * 32.f, w2, true);
                int w3 = __builtin_amdgcn_cvt_pk_fp8_f32(bflo(b.z) * 32.f, bfhi(b.z) * 32.f, 0, false); w3 = __builtin_amdgcn_cvt_pk_fp8_f32(bflo(b.w) * 32.f, bfhi(b.w) * 32.f, w3, true);
                *((u32x4*)(ws + WS_WPA8 + (size_t)r * 1024) + lane) = (u32x4){(unsigned)w0, (unsigned)w1, (unsigned)w2, (unsigned)w3}; }
            else { const int rr = r - 1024; const u32x4 a = *((const u32x4*)((const bf16_t*)(ws + WS_WPX) + (size_t)rr * 512) + lane);
                int w0 = __builtin_amdgcn_cvt_pk_fp8_f32(bflo(a.x) * 32.f, bfhi(a.x) * 32.f, 0, false); w0 = __builtin_amdgcn_cvt_pk_fp8_f32(bflo(a.y) * 32.f, bfhi(a.y) * 32.f, w0, true);
                int w1 = __builtin_amdgcn_cvt_pk_fp8_f32(bflo(a.z) * 32.f, bfhi(a.z) * 32.f, 0, false); w1 = __builtin_amdgcn_cvt_pk_fp8_f32(bflo(a.w) * 32.f, bfhi(a.w) * 32.f, w1, true);
                *((u32x2*)(ws + WS_WPX8 + (size_t)rr * 512) + lane) = (u32x2){(unsigned)w0, (unsigned)w1}; }
        }
    }
    __syncthreads();
    grid.sync();
    {
        pg8::Gemm g{(const bf16_t*)XN8, (const bf16_t*)W8, 512, 512, 512}; pg8::StaticOrder S; S.init(NTOK, 3584, G, bid);
        EpiInProjI8 E{ws, XS, WSC};
        pg8::gemm_phase<true>(ldsl, g, S, E, wv);
    }
    {
        pg8::Gemm g{XN, WIN + (size_t)2560 * 1024, 1024, 1024, 1024}; pg8::StaticOrder S; S.init(NTOK, 1024, G, bid);
        pg8::Epi8<FInProj> E{FInProj{ws, AG, 10}};
        pg8::gemm_phase(ldsl, g, S, E, wv);
    }
    if constexpr (PHON(1))
    {
        pg8::Gemm g{(const bf16_t*)(ws + WS_MN), (const bf16_t*)(ws + WS_WMKV), 1024, 1024, 1024}; pg8::StaticOrder S; S.init(NMEMROWS, 1024, G, (bid + 128) % G);
        pg8::Epi8<FStoreBf16> E{FStoreBf16{(bf16_t*)(ws + WS_KVM), 1024}};
        pg8::gemm_phase(ldsl, g, S, E, wv);
    }
    __syncthreads();
    grid.sync();
    STAMP(2);

    if constexpr (PHON(3))
    {
        pg8::Gemm g{AG, WE, AGK, 1024, 1024}; pg8::GroupedOrder S; S.init(32, 5, 1, G, bid);
        pg8::Epi8<FStoreEC> E{FStoreEC{EC}};
        pg8::gemm_phase(ldsl, g, S, E, wv);
    }
    __syncthreads();
    grid.sync();
    STAMP(4);

    if constexpr (PHON(4)) { PHASE_IDS
    for (long idx = ((long)wave * G + bid) * 64 + lane; idx < 9 * 32 * 2 * 64; idx += NGT) {
        const int n = (int)(idx & 63), dir = (int)((idx >> 6) & 1), g = (int)((idx >> 7) & 31), b = (int)(idx >> 12), dg = dir * 32 + g;
        const int c0 = b < 8 ? b * 128 : 1024, c1 = b < 8 ? c0 + 128 : 1280;
        const float dt = __expf(lstep[dg]); const float are = fminf(a_re[dg * 64 + n], -1e-4f), aim = a_im[dg * 64 + n];
        float lr, li; lam_pow(are, aim, dt, 64.f, lr, li);
        float sr = 0.f, si = 0.f;
        const int colE = dir * 128 + n;
        const int cstart = dir ? c1 - 1 : c0, cstep = dir ? -1 : 1;
        const float* e0 = EC + ((size_t)(g * NCHUNK + cstart)) * 256 + colE; bf16_t* a0 = AG + ((size_t)(g * NCHUNK + cstart)) * AGK + 1024 + colE;
        const long estep = (long)cstep * 256, astep = (long)cstep * AGK;
        for (int k = 0; k < c1 - c0; k += 16) {
            float er[16], ei[16];
#pragma unroll
            for (int j = 0; j < 16; ++j) { er[j] = e0[(k + j) * estep]; ei[j] = e0[(k + j) * estep + 64]; }
#pragma unroll
            for (int j = 0; j < 16; ++j) {
                bf16_t* ag = a0 + (k + j) * astep; ag[0] = (bf16_t)(cvtpk(sr, 0.f) & 0xffffu); ag[64] = (bf16_t)(cvtpk(si, 0.f) & 0xffffu);
                const float nr = lr * sr - li * si + er[j], ni = lr * si + li * sr + ei[j]; sr = nr; si = ni;
            }
        }
    }
    {
        bf16_t* Kb = (bf16_t*)(ws + WS_K); const float* kw = P.in[7]; unsigned char* K8 = ws + WS_K8;
        float wm = fmaxf(fabsf(kw[lane]), fabsf(kw[lane + 64]));
#pragma unroll
        for (int o = 1; o < 64; o <<= 1) wm = fmaxf(wm, __shfl_xor(wm, o));
        const float kmax = 11.3137085f * wm * 1.0001f + 1e-20f, ski = 127.f / kmax;
        if (lane == 0) *(float*)(ws + WS_SK) = kmax * (1.f / 127.f);
        const int kself = wave * G + bid; const bool split = NGW > 1152; const int nfree = split ? NGW - 576 : NGW, kfree = split ? kself - 576 : kself;
        if (kfree >= 0)
        for (int r8a = kfree; r8a < NTOK * 2 / 8; r8a += 2 * nfree) {
            u32x4 wv0[2], wv1[2]; u32x4* pp[2]; unsigned char* kd8[2]; bool okk[2]; f32x4 tc0[2], tc1[2], ts0[2], ts1[2];
            const int sub = lane & 7;
#pragma unroll
            for (int u = 0; u < 2; ++u) {
                const int r8 = r8a + u * nfree; okk[u] = r8 < NTOK * 2 / 8; const int rr = (okk[u] ? r8 : r8a) * 8 + (lane >> 3), token = rr >> 1, kvh = rr & 1;
                pp[u] = (u32x4*)(Kb + (size_t)token * 256 + kvh * 128 + sub * 16); wv0[u] = pp[u][0]; wv1[u] = pp[u][1];
                kd8[u] = K8 + (size_t)token * 256 + kvh * 128 + 32 * (sub >> 1) + 8 * (sub & 1);
                const int t = token < NPROMPT ? (token & (SEQ_P - 1)) : (token - NPROMPT); const int pos = sub < 4 ? (t >> 6) : (t & 63);
                const float* ct = cosT + pos * 32 + (sub & 3) * 8; const float* st = sinT + pos * 32 + (sub & 3) * 8;
                tc0[u] = *(const f32x4*)ct; tc1[u] = *(const f32x4*)(ct + 4); ts0[u] = *(const f32x4*)st; ts1[u] = *(const f32x4*)(st + 4);
            }
#pragma unroll
            for (int u = 0; u < 2; ++u) {
                const u32x4 w0 = wv0[u], w1 = wv1[u];
                float x[16]; x[0] = bflo(w0.x); x[1] = bfhi(w0.x); x[2] = bflo(w0.y); x[3] = bfhi(w0.y); x[4] = bflo(w0.z); x[5] = bfhi(w0.z); x[6] = bflo(w0.w); x[7] = bfhi(w0.w);
                x[8] = bflo(w1.x); x[9] = bfhi(w1.x); x[10] = bflo(w1.y); x[11] = bfhi(w1.y); x[12] = bflo(w1.z); x[13] = bfhi(w1.z); x[14] = bflo(w1.w); x[15] = bfhi(w1.w);
                float ss = 0.f;
#pragma unroll
                for (int j = 0; j < 16; ++j) ss += x[j] * x[j];
                ss += __shfl_xor(ss, 1); ss += __shfl_xor(ss, 2); ss += __shfl_xor(ss, 4);
                const float rstd = rsqrtf(ss * (1.f / 128.f) + EPS);
                unsigned ob[4] = {0u, 0u, 0u, 0u};
#pragma unroll
                for (int j = 0; j < 8; ++j) { const float a = x[2 * j] * rstd * kw[sub * 16 + 2 * j], b = x[2 * j + 1] * rstd * kw[sub * 16 + 2 * j + 1];
                    const float cs = j < 4 ? tc0[u][j & 3] : tc1[u][j & 3], sn = j < 4 ? ts0[u][j & 3] : ts1[u][j & 3];
                    const int q0 = (int)fminf(fmaxf(rintf((a * cs - b * sn) * ski), -127.f), 127.f), q1 = (int)fminf(fmaxf(rintf((a * sn + b * cs) * ski), -127.f), 127.f);
                    ob[j >> 1] |= ((unsigned)(q0 & 255) | ((unsigned)(q1 & 255) << 8)) << (16 * (j & 1)); }
                if (okk[u]) { *(u32x2*)kd8[u] = (u32x2){ob[0], ob[1]}; *(u32x2*)(kd8[u] + 16) = (u32x2){ob[2], ob[3]}; }
            }
        }
        if (kfree >= 0)
        for (int it = kfree; it < (NTOK / 64) * 2; it += nfree) {
            const bf16_t* vsrc = (const bf16_t*)(ws + WS_V) + (size_t)(it >> 1) * 64 * 256 + (it & 1) * 128 + 2 * lane;
            unsigned vraw[64];
#pragma unroll
            for (int k = 0; k < 64; ++k) vraw[k] = *(const unsigned*)(vsrc + (size_t)k * 256);
            unsigned char* dstb = ws + WS_V8 + (size_t)it * 8192;
#pragma unroll
            for (int sgl = 0; sgl < 2; ++sgl) {
                const int c = 2 * lane + sgl, sw = (c >> 2) & 3;
#pragma unroll
                for (int p = 0; p < 4; ++p) {
                    unsigned w[4];
#pragma unroll
                    for (int d = 0; d < 4; ++d) { float f[4];
#pragma unroll
                        for (int e = 0; e < 4; ++e) { const int b = 16 * p + 4 * d + e, h = b >> 5, j = b & 31;
                            const int key = (j < 16) ? ((j & 3) + 8 * (j >> 2) + 4 * h) : (32 + ((j - 16) & 3) + 8 * ((j - 16) >> 2) + 4 * h);
                            f[e] = sgl ? bfhi(vraw[key]) : bflo(vraw[key]); }
                        int ww = __builtin_amdgcn_cvt_pk_fp8_f32(f[0], f[1], 0, false); ww = __builtin_amdgcn_cvt_pk_fp8_f32(f[2], f[3], ww, true); w[d] = (unsigned)ww; }
                    *(u32x4*)(dstb + c * 64 + ((p ^ sw) << 4)) = (u32x4){w[0], w[1], w[2], w[3]};
                }
            }
        }
        if (kfree >= 0)
        for (long idx0 = (long)kfree * 64 + lane; idx0 < 32L * 1024 * 128; idx0 += 4L * nfree * 64) {
            f32x4 fa[4][2], fb[4][2]; int tauv[4], chv[4], c0v[4]; float dskv[4]; size_t dst[4]; bool ok[4];
#pragma unroll
            for (int u = 0; u < 4; ++u) {
                const long id = idx0 + (long)u * nfree * 64; ok[u] = id < 32L * 1024 * 128; const int idc = (int)(ok[u] ? id : idx0);
                const int q = idc & 127, r = (idc >> 7) & 1023, g = idc >> 17, i = r >> 4, ch = r & 15, j = q >> 1, c0 = (q & 1) * 8, tau = i - j;
                const float* pa = KT + ((size_t)(g * 64 + (tau > 0 ? tau : 0)) * 16 + ch) * 16 + c0;
                const float* pb = KT + ((size_t)((32 + g) * 64 + (tau < 0 ? -tau : 0)) * 16 + ch) * 16 + c0;
                fa[u][0] = *(const f32x4*)pa; fa[u][1] = *(const f32x4*)(pa + 4); fb[u][0] = *(const f32x4*)pb; fb[u][1] = *(const f32x4*)(pb + 4);
                tauv[u] = tau; chv[u] = ch; c0v[u] = c0; dskv[u] = s5d[g * 16 + ch]; dst[u] = ((size_t)(g * 1024 + r)) * AGK + q * 8;
            }
#pragma unroll
            for (int u = 0; u < 4; ++u) {
                const float wa = tauv[u] >= 0 ? 1.f : 0.f, wb = tauv[u] <= 0 ? 1.f : 0.f; float v[8];
#pragma unroll
                for (int e = 0; e < 8; ++e) v[e] = wa * fa[u][e >> 2][e & 3] + wb * fb[u][e >> 2][e & 3] + ((tauv[u] == 0 && (c0v[u] + e) == chv[u]) ? dskv[u] : 0.f);
                u32x4 w; w.x = cvtpk(v[0], v[1]); w.y = cvtpk(v[2], v[3]); w.z = cvtpk(v[4], v[5]); w.w = cvtpk(v[6], v[7]);
                if (ok[u]) *(u32x4*)(WG + dst[u]) = w;
            }
        }
        if (kfree >= 0)
        for (long idx = (long)kfree * 64 + lane; idx < 32L * 2 * 8 * 16; idx += (long)nfree * 64) {
            const int ch = (int)(idx & 15), oct = (int)((idx >> 4) & 7), dir = (int)((idx >> 7) & 1), g = (int)(idx >> 8), dg = dir * 32 + g, n0 = oct * 8;
            const float dt = __expf(lstep[dg]);
            float lr[8], li[8], pr[8], pi[8], cr[8], ci[8];
#pragma unroll
            for (int e = 0; e < 8; ++e) { const int n = n0 + e; const float are = fminf(a_re[dg * 64 + n], -1e-4f), aim = a_im[dg * 64 + n]; lam_pow(are, aim, dt, 1.f, lr[e], li[e]); pr[e] = lr[e]; pi[e] = li[e];
                cr[e] = c_re[(dg * 16 + ch) * 64 + n]; ci[e] = c_im[(dg * 16 + ch) * 64 + n]; }
            for (int pw = 1; pw <= 64; ++pw) {
                const int i = dir ? 64 - pw : pw - 1; float vr[8], vi[8];
#pragma unroll
                for (int e = 0; e < 8; ++e) { vr[e] = cr[e] * pr[e] - ci[e] * pi[e]; vi[e] = -(cr[e] * pi[e] + ci[e] * pr[e]);
                    const float nr = pr[e] * lr[e] - pi[e] * li[e], ni = pr[e] * li[e] + pi[e] * lr[e]; pr[e] = nr; pi[e] = ni; }
                bf16_t* d = WG + ((size_t)(g * 1024 + i * 16 + ch)) * AGK + 1024 + dir * 128 + n0;
                u32x4 w; w.x = cvtpk(vr[0], vr[1]); w.y = cvtpk(vr[2], vr[3]); w.z = cvtpk(vr[4], vr[5]); w.w = cvtpk(vr[6], vr[7]); *(u32x4*)d = w;
                w.x = cvtpk(vi[0], vi[1]); w.y = cvtpk(vi[2], vi[3]); w.z = cvtpk(vi[4], vi[5]); w.w = cvtpk(vi[6], vi[7]); *(u32x4*)(d + 64) = w;
            }
        }
    }
    }
    __syncthreads();
    grid.sync();
    STAMP(5);

    if constexpr (PHON(5))
    {
        pg8::Gemm g{AG, WG, AGK, AGK, AGK}; pg8::GroupedOrder S; S.init(32, 5, 4, G, bid);
        pg8::Epi8<FS5Out> E{FS5Out{(bf16_t*)(ws + WS_U)}};
        pg8::gemm_phase(ldsl, g, S, E, wv);
    }
    __syncthreads();
    grid.sync();
    STAMP(6);

    if constexpr (PHON(6))
    {
        pg8::Gemm g{(const bf16_t*)(ws + WS_U), (const bf16_t*)(ws + WS_WGLU), 512, 512, 512}; pg8::StaticOrder S; S.init(NTOK, 512, G, bid);
        pg8::Epi8<FGlu> E{FGlu{(const bf16_t*)(ws + WS_U), (bf16_t*)(ws + WS_GS), P.in[17]}};
        pg8::gemm_phase(ldsl, g, S, E, wv);
    }

    if constexpr (PHON(7))
    {
        bf16_t* Q = (bf16_t*)(ws + WS_Q); const unsigned char* K8 = ws + WS_K8; const unsigned char* V8 = ws + WS_V8; const bf16_t* GA = (const bf16_t*)(ws + WS_GA);
        const float skv = *(const float*)(ws + WS_SK);
        { const int per = (512 + G - 1) / G;
          for (int ui = vcu * per; ui < (vcu + 1) * per && ui < 512; ++ui) {
              const int qb = ui & 63, h = ui >> 6, kvh = h >> 2; const size_t tok0 = (size_t)NPROMPT + qb * 256;
              att::attn_unit_i8<1024, 256>(Q + tok0 * 1024 + h * 128, K8 + (size_t)NPROMPT * 256 + kvh * 128, V8 + ((size_t)(NPROMPT / 64) * 2 + kvh) * 8192, GA + tok0 * 1024 + h * 128,
                                           dob + DO_Y8A + tok0 * 1024 + h * 128, SEQ_S, (char*)lds, qb * 256, P.in[6], cosT, sinT, skv, wv);
          } }
        { const int per = (2048 + G - 1) / G;
          for (int uu = vcu * per; uu < (vcu + 1) * per && uu < 2048; ++uu) {
              int ui = uu;
              if (G == 256) { const int xcd = vcu >> 5, j = vcu & 31, k = uu & 7, pair = xcd * 2 + (k >> 2); ui = pair * 128 + j * 4 + (k & 3); }
              const int qb = ui & 31, hq = (ui >> 5) & 3, kvh = (ui >> 7) & 1, b = ui >> 8, h = kvh * 4 + hq; const size_t tok0 = (size_t)b * SEQ_P + qb * 256, kt0 = (size_t)b * SEQ_P;
              att::attn_unit_i8<1024, 256>(Q + tok0 * 1024 + h * 128, K8 + kt0 * 256 + kvh * 128, V8 + ((kt0 / 64) * 2 + kvh) * 8192, GA + tok0 * 1024 + h * 128,
                                           dob + DO_Y8A + tok0 * 1024 + h * 128, SEQ_P, (char*)lds, qb * 256, P.in[6], cosT, sinT, skv, wv);
          } }
        { bf16_t* QX = (bf16_t*)(ws + WS_QX); const bf16_t* GX = (const bf16_t*)(ws + WS_GX); const bf16_t* KVM = (const bf16_t*)(ws + WS_KVM);
          const int per = (1280 + G - 1) / G;
          for (int ui = vcu * per; ui < (vcu + 1) * per && ui < 1280; ++ui) {
              const int h = ui & 3, tb = ui >> 2; const size_t tok0 = (size_t)tb * 256; const int mb = tok0 < (size_t)NPROMPT ? (int)(tok0 / SEQ_P) : 8;
              const bf16_t* km = KVM + (size_t)mb * 256 * 1024 + h * 128;
              att::attn_unit<false, 512, 1024>(QX + tok0 * 512 + h * 128, km, km + 512, GX + tok0 * 512 + h * 128, dob + DO_Y8X + tok0 * 512 + h * 128, 256, (char*)lds, 0, nullptr, nullptr, nullptr, wv);
          } }
    }
    __syncthreads();
    grid.sync();
    STAMP(7);

    if constexpr (PHON(8))
    {
        pg8::Gemm g{(const bf16_t*)(dob + DO_Y8A), (const bf16_t*)(ws + WS_WPA8), 512, 512, 512, 0x79797979, 0x7A7A7A7A}; pg8::StaticOrder S; S.init(NTOK, 1024, G, bid);
        pg8::Epi8<FStoreBf16> E{FStoreBf16{(bf16_t*)(ws + WS_GA), 1024}};
        pg8::gemm_phase<2>(ldsl, g, S, E, wv);
    }
    if constexpr (PHON(8))
    {
        pg8::Gemm g{(const bf16_t*)(dob + DO_Y8X), (const bf16_t*)(ws + WS_WPX8), 256, 256, 256, 0x7B7B7B7B, 0x7A7A7A7A}; pg8::StaticOrder S; S.init(NTOK, 1024, G, bid);
        pg8::Epi8<FStoreBf16> E{FStoreBf16{(bf16_t*)(ws + WS_PX), 1024}};
        pg8::gemm_phase<2>(ldsl, g, S, E, wv);
    }
    if constexpr (PHON(8))
    {
        pg8::Gemm g{(const bf16_t*)(ws + WS_GS), (const bf16_t*)(ws + WS_WPS), 512, 512, 512}; pg8::StaticOrder S; S.init(NTOK, 1024, G, bid);
        pg8::Epi8<FStoreBf16> E{FStoreBf16{(bf16_t*)(ws + WS_PS), 1024}};
        pg8::gemm_phase(ldsl, g, S, E, wv);
    }
    __syncthreads();
    grid.sync();
    STAMP(8);

    if constexpr (PHON(9))
    {
        { pg8::Gemm g{(const bf16_t*)XN8, (const bf16_t*)(W8 + (size_t)3584 * 1024), 512, 512, 512}; pg8::PairOrder S{G, vcu};
          EpiMergeI8 E{ws, XS, WSC + 3584, (bf16_t*)(ws + WS_GA)};
          pg8::gemm_phase<true>(ldsl, g, S, E, wv); }
        { pg8::Gemm g{XN, WIN + (size_t)(4608 + 1024) * 1024, 1024, 1024, 1024}; pg8::SingleOrder S{G, vcu};
          pg8::Epi8<FMerge> E{FMerge{ws, (bf16_t*)(ws + WS_GA), 1}};
          pg8::gemm_phase(ldsl, g, S, E, wv); }
    }
    __syncthreads();
    grid.sync();
    STAMP(9);

    if constexpr (PHON(10))
    {
        pg8::Gemm g{(const bf16_t*)(ws + WS_GA), (const bf16_t*)(ws + WS_WOUT), 1024, 1024, 1024}; pg8::StaticOrder S; S.init(NTOK, 1024, G, bid);
        EpiOutNorm E{xp, xs, P.out, P.in[24], (float*)(ws + WS_RSS), (unsigned*)(ws + WS_CNT)};
        pg8::gemm_phase(ldsl, g, S, E, wv);
    }
    if (PROBE) {
        __syncthreads(); grid.sync(); STAMP(11);
        if (bid == 0) { PHASE_IDS
            __syncthreads();
            const unsigned long long* TS = (const unsigned long long*)(ws + 768 * 1024);
            const float tA_us = (float)(__hip_atomic_load(TS + PROBE_A1, __ATOMIC_RELAXED, __HIP_MEMORY_SCOPE_AGENT) - __hip_atomic_load(TS + PROBE_A0, __ATOMIC_RELAXED, __HIP_MEMORY_SCOPE_AGENT)) * 0.01f;
            const float tB_us = (float)(__hip_atomic_load(TS + PROBE_B1, __ATOMIC_RELAXED, __HIP_MEMORY_SCOPE_AGENT) - __hip_atomic_load(TS + PROBE_B0, __ATOMIC_RELAXED, __HIP_MEMORY_SCOPE_AGENT)) * 0.01f;
            if (tid == 0) P.out[0] += tA_us * (1.f / 2000.f);
            const float dB = sqrtf(80e-6f * tB_us * 1e-3f);
            for (int i = tid; i < 1048576; i += 512) P.out[1024 + i] += dB;
        }
    }
}

#undef XN8
#undef XS
#undef W8
#undef WSC
extern "C" void kernel_launch(void* const* d_in, const int* in_sizes, int n_in, void* d_out, int out_size, void* d_ws, size_t ws_size, hipStream_t stream) {
    static int grid = 0;
    if (grid == 0) {
        if (n_in != 25 || out_size != NTOK * DM || ws_size < WS_END) { fprintf(stderr, "kernel_launch: unexpected shapes (n_in %d out %d ws %zu)\n", n_in, out_size, ws_size); grid = -1; return; }
        int dev = 0, cus = 0, per_cu = 0;
        hipGetDevice(&dev); hipDeviceGetAttribute(&cus, hipDeviceAttributeMultiprocessorCount, dev);
        if (hipFuncSetAttribute((const void*)hybrid_fwd, hipFuncAttributeMaxDynamicSharedMemorySize, LDS_BYTES) != hipSuccess) { fprintf(stderr, "kernel_launch: hipFuncSetAttribute failed\n"); grid = -1; return; }
        if (hipOccupancyMaxActiveBlocksPerMultiprocessor(&per_cu, (const void*)hybrid_fwd, 512, LDS_BYTES) != hipSuccess || per_cu < 1) { fprintf(stderr, "kernel_launch: occupancy query failed (%d)\n", per_cu); (void)hipGetLastError(); per_cu = 1; }
        grid = cus * per_cu;
    }
    if (grid < 0) return;
    Params p{};
    for (int i = 0; i < 25; ++i) p.in[i] = (const float*)d_in[i];
    p.out = (float*)d_out; p.ws = (unsigned char*)d_ws;
    void* args[] = {&p};
    hipError_t e = hipLaunchCooperativeKernel((const void*)hybrid_fwd, dim3(grid), dim3(512), args, LDS_BYTES, stream);
    if (e != hipSuccess) fprintf(stderr, "kernel_launch: cooperative launch failed: %s (grid %d)\n", hipGetErrorString(e), grid);
}
```

```cpp
#include <hip/hip_runtime.h>
#include <hip/hip_cooperative_groups.h>
#include <cstdio>
#include <cstdint>
namespace cg = cooperative_groups;

#define LAS __attribute__((address_space(3)))
typedef unsigned short bf16_t;
typedef short bf16x8 __attribute__((ext_vector_type(8)));
typedef short s16x4 __attribute__((ext_vector_type(4)));
typedef float f32x4 __attribute__((ext_vector_type(4)));
typedef float f32x16 __attribute__((ext_vector_type(16)));
typedef unsigned u32x4 __attribute__((ext_vector_type(4)));
typedef unsigned u32x2 __attribute__((ext_vector_type(2)));
typedef int i32x4 __attribute__((ext_vector_type(4)));
typedef int i32x16 __attribute__((ext_vector_type(16)));

constexpr int DM = 1024, NTOK = 81920, NPROMPT = 65536, SEQ_P = 8192, SEQ_S = 16384;
constexpr int NMEMROWS = 2304;
constexpr int CH = 64;
constexpr int NCHUNK = NTOK / CH;
constexpr int AGK = 1280;
constexpr float EPS = 1e-6f;

constexpr size_t MiB = 1u << 20;
constexpr size_t WS_RSS = 0, WS_CNT = 512 * 1024;
constexpr size_t WS_COS = 1 * MiB, WS_SIN = 1 * MiB + 65536;
constexpr size_t WS_KT = 2 * MiB;
constexpr size_t WS_WIN = 6 * MiB;
constexpr size_t WS_WMKV = 21 * MiB, WS_WPA = 23 * MiB, WS_WPS = 25 * MiB, WS_WPX = 26 * MiB, WS_WOUT = 27 * MiB, WS_WGLU = 29 * MiB;
constexpr size_t WS_MN = 30 * MiB, WS_KVM = 35 * MiB;
constexpr size_t WS_XN = 40 * MiB;
constexpr size_t WS_Q = 200 * MiB;
constexpr size_t WS_GA = 360 * MiB;
constexpr size_t WS_K = 520 * MiB, WS_V = 560 * MiB, WS_U = 600 * MiB;
constexpr size_t WS_PS = 520 * MiB;
constexpr size_t WS_GS = 680 * MiB;
constexpr size_t WS_QX = 760 * MiB;
constexpr size_t WS_GX = 840 * MiB;
constexpr size_t WS_PX = 840 * MiB;
constexpr size_t WS_K8 = 920 * MiB;
constexpr size_t WS_V8 = 940 * MiB;
constexpr size_t WS_SK = 900 * 1024;
constexpr size_t WS_W8 = 1000 * MiB, WS_WSC = 1006 * MiB, WS_XS = 1007 * MiB;
constexpr size_t WS_WPA8 = 1008 * MiB, WS_WPX8 = 1009 * MiB;
constexpr size_t WS_END = 1010 * MiB;
constexpr size_t DO_Y8A = 0, DO_Y8X = 80 * MiB;
constexpr size_t DO_XN8 = 236 * MiB;
constexpr size_t DO_AG = 0, DO_WG = 100 * MiB, DO_WE = 180 * MiB, DO_EC = 196 * MiB;

constexpr int LDS_BYTES = 135168;

__device__ __forceinline__ unsigned cvtpk(float lo, float hi) { unsigned r; asm volatile("v_cvt_pk_bf16_f32 %0, %1, %2" : "=v"(r) : "v"(lo), "v"(hi)); return r; }
__device__ __forceinline__ float bflo(unsigned w) { return __uint_as_float(w << 16); }
__device__ __forceinline__ float bfhi(unsigned w) { return __uint_as_float(w & 0xffff0000u); }
__device__ __forceinline__ float bf2f(bf16_t s) { return __uint_as_float(((unsigned)s) << 16); }
__device__ __forceinline__ float sigmoidf_(float x) { return __builtin_amdgcn_rcpf(1.f + __builtin_amdgcn_exp2f(-1.4426950408889634f * x)); }
__device__ __forceinline__ float siluf_(float x) { return x * sigmoidf_(x); }
__device__ __forceinline__ float gelu_tanh_(float x) { return x * sigmoidf_(1.5957691216057308f * (x + 0.044715f * x * x * x)); }
__device__ __forceinline__ int opaque_tid(int wv) { int l; asm volatile("v_mbcnt_lo_u32_b32 %0, -1, 0\n\tv_mbcnt_hi_u32_b32 %0, -1, %0" : "=v"(l)); return wv * 64 + l; }
__device__ __forceinline__ float wave_sum(float v) {
#pragma unroll
    for (int o = 1; o < 64; o <<= 1) v += __shfl_xor(v, o);
    return v;
}
__device__ __forceinline__ void cexp_turns(float turns, float& c, float& s) { const float f = turns - rintf(turns); c = cospif(2.f * f); s = sinpif(2.f * f); }
__device__ __forceinline__ void lam_pow(float are, float aim, float dt, float p, float& re, float& im) {
    const float mag = __expf(are * dt * p); float c, s; cexp_turns(aim * dt * p * 0.15915494309189535f, c, s); re = mag * c; im = mag * s;
}
__device__ __forceinline__ void zoh_coef(float are, float aim, float dt, float& cr, float& ci) {
    const float x = are * dt, y = aim * dt; const float ex1 = expm1f(x); float cy, sy; cexp_turns(y * 0.15915494309189535f, cy, sy);
    const float re1 = ex1 * cy + (cy - 1.f), im1 = (1.f + ex1) * sy; const float den = 1.f / (are * are + aim * aim);
    cr = (re1 * are + im1 * aim) * den; ci = (im1 * are - re1 * aim) * den;
}

namespace pg8 {
constexpr int BM = 256, BK = 64, HALF = 128, HTB = HALF * BK * 2, STAGE_BYTES = 8 * HTB, NXCD = 8, WGM = 8;
__host__ __device__ __forceinline__ int lds_byte(int r, int c) { const int st = (r >> 4) * 2 + (c >> 5), rr = r & 15, cc = c & 31, ob = rr * 64 + cc * 2; return st * 1024 + (ob ^ (((ob >> 9) & 1) << 5)); }
__host__ __device__ __forceinline__ void stage_rc(int b, int& R, int& C) { const int st = b / 1024, sb = b % 1024, swz = sb ^ (((sb >> 9) & 1) << 5); R = (st >> 1) * 16 + swz / 64; C = (st & 1) * 32 + (swz % 64) / 2; }
__host__ __device__ __forceinline__ int perm32(int rho) { const int n = rho >> 4, i = rho & 15; return 8 * (i >> 2) + 4 * n + (i & 3); }
struct Unit { int pm, pn; };
struct Gemm { const bf16_t* A; const bf16_t* Bt; int lda, ldb, K; int sa = 0x7F7F7F7F, sb = 0x7F7F7F7F; };

struct StaticOrder {
    int nM, nN, nwg, G, c;
    __device__ void init(int M, int N, int G_, int c_) { nM = M / BM; nN = N / BM; nwg = nM * nN; G = G_; c = c_; }
    __device__ bool next(int i, Unit& u) const {
        const long L = (long)i * G + c; if (L >= nwg) return false;
        int wgid = (int)L; { const int q = nwg / NXCD, r = nwg % NXCD, xcd = wgid % NXCD, off = wgid / NXCD; wgid = (xcd < r ? xcd * (q + 1) : r * (q + 1) + (xcd - r) * q) + off; }
        const int nig = WGM * nN, gid = wgid / nig, fm = gid * WGM, gsz = (nM - fm) < WGM ? (nM - fm) : WGM;
        u.pm = fm + ((wgid % nig) % gsz); u.pn = (wgid % nig) / gsz; return true;
    }
};
struct GroupedOrder {
    int RT, CT, total, G, c;
    __device__ void init(int ng, int RT_, int CT_, int G_, int c_) { RT = RT_; CT = CT_; total = ng * RT_ * CT_; G = G_; c = c_; }
    __device__ bool next(int i, Unit& u) const {
        const int L = i * G + c; if (L >= total) return false;
        const int per = RT * CT, g = L / per, rem = L % per, a = rem / CT, b = rem % CT; u.pm = g * RT + a; u.pn = g * CT + b; return true;
    }
};
struct PairOrder {
    int G, c;
    __device__ bool next(int i, Unit& u) const { const int tr = (i >> 1) * G + c; if (tr >= 1280) return false; u.pm = tr >> 2; u.pn = (i & 1) * 4 + (tr & 3); return true; }
};
struct SingleOrder {
    int G, c;
    __device__ bool next(int i, Unit& u) const { const int tr = i * G + c; if (tr >= 1280) return false; u.pm = tr >> 2; u.pn = tr & 3; return true; }
};
struct TripleOrder {
    int G, c;
    __device__ bool next(int i, Unit& u) const {
        const int tr = (i / 3) * G + c; if (tr >= 1280) return false;
        const int br = i % 3; u.pm = tr >> 2; u.pn = br * 4 + (tr & 3); return true;
    }
};

template <class F> struct Epi8 {
    static constexpr bool PERM = true;
    F f;
    __device__ __forceinline__ void operator()(const f32x4 (&acc)[2][2][4][2], const Unit& u, int wr, int wc, int fr, int fq) const {
        const int row0 = u.pm * BM + wr * 64 + fr, col0 = u.pn * BM + wc * 32 + 8 * fq;
        if constexpr (F::HAS_LOAD) {
#pragma unroll
            for (int ai = 0; ai < 2; ++ai) {
                typename F::Ld ld[4][2];
#pragma unroll
                for (int m = 0; m < 4; ++m)
#pragma unroll
                    for (int bj = 0; bj < 2; ++bj) ld[m][bj] = f.load(u, row0 + ai * HALF + m * 16, col0 + bj * HALF);
#pragma unroll
                for (int m = 0; m < 4; ++m)
#pragma unroll
                    for (int bj = 0; bj < 2; ++bj) f.apply(u, row0 + ai * HALF + m * 16, col0 + bj * HALF, acc[ai][bj][m][0], acc[ai][bj][m][1], ld[m][bj]);
                asm volatile("" ::: "memory");
            }
        } else {
#pragma unroll
            for (int ai = 0; ai < 2; ++ai)
#pragma unroll
                for (int m = 0; m < 4; ++m) {
#pragma unroll
                    for (int bj = 0; bj < 2; ++bj) f(u, row0 + ai * HALF + m * 16, col0 + bj * HALF, acc[ai][bj][m][0], acc[ai][bj][m][1]);
                    asm volatile("" ::: "memory");
                }
        }
    }
};

template <bool I8> __device__ __forceinline__ f32x4 mma16(bf16x8 b, bf16x8 a, f32x4 c) {
    if constexpr (I8) return __builtin_bit_cast(f32x4, __builtin_amdgcn_mfma_i32_16x16x64_i8(__builtin_bit_cast(i32x4, b), __builtin_bit_cast(i32x4, a), __builtin_bit_cast(i32x4, c), 0, 0, 0));
    else return __builtin_amdgcn_mfma_f32_16x16x32_bf16(b, a, c, 0, 0, 0);
}
typedef int i32x8g __attribute__((ext_vector_type(8)));
template <int MODE = 0, class Epi, class Sched>
__device__ __forceinline__ void gemm_phase(LAS unsigned char* lds, const Gemm g, const Sched& S, const Epi& E, int wv) {
    const int tid = opaque_tid(wv), wid = __builtin_amdgcn_readfirstlane(tid >> 6), lane = tid & 63, wr = wid >> 2, wc = wid & 3, fr = lane & 15, fq = lane >> 4;
    const int K = g.K, nt = K / BK;
    unsigned voffA[2], voffB[2];
#pragma unroll
    for (int i = 0; i < 2; ++i) { int R, C; stage_rc(tid * 16 + i * 8192, R, C); const int Rb = Epi::PERM ? ((R & ~31) + perm32(R & 31)) : R;
        voffA[i] = (unsigned)(R * g.lda + C) * 2u; voffB[i] = (unsigned)(Rb * g.ldb + C) * 2u; }
    const size_t kstep = (size_t)(BK * 2);
    const size_t hstepA = (size_t)HALF * g.lda * 2, hstepB = (size_t)HALF * g.ldb * 2;
    const size_t tstepA = 2 * hstepA, tstepB = 2 * hstepB;
    const unsigned ldsw = (unsigned)wid * 1024u;
    const int aoff = lds_byte(wr * 64 + fr, fq * 8), boff = lds_byte(wc * 32 + fr, fq * 8);
    const int aoff8 = lds_byte(wr * 64 + fr, (fq & 1) * 32 + (fq >> 1) * 16), boff8 = lds_byte(wc * 32 + fr, (fq & 1) * 32 + (fq >> 1) * 16);
#define PG8_SA(b, h) (((b) * 2 + (h)) * HTB)
#define PG8_SB(b, h) ((4 + (b) * 2 + (h)) * HTB)
#define PG8_STAGE(bufoff, gbase, voff) do { _Pragma("unroll") for (int _i = 0; _i < 2; ++_i) \
        __builtin_amdgcn_global_load_lds((const unsigned*)((const char*)(gbase) + (voff)[_i]), (LAS unsigned*)(lds + (bufoff) + ldsw + _i * 8192), 16, 0, 0); } while (0)
#define PG8_LDA(dst, b, h) do { if constexpr (MODE == 2) { _Pragma("unroll") for (int m = 0; m < 4; ++m) dst##8[m] = *(const LAS i32x8g*)(lds + PG8_SA(b, h) + aoff8 + m * 2048); } \
    else { _Pragma("unroll") for (int m = 0; m < 4; ++m) _Pragma("unroll") for (int k = 0; k < 2; ++k) dst[m][k] = *(const LAS bf16x8*)(lds + PG8_SA(b, h) + aoff + m * 2048 + k * 1024); } } while (0)
#define PG8_LDB(dst, b, h) do { if constexpr (MODE == 2) { _Pragma("unroll") for (int n = 0; n < 2; ++n) dst##8[n] = *(const LAS i32x8g*)(lds + PG8_SB(b, h) + boff8 + n * 2048); } \
    else { _Pragma("unroll") for (int n = 0; n < 2; ++n) _Pragma("unroll") for (int k = 0; k < 2; ++k) dst[n][k] = *(const LAS bf16x8*)(lds + PG8_SB(b, h) + boff + n * 2048 + k * 1024); } } while (0)
#define PG8_MMA(ai, bj, At, Bt) do { __builtin_amdgcn_s_setprio(1); \
    if constexpr (MODE == 2) { _Pragma("unroll") for (int m = 0; m < 4; ++m) _Pragma("unroll") for (int n = 0; n < 2; ++n) \
        asm volatile("v_mfma_scale_f32_16x16x128_f8f6f4 %0, %1, %2, %0, %3, %4 op_sel_hi:[0,0,0]" : "+v"(acc[ai][bj][m][n]) : "v"(Bt##8[n]), "v"(At##8[m]), "v"(vsb), "v"(vsa)); } \
    else { _Pragma("unroll") for (int m = 0; m < 4; ++m) _Pragma("unroll") for (int n = 0; n < 2; ++n) _Pragma("unroll") for (int k = 0; k < 2; ++k) \
        acc[ai][bj][m][n] = mma16<MODE == 1>(Bt[n][k], At[m][k], acc[ai][bj][m][n]); } __builtin_amdgcn_s_setprio(0); } while (0)
#define PG8_WAIT_V(n) asm volatile("s_waitcnt vmcnt(" #n ")" ::: "memory")
#define PG8_WAIT_L(n) asm volatile("s_waitcnt lgkmcnt(" #n ")" ::: "memory")
#define PG8_BAR __builtin_amdgcn_s_barrier()
#define PG8_SCHED __builtin_amdgcn_sched_barrier(0)
    Unit cur, nxt; int ui = 0;
    if (!S.next(0, cur)) return;
    f32x4 acc[2][2][4][2];
#pragma unroll
    for (int a = 0; a < 2; ++a)
#pragma unroll
        for (int b = 0; b < 2; ++b)
#pragma unroll
            for (int m = 0; m < 4; ++m)
#pragma unroll
                for (int n = 0; n < 2; ++n) acc[a][b][m][n] = (f32x4){0.f, 0.f, 0.f, 0.f};
    bf16x8 At[4][2], B0[2][2], B1[2][2];
    i32x8g At8[4], B08[2], B18[2];
    const int vsa = g.sa, vsb = g.sb;
    const char* cA = (const char*)g.A + (size_t)cur.pm * tstepA; const char* cB = (const char*)g.Bt + (size_t)cur.pn * tstepB;
    PG8_STAGE(PG8_SB(0, 0), cB, voffB); PG8_STAGE(PG8_SB(0, 1), cB + hstepB, voffB); PG8_STAGE(PG8_SA(0, 0), cA, voffA); PG8_STAGE(PG8_SA(0, 1), cA + hstepA, voffA);
    if (wr == 1) PG8_BAR;
    PG8_WAIT_V(2); PG8_BAR;
    PG8_STAGE(PG8_SB(1, 0), cB + kstep, voffB); PG8_STAGE(PG8_SA(1, 0), cA + kstep, voffA); PG8_STAGE(PG8_SB(1, 1), cB + hstepB + kstep, voffB);
    PG8_WAIT_V(6); PG8_BAR;
    for (;;) {
        const bool has_next = S.next(ui + 1, nxt);
        const char* nA = has_next ? (const char*)g.A + (size_t)nxt.pm * tstepA : cA; const char* nB = has_next ? (const char*)g.Bt + (size_t)nxt.pn * tstepB : cB;
        for (int t = 0; t < nt; t += 2) {
            const bool last = (t == nt - 2);
            const char* a1 = cA + (size_t)(t + 1) * kstep;
            const char* a2 = last ? nA : cA + (size_t)(t + 2) * kstep; const char* b2 = last ? nB : cB + (size_t)(t + 2) * kstep;
            const char* a3 = a2 + kstep; const char* b3 = b2 + kstep;
            PG8_LDB(B0, 0, 0); PG8_LDB(B1, 0, 1); PG8_SCHED; PG8_LDA(At, 0, 0); PG8_STAGE(PG8_SA(1, 1), a1 + hstepA, voffA);
            PG8_WAIT_V(8); PG8_WAIT_L(0); PG8_BAR; PG8_MMA(0, 0, At, B0); PG8_MMA(0, 1, At, B1); PG8_BAR; PG8_SCHED;
            PG8_LDA(At, 0, 1); PG8_STAGE(PG8_SB(0, 0), b2, voffB); PG8_STAGE(PG8_SB(0, 1), b2 + hstepB, voffB); PG8_STAGE(PG8_SA(0, 0), a2, voffA);
            PG8_WAIT_V(8); PG8_WAIT_L(0); PG8_BAR; PG8_MMA(1, 0, At, B0); PG8_MMA(1, 1, At, B1); PG8_BAR; PG8_SCHED;
            PG8_LDB(B0, 1, 0); PG8_LDB(B1, 1, 1); PG8_SCHED; PG8_LDA(At, 1, 0); PG8_STAGE(PG8_SA(0, 1), a2 + hstepA, voffA);
            PG8_WAIT_V(8); PG8_WAIT_L(0); PG8_BAR; PG8_MMA(0, 0, At, B0); PG8_MMA(0, 1, At, B1); PG8_BAR; PG8_SCHED;
            PG8_LDA(At, 1, 1); PG8_STAGE(PG8_SB(1, 0), b3, voffB); PG8_STAGE(PG8_SB(1, 1), b3 + hstepB, voffB); PG8_STAGE(PG8_SA(1, 0), a3, voffA);
            PG8_WAIT_V(8); PG8_WAIT_L(0); PG8_BAR; PG8_MMA(1, 0, At, B0); PG8_MMA(1, 1, At, B1); PG8_BAR; PG8_SCHED;
        }
        if (wr == 0) PG8_BAR;
        if constexpr (MODE == 2) asm volatile("s_nop 15\n\ts_nop 15\n\ts_nop 15" ::: "memory");
        E(acc, cur, wr, wc, fr, fq);
        if (!has_next) break;
#pragma unroll
        for (int a = 0; a < 2; ++a)
#pragma unroll
            for (int b = 0; b < 2; ++b)
#pragma unroll
                for (int m = 0; m < 4; ++m)
#pragma unroll
                    for (int n = 0; n < 2; ++n) acc[a][b][m][n] = (f32x4){0.f, 0.f, 0.f, 0.f};
        cur = nxt; cA = nA; cB = nB; ++ui;
        if (wr == 1) PG8_BAR;
    }
    PG8_WAIT_V(0);
    PG8_BAR;
#undef PG8_SA
#undef PG8_SB
#undef PG8_STAGE
#undef PG8_LDA
#undef PG8_LDB
#undef PG8_MMA
#undef PG8_WAIT_V
#undef PG8_WAIT_L
#undef PG8_BAR
#undef PG8_SCHED
}
}

__device__ __forceinline__ u32x4 pack8(f32x4 v0, f32x4 v1) { u32x4 w; w.x = cvtpk(v0[0], v0[1]); w.y = cvtpk(v0[2], v0[3]); w.z = cvtpk(v1[0], v1[1]); w.w = cvtpk(v1[2], v1[3]); return w; }
__device__ __forceinline__ void unpack8(u32x4 w, f32x4& a, f32x4& b) { a = (f32x4){bflo(w.x), bfhi(w.x), bflo(w.y), bfhi(w.y)}; b = (f32x4){bflo(w.z), bfhi(w.z), bflo(w.w), bfhi(w.w)}; }
__device__ __forceinline__ f32x4 silu4(f32x4 v) { return (f32x4){siluf_(v[0]), siluf_(v[1]), siluf_(v[2]), siluf_(v[3])}; }
__device__ __forceinline__ f32x4 sig4(f32x4 v) { return (f32x4){sigmoidf_(v[0]), sigmoidf_(v[1]), sigmoidf_(v[2]), sigmoidf_(v[3])}; }
__device__ __forceinline__ f32x4 gelu4(f32x4 v) { return (f32x4){gelu_tanh_(v[0]), gelu_tanh_(v[1]), gelu_tanh_(v[2]), gelu_tanh_(v[3])}; }

struct FInProj { static constexpr bool HAS_LOAD = false;
    unsigned char* ws; bf16_t* AG; int pn0;
    __device__ __forceinline__ void operator()(const pg8::Unit& u, int row, int col, f32x4 v0, f32x4 v1) const {
        const int pn = u.pn + pn0; col += pn0 * 256; size_t off; int ld, c; bool act = false;
        if (pn < 4) { off = WS_Q; ld = 1024; c = col; }
        else if (pn == 4) { off = WS_K; ld = 256; c = col - 1024; }
        else if (pn == 5) { off = WS_V; ld = 256; c = col - 1280; }
        else if (pn < 10) { off = WS_GA; ld = 1024; c = col - 1536; act = true; }
        else if (pn < 12) {
            const int cu = col - 2560, g = cu >> 4;
            *(u32x4*)(AG + ((size_t)(g * NCHUNK + (row >> 6))) * AGK + (row & 63) * 16 + (cu & 15)) = pack8(v0, v1); return; }
        else if (pn < 14) { off = WS_GS; ld = 512; c = col - 3072; act = true; }
        else if (pn < 16) { off = WS_QX; ld = 512; c = col - 3584; }
        else { off = WS_GX; ld = 512; c = col - 4096; act = true; }
        if (act) { v0 = silu4(v0); v1 = silu4(v1); }
        *(u32x4*)((bf16_t*)(ws + off) + (size_t)row * ld + c) = pack8(v0, v1);
    }
};
struct EpiInProjI8 {
    static constexpr bool PERM = true;
    unsigned char* ws; const float* xs; const float* wsc;
    __device__ __forceinline__ void operator()(const f32x4 (&acc)[2][2][4][2], const pg8::Unit& u, int wr, int wc, int fr, int fq) const {
        const int row0 = u.pm * 256 + wr * 64 + fr, col0 = u.pn * 256 + wc * 32 + 8 * fq, pn = u.pn;
        float rs[2][4]; f32x4 cs[2][2];
#pragma unroll
        for (int ai = 0; ai < 2; ++ai)
#pragma unroll
            for (int m = 0; m < 4; ++m) rs[ai][m] = xs[row0 + ai * 128 + m * 16];
#pragma unroll
        for (int bj = 0; bj < 2; ++bj)
#pragma unroll
            for (int n = 0; n < 2; ++n) cs[bj][n] = *(const f32x4*)(wsc + col0 + bj * 128 + 4 * n);
        size_t off; int ld, c0; bool act = false;
        if (pn < 4) { off = WS_Q; ld = 1024; c0 = col0; }
        else if (pn == 4) { off = WS_K; ld = 256; c0 = col0 - 1024; }
        else if (pn == 5) { off = WS_V; ld = 256; c0 = col0 - 1280; }
        else if (pn < 10) { off = WS_GA; ld = 1024; c0 = col0 - 1536; act = true; }
        else if (pn < 12) { off = WS_QX; ld = 512; c0 = col0 - 2560; }
        else { off = WS_GX; ld = 512; c0 = col0 - 3072; act = true; }
        bf16_t* base = (bf16_t*)(ws + off);
#pragma unroll
        for (int ai = 0; ai < 2; ++ai)
#pragma unroll
            for (int m = 0; m < 4; ++m) {
#pragma unroll
                for (int bj = 0; bj < 2; ++bj) {
                    f32x4 v0 = __builtin_convertvector(__builtin_bit_cast(i32x4, acc[ai][bj][m][0]), f32x4) * rs[ai][m] * cs[bj][0];
                    f32x4 v1 = __builtin_convertvector(__builtin_bit_cast(i32x4, acc[ai][bj][m][1]), f32x4) * rs[ai][m] * cs[bj][1];
                    if (act) { v0 = silu4(v0); v1 = silu4(v1); }
                    *(u32x4*)(base + (size_t)(row0 + ai * 128 + m * 16) * ld + c0 + bj * 128) = pack8(v0, v1);
                }
                asm volatile("" ::: "memory");
            }
    }
};
struct EpiMergeI8 {
    static constexpr bool PERM = true;
    const unsigned char* wsb; const float* xs; const float* wsc; bf16_t* MG;
    __device__ __forceinline__ void operator()(f32x4 (&acc)[2][2][4][2], const pg8::Unit& u, int wr, int wc, int fr, int fq) const {
        { int l; asm volatile("v_mbcnt_lo_u32_b32 %0, -1, 0\n\tv_mbcnt_hi_u32_b32 %0, -1, %0" : "=v"(l)); fr = l & 15; fq = l >> 4; }
        const int k = u.pn >> 2, br = 2 * k, rowt = u.pm * 256, ct = (u.pn & 3) * 256;
        const unsigned lrow = (unsigned)(wr * 64 + fr), lcol = (unsigned)(wc * 32 + 8 * fq), loff = lrow * 1024u + lcol;
        const float* xsb = xs + rowt; const float* wb = wsc + u.pn * 256;
        const bf16_t* Pt = (const bf16_t*)(wsb + (size_t)(360 + 240 * br) * MiB) + (size_t)rowt * 1024 + ct;
        bf16_t* Mt = MG + (size_t)rowt * 1024 + ct;
        {
            f32x4 cs[2][2];
#pragma unroll
            for (int bj = 0; bj < 2; ++bj)
#pragma unroll
                for (int n = 0; n < 2; ++n) cs[bj][n] = *(const f32x4*)((wb + bj * 128 + 4 * n) + lcol);
#pragma unroll
            for (int ai = 0; ai < 2; ++ai)
#pragma unroll
                for (int m = 0; m < 4; ++m) { const float rsv = (xsb + ai * 128 + m * 16)[lrow];
#pragma unroll
                    for (int bj = 0; bj < 2; ++bj)
#pragma unroll
                        for (int n = 0; n < 2; ++n) acc[ai][bj][m][n] = sig4(__builtin_convertvector(__builtin_bit_cast(i32x4, acc[ai][bj][m][n]), f32x4) * rsv * cs[bj][n]); }
        }
#pragma unroll
        for (int ai = 0; ai < 2; ++ai) {
            u32x4 pv[4][2], av[4][2];
#pragma unroll
            for (int m = 0; m < 4; ++m)
#pragma unroll
                for (int bj = 0; bj < 2; ++bj) { const size_t o = (size_t)(ai * 128 + m * 16) * 1024 + bj * 128;
                    pv[m][bj] = *(const u32x4*)((Pt + o) + loff); if (br != 0) av[m][bj] = *(const u32x4*)((Mt + o) + loff); else av[m][bj] = (u32x4){0u, 0u, 0u, 0u}; }
#pragma unroll
            for (int m = 0; m < 4; ++m)
#pragma unroll
                for (int bj = 0; bj < 2; ++bj) { const size_t o = (size_t)(ai * 128 + m * 16) * 1024 + bj * 128;
                    f32x4 p0, p1, a0, a1; unpack8(pv[m][bj], p0, p1); unpack8(av[m][bj], a0, a1);
                    *(u32x4*)((Mt + o) + loff) = pack8(a0 + acc[ai][bj][m][0] * p0, a1 + acc[ai][bj][m][1] * p1); }
            asm volatile("" ::: "memory");
        }
    }
};
static_assert(WS_GA == 360 * MiB && WS_PX == 840 * MiB, "EpiMergeI8 offset arithmetic");
struct FStoreBf16 { static constexpr bool HAS_LOAD = false; bf16_t* O; int ldc;
    __device__ __forceinline__ void operator()(const pg8::Unit&, int row, int col, f32x4 v0, f32x4 v1) const { *(u32x4*)(O + (size_t)row * ldc + col) = pack8(v0, v1); } };
struct FStorePSX { static constexpr bool HAS_LOAD = false; unsigned char* ws;
    __device__ __forceinline__ void operator()(const pg8::Unit& u, int row, int col, f32x4 v0, f32x4 v1) const {
        const int g = u.pn >> 2; bf16_t* O = (bf16_t*)(ws + (g ? WS_PX : WS_PS));
        *(u32x4*)(O + (size_t)(row - g * NTOK) * 1024 + (col - g * 1024)) = pack8(v0, v1); } };
struct FStoreEC { static constexpr bool HAS_LOAD = false; float* O;
    __device__ __forceinline__ void operator()(const pg8::Unit& u, int row, int col, f32x4 v0, f32x4 v1) const { float* p = O + (size_t)row * 256 + (col - u.pn * 256); *(f32x4*)p = v0; *(f32x4*)(p + 4) = v1; } };
struct FS5Out { static constexpr bool HAS_LOAD = false; bf16_t* YG;
    __device__ __forceinline__ void operator()(const pg8::Unit& u, int row, int col, f32x4 v0, f32x4 v1) const {
        const int g = u.pn >> 2, chunk = row - g * NCHUNK, cl = col - g * 1024, i = cl >> 4, c0 = cl & 15;
        *(u32x4*)(YG + (size_t)(chunk * CH + i) * 512 + g * 16 + c0) = pack8(gelu4(v0), gelu4(v1));
    } };
struct FGlu { static constexpr bool HAS_LOAD = true; const bf16_t* YG; bf16_t* GS; const float* bias;
    struct Ld { u32x4 y, g; };
    __device__ __forceinline__ Ld load(const pg8::Unit&, int row, int col) const { const size_t o = (size_t)row * 512 + col; Ld l; l.y = *(const u32x4*)(YG + o); l.g = *(const u32x4*)(GS + o); return l; }
    __device__ __forceinline__ void apply(const pg8::Unit&, int row, int col, f32x4 v0, f32x4 v1, const Ld& l) const {
        const size_t o = (size_t)row * 512 + col; f32x4 y0, y1, g0, g1; unpack8(l.y, y0, y1); unpack8(l.g, g0, g1);
        const f32x4 b0 = *(const f32x4*)(bias + col), b1 = *(const f32x4*)(bias + col + 4);
        *(u32x4*)(GS + o) = pack8(y0 * sig4(v0 + b0) * g0, y1 * sig4(v1 + b1) * g1);
    } };
static_assert(WS_GA == 360 * MiB && WS_PS == 520 * MiB && WS_PX == 840 * MiB, "FMerge offset arithmetic");
struct FMerge { static constexpr bool HAS_LOAD = true; const unsigned char* wsb; bf16_t* MG; int brofs;
    struct Ld { u32x4 p, a; };
    __device__ __forceinline__ Ld load(const pg8::Unit& u, int row, int col) const {
        const int br = (u.pn >> 2) + brofs, c = col - (u.pn >> 2) * 1024; const size_t o = (size_t)row * 1024 + c;
        const bf16_t* P = (const bf16_t*)(wsb + (size_t)(360 + 160 * br + 160 * (br >> 1)) * MiB);
        Ld l; l.p = *(const u32x4*)(P + o); if (br != 0) l.a = *(const u32x4*)(MG + o); else l.a = (u32x4){0u, 0u, 0u, 0u}; return l;
    }
    __device__ __forceinline__ void apply(const pg8::Unit& u, int row, int col, f32x4 v0, f32x4 v1, const Ld& l) const {
        const int c = col - (u.pn >> 2) * 1024; const size_t o = (size_t)row * 1024 + c;
        f32x4 p0, p1, a0, a1; unpack8(l.p, p0, p1); unpack8(l.a, a0, a1);
        *(u32x4*)(MG + o) = pack8(a0 + sig4(v0) * p0, a1 + sig4(v1) * p1);
    } };
struct EpiOutNorm {
    static constexpr bool PERM = true;
    const float* xp; const float* xs; float* out; const float* gfin; float* rowss; unsigned* cnt;
    __device__ __forceinline__ void operator()(f32x4 (&acc)[2][2][4][2], const pg8::Unit& u, int wr, int wc, int fr, int fq) const {
        { int l; asm volatile("v_mbcnt_lo_u32_b32 %0, -1, 0\n\tv_mbcnt_hi_u32_b32 %0, -1, %0" : "=v"(l)); fr = l & 15; fq = l >> 4; }
        const int rowt = u.pm * 256, col0 = u.pn * 256 + wc * 32 + 8 * fq;
        const float* xb = rowt < NPROMPT ? xp + (size_t)rowt * DM : xs + (size_t)(rowt - NPROMPT) * DM;
        float* ob = out + (size_t)rowt * DM; float* rs = rowss + rowt;
        const unsigned loff = (unsigned)((wr * 64 + fr) * DM + col0), lrow = (unsigned)(wr * 64 + fr);
#pragma unroll
        for (int am = 0; am < 4; ++am) {
            const int ai = am >> 1, mb = (am & 1) * 2;
            const float* xq = xb;
            if (am == 0) asm volatile("" : "+s"(xq));
            else asm volatile("" : "+s"(xq), "+v"(acc[(am - 1) >> 1][1][((am - 1) & 1) * 2 + 1][1]));
            f32x4 xa[2][2][2];
#pragma unroll
            for (int mm = 0; mm < 2; ++mm)
#pragma unroll
                for (int bj = 0; bj < 2; ++bj) { const float* xt = xq + (size_t)(ai * 128 + (mb + mm) * 16) * DM + bj * 128; xa[mm][bj][0] = *(const f32x4*)(xt + loff); xa[mm][bj][1] = *(const f32x4*)(xt + 4 + loff); }
#pragma unroll
            for (int mm = 0; mm < 2; ++mm)
#pragma unroll
                for (int bj = 0; bj < 2; ++bj) { acc[ai][bj][mb + mm][0] += xa[mm][bj][0]; acc[ai][bj][mb + mm][1] += xa[mm][bj][1]; }
            asm volatile("" ::: "memory");
        }
#pragma unroll
        for (int ai = 0; ai < 2; ++ai)
#pragma unroll
            for (int m = 0; m < 4; ++m) { float sq = 0.f;
#pragma unroll
                for (int bj = 0; bj < 2; ++bj)
#pragma unroll
                    for (int n = 0; n < 2; ++n) { const f32x4 v = acc[ai][bj][m][n]; sq += (v[0] * v[0] + v[1] * v[1]) + (v[2] * v[2] + v[3] * v[3]); }
                { auto rr = __builtin_amdgcn_permlane16_swap(__float_as_uint(sq), __float_as_uint(sq), false, false); sq = __uint_as_float(rr[0]) + __uint_as_float(rr[1]); }
                { auto rr = __builtin_amdgcn_permlane32_swap(__float_as_uint(sq), __float_as_uint(sq), false, false); sq = __uint_as_float(rr[0]) + __uint_as_float(rr[1]); }
                if (fq == 0) atomicAdd((rs + ai * 128 + m * 16) + lrow, sq);
            }
        asm volatile("s_waitcnt vmcnt(0)" ::: "memory");
        __syncthreads();
        if (wr == 0 && wc == 0 && fr == 0 && fq == 0) {
            __builtin_amdgcn_fence(__ATOMIC_RELEASE, "agent");
            __hip_atomic_fetch_add(cnt + u.pm, 1u, __ATOMIC_RELAXED, __HIP_MEMORY_SCOPE_AGENT);
            unsigned spins = 0;
            while (__hip_atomic_load(cnt + u.pm, __ATOMIC_RELAXED, __HIP_MEMORY_SCOPE_AGENT) < 4u && ++spins < (1u << 24)) __builtin_amdgcn_s_sleep(1);
            __builtin_amdgcn_fence(__ATOMIC_ACQUIRE, "agent");
        }
        __syncthreads();
        const float* gp = gfin; asm volatile("" : "+s"(gp));
#pragma unroll
        for (int ai = 0; ai < 2; ++ai)
#pragma unroll
            for (int m = 0; m < 4; ++m) {
                const float rstd = rsqrtf(__hip_atomic_load((rs + ai * 128 + m * 16) + lrow, __ATOMIC_RELAXED, __HIP_MEMORY_SCOPE_AGENT) * (1.f / DM) + EPS);
#pragma unroll
                for (int bj = 0; bj < 2; ++bj) { const f32x4 g0 = *(const f32x4*)(gp + col0 + bj * 128), g1 = *(const f32x4*)(gp + col0 + bj * 128 + 4);
                    float* ot = ob + (size_t)(ai * 128 + m * 16) * DM + bj * 128;
                    *(f32x4*)(ot + loff) = acc[ai][bj][m][0] * rstd * g0; *(f32x4*)(ot + 4 + loff) = acc[ai][bj][m][1] * rstd * g1; }
            }
    }
};

namespace att {
constexpr int D = 128, NW = 8, QBLK = 32, KVBLK = 64;
constexpr float SCALE = 0.088388347648318440f, THR = 8.f;
constexpr size_t SHM_V = KVBLK * D * 2, SHM_K = KVBLK * D * 2, SHM_ATTN = 2 * SHM_V + 2 * SHM_K + NW * 64 * 4;
#define KSWZ(row, colB) ((row) * 256 + ((colB) ^ (((row) & 7) << 4)))
#define SBAR() __builtin_amdgcn_sched_barrier(0)
__device__ __forceinline__ int crow(int r, int hi) { return (r & 3) + 8 * (r >> 2) + 4 * hi; }
__device__ __forceinline__ void partialSM(f32x16& p0, f32x16& p1, float& m_reg, float& mn, float& alpha) {
    constexpr float C = SCALE * 1.4426950408889634f;
    float pmax = p0[0];
#pragma unroll
    for (int r = 1; r < 16; ++r) pmax = fmaxf(pmax, p0[r]);
#pragma unroll
    for (int r = 0; r < 16; ++r) pmax = fmaxf(pmax, p1[r]);
    { auto rr = __builtin_amdgcn_permlane32_swap(__float_as_uint(pmax), __float_as_uint(pmax), false, false);
      pmax = fmaxf(__uint_as_float(rr[0]), __uint_as_float(rr[1])); }
    if (__builtin_expect(__all(pmax - m_reg <= THR / SCALE), 1)) { mn = m_reg; alpha = 1.f; }
    else { mn = fmaxf(m_reg, pmax); alpha = __builtin_amdgcn_exp2f((m_reg - mn) * C); m_reg = mn; }
    const float mnC = -mn * C;
#pragma unroll
    for (int r = 0; r < 16; ++r) p0[r] = fmaf(p0[r], C, mnC);
#pragma unroll
    for (int r = 0; r < 16; ++r) p1[r] = fmaf(p1[r], C, mnC);
#pragma unroll
    for (int r = 0; r < 16; ++r) p0[r] = __builtin_amdgcn_exp2f(p0[r]);
}
__device__ __forceinline__ void finishSM(f32x16& p0, f32x16& p1, float alpha, float& l_reg, bf16x8& pa0, bf16x8& pa1, bf16x8& pa2, bf16x8& pa3) {
#pragma unroll
    for (int r = 0; r < 16; ++r) p1[r] = __builtin_amdgcn_exp2f(p1[r]);
    float ps = 0;
#pragma unroll
    for (int r = 0; r < 16; ++r) ps += p0[r];
#pragma unroll
    for (int r = 0; r < 16; ++r) ps += p1[r];
    { auto rr = __builtin_amdgcn_permlane32_swap(__float_as_uint(ps), __float_as_uint(ps), false, false);
      ps = __uint_as_float(rr[0]) + __uint_as_float(rr[1]); }
    l_reg = l_reg * alpha + ps;
#define PK4(P, BASE, OUT) do { unsigned a0 = cvtpk(P[BASE + 0], P[BASE + 1]), a1 = cvtpk(P[BASE + 2], P[BASE + 3]);   \
    unsigned b0 = cvtpk(P[BASE + 4], P[BASE + 5]), b1 = cvtpk(P[BASE + 6], P[BASE + 7]);                              \
    auto r0 = __builtin_amdgcn_permlane32_swap(a0, b0, false, false); auto r1 = __builtin_amdgcn_permlane32_swap(a1, b1, false, false); \
    u32x4 w = {r0[0], r1[0], r0[1], r1[1]}; OUT = *reinterpret_cast<bf16x8*>(&w); } while (0)
    PK4(p0, 0, pa0); PK4(p0, 8, pa1); PK4(p1, 0, pa2); PK4(p1, 8, pa3);
#undef PK4
}
__device__ __forceinline__ void qkt(f32x16& p0, f32x16& p1, const bf16_t* Ks, const bf16x8* qr, int r32, int hi) {
    p0 = f32x16{}; p1 = f32x16{};
#pragma unroll
    for (int d0 = 0; d0 < 8; ++d0) { const int cb = (d0 * 16 + hi * 8) * 2;
        bf16x8 b0 = *reinterpret_cast<const bf16x8*>((const char*)Ks + KSWZ(r32, cb));
        bf16x8 b1 = *reinterpret_cast<const bf16x8*>((const char*)Ks + KSWZ(32 + r32, cb));
        p0 = __builtin_amdgcn_mfma_f32_32x32x16_bf16(b0, qr[d0], p0, 0, 0, 0);
        p1 = __builtin_amdgcn_mfma_f32_32x32x16_bf16(b1, qr[d0], p1, 0, 0, 0); }
}
__device__ __forceinline__ int v_st(int k, int c) { const int kk = (k & ~0xC) | ((k & 4) << 1) | ((k & 8) >> 1); return ((kk >> 3) * 4 + (c >> 5)) * 512 + ((kk & 7) * 32 + (c & 31)) * 2; }
__device__ __forceinline__ int v_rd_base(int lane) { return ((lane & 3) << 3) | (((lane >> 2) & 3) << 6) | (((lane >> 4) & 1) << 5) | (((lane >> 5) & 1) << 8); }
constexpr int v_rd_off(int d0, int ks, int half) { return d0 * 512 + ks * 4096 + half * 2048; }
template <int OFF> __device__ __forceinline__ s16x4 tr_read(int vb) {
    s16x4 r; asm volatile("ds_read_b64_tr_b16 %0, %1 offset:%2" : "=&v"(r) : "v"(vb), "i"(OFF) : "memory"); return r;
}
template <int D0> __device__ __forceinline__ void pv_one(f32x16& od, int vb, bf16x8 pa0, bf16x8 pa1, bf16x8 pa2, bf16x8 pa3) {
    const s16x4 l0 = tr_read<v_rd_off(D0, 0, 0)>(vb), h0 = tr_read<v_rd_off(D0, 0, 1)>(vb), l1 = tr_read<v_rd_off(D0, 1, 0)>(vb), h1 = tr_read<v_rd_off(D0, 1, 1)>(vb);
    const s16x4 l2 = tr_read<v_rd_off(D0, 2, 0)>(vb), h2 = tr_read<v_rd_off(D0, 2, 1)>(vb), l3 = tr_read<v_rd_off(D0, 3, 0)>(vb), h3 = tr_read<v_rd_off(D0, 3, 1)>(vb);
    asm volatile("s_waitcnt lgkmcnt(0)" ::: "memory"); SBAR();
#define PK(L, H) (bf16x8){L[0], L[1], L[2], L[3], H[0], H[1], H[2], H[3]}
    od = __builtin_amdgcn_mfma_f32_32x32x16_bf16(pa0, PK(l0, h0), od, 0, 0, 0);
    od = __builtin_amdgcn_mfma_f32_32x32x16_bf16(pa1, PK(l1, h1), od, 0, 0, 0);
    od = __builtin_amdgcn_mfma_f32_32x32x16_bf16(pa2, PK(l2, h2), od, 0, 0, 0);
    od = __builtin_amdgcn_mfma_f32_32x32x16_bf16(pa3, PK(l3, h3), od, 0, 0, 0);
#undef PK
}
__device__ __forceinline__ void pv_d0(f32x16* o, int vb, bf16x8 pa0, bf16x8 pa1, bf16x8 pa2, bf16x8 pa3) {
    pv_one<0>(o[0], vb, pa0, pa1, pa2, pa3); pv_one<1>(o[1], vb, pa0, pa1, pa2, pa3); pv_one<2>(o[2], vb, pa0, pa1, pa2, pa3); pv_one<3>(o[3], vb, pa0, pa1, pa2, pa3);
}


__device__ __forceinline__ void qkt_i8(f32x16& p0, f32x16& p1, const unsigned char* Ks, const i32x4* qi, const i32x16& cinit, int r32, int hi) {
    i32x16 a0, a1; const int sw = ((r32 >> 1) & 7) << 4;
#pragma unroll
    for (int m = 0; m < 4; ++m) { const int cb = m * 32 + hi * 16;
        const i32x4 b0 = *reinterpret_cast<const i32x4*>(Ks + r32 * 128 + (cb ^ sw));
        const i32x4 b1 = *reinterpret_cast<const i32x4*>(Ks + (32 + r32) * 128 + (cb ^ sw));
        if (m == 0) { a0 = __builtin_amdgcn_mfma_i32_32x32x32_i8(b0, qi[0], cinit, 0, 0, 0); a1 = __builtin_amdgcn_mfma_i32_32x32x32_i8(b1, qi[0], cinit, 0, 0, 0); }
        else { a0 = __builtin_amdgcn_mfma_i32_32x32x32_i8(b0, qi[m], a0, 0, 0, 0); a1 = __builtin_amdgcn_mfma_i32_32x32x32_i8(b1, qi[m], a1, 0, 0, 0); } }
    p0 = __builtin_bit_cast(f32x16, a0); p1 = __builtin_bit_cast(f32x16, a1);
}
__device__ __forceinline__ void partialSM_i8(f32x16& p0, f32x16& p1, float& m_reg, float& mn, float& alpha, float dq, float Cq, float Kq) {
    constexpr float C = SCALE * 1.4426950408889634f;
    float pmax = p0[0];
#pragma unroll
    for (int r = 1; r < 16; ++r) pmax = fmaxf(pmax, p0[r]);
#pragma unroll
    for (int r = 0; r < 16; ++r) pmax = fmaxf(pmax, p1[r]);
    { auto rr = __builtin_amdgcn_permlane32_swap(__float_as_uint(pmax), __float_as_uint(pmax), false, false);
      pmax = fmaxf(__uint_as_float(rr[0]), __uint_as_float(rr[1])); }
    const float pm = (pmax - 12582912.f) * dq;
    if (__builtin_expect(__all(pm - m_reg <= 4.f / SCALE), 1)) { mn = m_reg; alpha = 1.f; }
    else { mn = fmaxf(m_reg, pm); alpha = __builtin_amdgcn_exp2f((m_reg - mn) * C); m_reg = mn; }
    const float mnC = 3.f - (Kq + mn * C);
#pragma unroll
    for (int r = 0; r < 16; ++r) p0[r] = fmaf(p0[r], Cq, mnC);
#pragma unroll
    for (int r = 0; r < 16; ++r) p1[r] = fmaf(p1[r], Cq, mnC);
#pragma unroll
    for (int r = 0; r < 16; ++r) p0[r] = __builtin_amdgcn_exp2f(p0[r]);
}


typedef int i32x8 __attribute__((ext_vector_type(8)));
__device__ __forceinline__ void finishSM_f8(f32x16& p0, f32x16& p1, float alpha, float& l_reg, i32x8& pa8) {
#pragma unroll
    for (int r = 0; r < 16; ++r) p1[r] = __builtin_amdgcn_exp2f(p1[r]);
    float ps = 0;
#pragma unroll
    for (int r = 0; r < 16; ++r) ps += p0[r];
#pragma unroll
    for (int r = 0; r < 16; ++r) ps += p1[r];
    { auto rr = __builtin_amdgcn_permlane32_swap(__float_as_uint(ps), __float_as_uint(ps), false, false);
      ps = __uint_as_float(rr[0]) + __uint_as_float(rr[1]); }
    l_reg = l_reg * alpha + ps;
#pragma unroll
    for (int d = 0; d < 4; ++d) { int w = __builtin_amdgcn_cvt_pk_fp8_f32(p0[4 * d], p0[4 * d + 1], 0, false); pa8[d] = __builtin_amdgcn_cvt_pk_fp8_f32(p0[4 * d + 2], p0[4 * d + 3], w, true); }
#pragma unroll
    for (int d = 0; d < 4; ++d) { int w = __builtin_amdgcn_cvt_pk_fp8_f32(p1[4 * d], p1[4 * d + 1], 0, false); pa8[4 + d] = __builtin_amdgcn_cvt_pk_fp8_f32(p1[4 * d + 2], p1[4 * d + 3], w, true); }
}
__device__ __forceinline__ void pv8(f32x16* o, const unsigned char* Vs, i32x8 pa8, int r32, int hi) {
#pragma unroll
    for (int cb = 0; cb < 4; ++cb) { const int c = cb * 32 + r32, sw = (c >> 2) & 3;
        const u32x4 b0 = *(const u32x4*)(Vs + c * 64 + (((2 * hi) ^ sw) << 4)), b1 = *(const u32x4*)(Vs + c * 64 + (((2 * hi + 1) ^ sw) << 4));
        const i32x8 b8 = {(int)b0.x, (int)b0.y, (int)b0.z, (int)b0.w, (int)b1.x, (int)b1.y, (int)b1.z, (int)b1.w};
        o[cb] = __builtin_amdgcn_mfma_scale_f32_32x32x64_f8f6f4(pa8, b8, o[cb], 0, 0, 0, 0x7F7F7F7F, 0, 0x7F7F7F7F); }
}

template <int LDQ, int LDK>
__device__ __forceinline__ void attn_unit_i8(const bf16_t* Qb, const unsigned char* __restrict__ K8h, const unsigned char* __restrict__ V8h, const bf16_t* Gb, unsigned char* O8,
                                          int seq, char* lds, int t0, const float* __restrict__ qw, const float* __restrict__ cosT, const float* __restrict__ sinT, float sk, int wv) {
    const int tid = opaque_tid(wv), wid = __builtin_amdgcn_readfirstlane(tid >> 6), lane = tid & 63, r32 = lane & 31, hi = lane >> 5;
    unsigned char* V_lds = (unsigned char*)lds; unsigned char* K_lds = (unsigned char*)(lds + 16384);
    float* wsl = (float*)(lds + 65536) + wid * 64; float* li_l = wsl; float* al_l = wsl + 32;
    float m_reg = -1e30f, l_reg = 0; f32x16 o[4] = {}; i32x4 qi[4];
    const int kr = tid >> 3, kp = tid & 7, kst = kr * 128 + ((kp ^ ((kr >> 1) & 7)) << 4);
    struct { u32x4 vs, ks; } sr_[2];
#define SLOAD(i, k0) do { sr_[i].vs = *(const u32x4*)(V8h + (size_t)((k0) >> 6) * 16384 + tid * 16); \
    sr_[i].ks = *(const u32x4*)(K8h + (long)((k0) + kr) * 256 + kp * 16); } while (0)
#define SWRITE(b, i) do { *(u32x4*)(V_lds + (b) * 8192 + tid * 16) = sr_[i].vs; *(u32x4*)(K_lds + (b) * 8192 + kst) = sr_[i].ks; } while (0)
#define SWAIT() asm volatile("s_waitcnt vmcnt(2)" ::: "memory")
#define RESC(a) do { if (__any((a) < 1.f)) { if (hi == 0) al_l[r32] = (a); asm volatile("s_waitcnt lgkmcnt(0)" ::: "memory"); \
    _Pragma("unroll") for (int d = 0; d < 4; ++d) _Pragma("unroll") for (int r = 0; r < 16; ++r) o[d][r] *= al_l[crow(r, hi)]; } } while (0)
    f32x16 pA0, pA1, pB0, pB1; float mnA, mnB, alA, alB; i32x8 pa8; const int NT = seq / KVBLK;
    constexpr int SE = 0, SO = 1;
    SLOAD(SE, 0); SLOAD(SO, KVBLK);
    const bf16_t* Qw = Qb + (long)(wid * QBLK + r32) * LDQ + hi * 8;
    float dq, Cq, Kq; i32x16 cinit;
    {
        bf16x8 qraw[8];
#pragma unroll
        for (int d0 = 0; d0 < 8; ++d0) qraw[d0] = *reinterpret_cast<const bf16x8*>(Qw + d0 * 16);
        float ss = 0.f;
#pragma unroll
        for (int d0 = 0; d0 < 8; ++d0)
#pragma unroll
            for (int j = 0; j < 8; ++j) { const float x = bf2f((bf16_t)qraw[d0][j]); ss += x * x; }
        { auto rr = __builtin_amdgcn_permlane32_swap(__float_as_uint(ss), __float_as_uint(ss), false, false); ss = __uint_as_float(rr[0]) + __uint_as_float(rr[1]); }
        const float rstd = rsqrtf(ss * (1.f / 128.f) + EPS);
        const int t = t0 + wid * QBLK + r32;
        float xq[8][8]; float amax = 1e-20f;
#pragma unroll
        for (int d0 = 0; d0 < 8; ++d0) {
            const int pos = (d0 < 4) ? (t >> 6) : (t & 63);
            const f32x4 cs = *(const f32x4*)(cosT + pos * 32 + (d0 & 3) * 8 + hi * 4), sn = *(const f32x4*)(sinT + pos * 32 + (d0 & 3) * 8 + hi * 4);
            const f32x4 w0 = *(const f32x4*)(qw + d0 * 16 + hi * 8), w1 = *(const f32x4*)(qw + d0 * 16 + hi * 8 + 4);
            float x[8];
#pragma unroll
            for (int j = 0; j < 8; ++j) x[j] = bf2f((bf16_t)qraw[d0][j]) * rstd * (j < 4 ? w0[j] : w1[j - 4]);
#pragma unroll
            for (int pr = 0; pr < 4; ++pr) { xq[d0][2 * pr] = x[2 * pr] * cs[pr] - x[2 * pr + 1] * sn[pr]; xq[d0][2 * pr + 1] = x[2 * pr] * sn[pr] + x[2 * pr + 1] * cs[pr]; }
#pragma unroll
            for (int j = 0; j < 8; ++j) amax = fmaxf(amax, fabsf(xq[d0][j]));
        }
        { auto rr = __builtin_amdgcn_permlane32_swap(__float_as_uint(amax), __float_as_uint(amax), false, false); amax = fmaxf(__uint_as_float(rr[0]), __uint_as_float(rr[1])); }
        const float qinv = 127.f / amax;
        dq = amax * (1.f / 127.f) * sk; Cq = dq * (SCALE * 1.4426950408889634f); Kq = 12582912.f * Cq;
#pragma unroll
        for (int m = 0; m < 4; ++m) {
            unsigned w[4];
#pragma unroll
            for (int hf = 0; hf < 2; ++hf)
#pragma unroll
                for (int g4 = 0; g4 < 2; ++g4) { const float* xv = &xq[2 * m + hf][4 * g4];
                    const int a = (int)rintf(xv[0] * qinv), b = (int)rintf(xv[1] * qinv), c = (int)rintf(xv[2] * qinv), d = (int)rintf(xv[3] * qinv);
                    w[hf * 2 + g4] = (unsigned)(a & 255) | ((unsigned)(b & 255) << 8) | ((unsigned)(c & 255) << 16) | ((unsigned)d << 24); }
            qi[m] = (i32x4){(int)w[0], (int)w[1], (int)w[2], (int)w[3]};
        }
#pragma unroll
        for (int r = 0; r < 16; ++r) cinit[r] = 0x4B400000;
        asm volatile("" : "+v"(cinit));
    }
    asm volatile("s_waitcnt vmcnt(0)" ::: "memory"); SWRITE(0, SE); __syncthreads();
    qkt_i8(pA0, pA1, K_lds, qi, cinit, r32, hi); partialSM_i8(pA0, pA1, m_reg, mnA, alA, dq, Cq, Kq);
    SLOAD(SE, 2 * KVBLK);
    SWRITE(1, SO); __syncthreads();
    if (wid >= 4) __builtin_amdgcn_s_setprio(1);
    for (int j = 1; j + 1 < NT; j += 2) {
        SBAR(); qkt_i8(pB0, pB1, K_lds + 8192, qi, cinit, r32, hi);
        finishSM_f8(pA0, pA1, alA, l_reg, pa8); SBAR();
        SLOAD(SO, (j + 2) * KVBLK); SBAR();
        pv8(o, V_lds, pa8, r32, hi); partialSM_i8(pB0, pB1, m_reg, mnB, alB, dq, Cq, Kq);
        __syncthreads(); SWAIT(); SWRITE(0, SE);
        RESC(alB); __syncthreads();
        SBAR(); qkt_i8(pA0, pA1, K_lds, qi, cinit, r32, hi);
        finishSM_f8(pB0, pB1, alB, l_reg, pa8); SBAR();
        SLOAD(SE, (j + 3) * KVBLK); SBAR();
        pv8(o, V_lds + 8192, pa8, r32, hi); partialSM_i8(pA0, pA1, m_reg, mnA, alA, dq, Cq, Kq);
        __syncthreads(); SWAIT(); SWRITE(1, SO);
        RESC(alA); __syncthreads();
    }
    SBAR(); qkt_i8(pB0, pB1, K_lds + 8192, qi, cinit, r32, hi);
    finishSM_f8(pA0, pA1, alA, l_reg, pa8); SBAR();
    pv8(o, V_lds, pa8, r32, hi); partialSM_i8(pB0, pB1, m_reg, mnB, alB, dq, Cq, Kq);
    __syncthreads(); RESC(alB);
    finishSM_f8(pB0, pB1, alB, l_reg, pa8); SBAR();
    pv8(o, V_lds + 8192, pa8, r32, hi);
    __builtin_amdgcn_s_setprio(0);
    int l2; asm volatile("v_mbcnt_lo_u32_b32 %0, -1, 0\n\tv_mbcnt_hi_u32_b32 %0, -1, %0" : "=v"(l2));
    const int hi2 = l2 >> 5, r322 = l2 & 31;
    if (hi2 == 0) li_l[r322] = l_reg; asm volatile("s_waitcnt lgkmcnt(0)" ::: "memory");
    float rli[16];
#pragma unroll
    for (int r = 0; r < 16; ++r) rli[r] = __builtin_amdgcn_rcpf(li_l[crow(r, hi2)]);
    unsigned char* O8w = O8 + (long)(wid * QBLK) * LDQ; const bf16_t* Gw = Gb + (long)(wid * QBLK) * LDQ;
    constexpr float osc = (LDQ == 1024) ? 64.f : 16.f;
    __syncthreads();
    bf16_t* stg = (bf16_t*)lds + wid * 4096;
#pragma unroll
    for (int r = 0; r < 16; ++r) { const int orow = crow(r, hi2);
#pragma unroll
        for (int d0 = 0; d0 < 4; ++d0) stg[orow * 128 + d0 * 32 + r322] = (bf16_t)(cvtpk(o[d0][r] * rli[r], 0.f) & 0xffffu); }
    asm volatile("s_waitcnt lgkmcnt(0)" ::: "memory");
    const unsigned lo2 = (unsigned)((l2 >> 4) * LDQ + (l2 & 15) * 8);
    u32x4 gv[8], ov[8];
#pragma unroll
    for (int i = 0; i < 8; ++i) gv[i] = *(const u32x4*)((Gw + i * 4 * LDQ) + lo2);
#pragma unroll
    for (int i = 0; i < 8; ++i) ov[i] = *(const u32x4*)(stg + (i * 4 + (l2 >> 4)) * 128 + (l2 & 15) * 8);
#pragma unroll
    for (int i = 0; i < 8; ++i) {
        int w0 = __builtin_amdgcn_cvt_pk_fp8_f32(bflo(ov[i].x) * bflo(gv[i].x) * osc, bfhi(ov[i].x) * bfhi(gv[i].x) * osc, 0, false);
        w0 = __builtin_amdgcn_cvt_pk_fp8_f32(bflo(ov[i].y) * bflo(gv[i].y) * osc, bfhi(ov[i].y) * bfhi(gv[i].y) * osc, w0, true);
        int w1 = __builtin_amdgcn_cvt_pk_fp8_f32(bflo(ov[i].z) * bflo(gv[i].z) * osc, bfhi(ov[i].z) * bfhi(gv[i].z) * osc, 0, false);
        w1 = __builtin_amdgcn_cvt_pk_fp8_f32(bflo(ov[i].w) * bflo(gv[i].w) * osc, bfhi(ov[i].w) * bfhi(gv[i].w) * osc, w1, true);
        *(u32x2*)((O8w + i * 4 * LDQ) + lo2) = (u32x2){(unsigned)w0, (unsigned)w1}; }
    __syncthreads();
#undef SLOAD
#undef SWRITE
#undef SWAIT
#undef RESC
}

template <bool ROPE, int LDQ, int LDK>
__device__ __forceinline__ void attn_unit(const bf16_t* Qb, const bf16_t* __restrict__ Kh, const bf16_t* __restrict__ Vh, const bf16_t* Gb, bf16_t* Ob,
                                          int seq, char* lds, int t0, const float* __restrict__ qw, const float* __restrict__ cosT, const float* __restrict__ sinT, int wv) {
    const int tid = opaque_tid(wv), wid = __builtin_amdgcn_readfirstlane(tid >> 6), lane = tid & 63, r32 = lane & 31, hi = lane >> 5;
    bf16_t* V_lds = (bf16_t*)lds; bf16_t* K_lds = (bf16_t*)(lds + 2 * SHM_V);
    float* wsl = (float*)(lds + 2 * SHM_V + 2 * SHM_K) + wid * 64; float* li_l = wsl; float* al_l = wsl + 32;
    float m_reg = -1e30f, l_reg = 0; f32x16 o[4] = {}; bf16x8 qr[8];
    const int sr = tid >> 4, sc = (tid & 15) * 8, vst0 = v_st(sr, sc), vst1 = v_st(32 + sr, sc);
    const int vb0 = (int)(uintptr_t)V_lds + v_rd_base(lane);
    struct { bf16x8 vs0, vs1, ks0, ks1; } sr_[2];
#define SLOAD(i, k0) do { sr_[i].vs0 = *(const bf16x8*)(&Vh[(long)((k0) + sr) * LDK + sc]); sr_[i].vs1 = *(const bf16x8*)(&Vh[(long)((k0) + 32 + sr) * LDK + sc]); \
    sr_[i].ks0 = *(const bf16x8*)(&Kh[(long)((k0) + sr) * LDK + sc]); sr_[i].ks1 = *(const bf16x8*)(&Kh[(long)((k0) + 32 + sr) * LDK + sc]); } while (0)
#define SWRITE(b, i) do { *(bf16x8*)((char*)V_lds + (b) * SHM_V + vst0) = sr_[i].vs0;          \
    *(bf16x8*)((char*)V_lds + (b) * SHM_V + vst1) = sr_[i].vs1; int kc = sc * 2;               \
    *(bf16x8*)((char*)K_lds + (b) * SHM_K + KSWZ(sr, kc)) = sr_[i].ks0;                       \
    *(bf16x8*)((char*)K_lds + (b) * SHM_K + KSWZ(32 + sr, kc)) = sr_[i].ks1; } while (0)
#define SWAIT() asm volatile("s_waitcnt vmcnt(4)" ::: "memory")
#define RESC(a) do { if (__any((a) < 1.f)) { if (hi == 0) al_l[r32] = (a); asm volatile("s_waitcnt lgkmcnt(0)" ::: "memory"); \
    _Pragma("unroll") for (int d = 0; d < 4; ++d) _Pragma("unroll") for (int r = 0; r < 16; ++r) o[d][r] *= al_l[crow(r, hi)]; } } while (0)
    f32x16 pA0, pA1, pB0, pB1; float mnA, mnB, alA, alB; bf16x8 pa0, pa1, pa2, pa3; const int NT = seq / KVBLK;
    constexpr int SE = 0, SO = 1;
    SLOAD(SE, 0); SLOAD(SO, KVBLK);
    const bf16_t* Qw = Qb + (long)(wid * QBLK + r32) * LDQ + hi * 8;
#pragma unroll
    for (int d0 = 0; d0 < 8; ++d0) qr[d0] = *reinterpret_cast<const bf16x8*>(Qw + d0 * 16);
    if constexpr (ROPE) {
        float ss = 0.f;
#pragma unroll
        for (int d0 = 0; d0 < 8; ++d0)
#pragma unroll
            for (int j = 0; j < 8; ++j) { const float x = bf2f((bf16_t)qr[d0][j]); ss += x * x; }
        { auto rr = __builtin_amdgcn_permlane32_swap(__float_as_uint(ss), __float_as_uint(ss), false, false); ss = __uint_as_float(rr[0]) + __uint_as_float(rr[1]); }
        const float rstd = rsqrtf(ss * (1.f / 128.f) + EPS);
        const int t = t0 + wid * QBLK + r32;
#pragma unroll
        for (int d0 = 0; d0 < 8; ++d0) {
            const int pos = (d0 < 4) ? (t >> 6) : (t & 63);
            const f32x4 cs = *(const f32x4*)(cosT + pos * 32 + (d0 & 3) * 8 + hi * 4), sn = *(const f32x4*)(sinT + pos * 32 + (d0 & 3) * 8 + hi * 4);
            const f32x4 w0 = *(const f32x4*)(qw + d0 * 16 + hi * 8), w1 = *(const f32x4*)(qw + d0 * 16 + hi * 8 + 4);
            float x[8];
#pragma unroll
            for (int j = 0; j < 8; ++j) x[j] = bf2f((bf16_t)qr[d0][j]) * rstd * (j < 4 ? w0[j] : w1[j - 4]);
            u32x4 w;
            w.x = cvtpk(x[0] * cs[0] - x[1] * sn[0], x[0] * sn[0] + x[1] * cs[0]);
            w.y = cvtpk(x[2] * cs[1] - x[3] * sn[1], x[2] * sn[1] + x[3] * cs[1]);
            w.z = cvtpk(x[4] * cs[2] - x[5] * sn[2], x[4] * sn[2] + x[5] * cs[2]);
            w.w = cvtpk(x[6] * cs[3] - x[7] * sn[3], x[6] * sn[3] + x[7] * cs[3]);
            qr[d0] = *reinterpret_cast<bf16x8*>(&w);
        }
    }
    asm volatile("s_waitcnt vmcnt(0)" ::: "memory"); SWRITE(0, SE); __syncthreads();
    qkt(pA0, pA1, K_lds, qr, r32, hi); partialSM(pA0, pA1, m_reg, mnA, alA);
    SLOAD(SE, 2 * KVBLK);
    SWRITE(1, SO); __syncthreads();
    if (wid >= 4) __builtin_amdgcn_s_setprio(1);
    for (int j = 1; j + 1 < NT; j += 2) {
        SBAR(); qkt(pB0, pB1, (bf16_t*)((char*)K_lds + SHM_K), qr, r32, hi);
        finishSM(pA0, pA1, alA, l_reg, pa0, pa1, pa2, pa3); SBAR();
        SLOAD(SO, (j + 2) * KVBLK); SBAR();
        pv_d0(o, vb0, pa0, pa1, pa2, pa3); partialSM(pB0, pB1, m_reg, mnB, alB);
        __syncthreads(); SWAIT(); SWRITE(0, SE);
        RESC(alB); __syncthreads();
        SBAR(); qkt(pA0, pA1, K_lds, qr, r32, hi);
        finishSM(pB0, pB1, alB, l_reg, pa0, pa1, pa2, pa3); SBAR();
        SLOAD(SE, (j + 3) * KVBLK); SBAR();
        pv_d0(o, vb0 + (int)SHM_V, pa0, pa1, pa2, pa3); partialSM(pA0, pA1, m_reg, mnA, alA);
        __syncthreads(); SWAIT(); SWRITE(1, SO);
        RESC(alA); __syncthreads();
    }
    SBAR(); qkt(pB0, pB1, (bf16_t*)((char*)K_lds + SHM_K), qr, r32, hi);
    finishSM(pA0, pA1, alA, l_reg, pa0, pa1, pa2, pa3); SBAR();
    pv_d0(o, vb0, pa0, pa1, pa2, pa3); partialSM(pB0, pB1, m_reg, mnB, alB);
    __syncthreads(); RESC(alB);
    finishSM(pB0, pB1, alB, l_reg, pa0, pa1, pa2, pa3); SBAR();
    pv_d0(o, vb0 + (int)SHM_V, pa0, pa1, pa2, pa3);
    __builtin_amdgcn_s_setprio(0);
    int l2; asm volatile("v_mbcnt_lo_u32_b32 %0, -1, 0\n\tv_mbcnt_hi_u32_b32 %0, -1, %0" : "=v"(l2));
    const int hi2 = l2 >> 5, r322 = l2 & 31;
    if (hi2 == 0) li_l[r322] = l_reg; asm volatile("s_waitcnt lgkmcnt(0)" ::: "memory");
    float rli[16];
#pragma unroll
    for (int r = 0; r < 16; ++r) rli[r] = __builtin_amdgcn_rcpf(li_l[crow(r, hi2)]);
    bf16_t* Ow = Ob + (long)(wid * QBLK) * LDQ; const bf16_t* Gw = Gb + (long)(wid * QBLK) * LDQ;
    __syncthreads();
    bf16_t* stg = (bf16_t*)lds + wid * 4096;
#pragma unroll
    for (int r = 0; r < 16; ++r) { const int orow = crow(r, hi2);
#pragma unroll
        for (int d0 = 0; d0 < 4; ++d0) stg[orow * 128 + d0 * 32 + r322] = (bf16_t)(cvtpk(o[d0][r] * rli[r], 0.f) & 0xffffu); }
    asm volatile("s_waitcnt lgkmcnt(0)" ::: "memory");
    const unsigned lo2 = (unsigned)((l2 >> 4) * LDQ + (l2 & 15) * 8);
    u32x4 gv[8], ov[8];
#pragma unroll
    for (int i = 0; i < 8; ++i) gv[i] = *(const u32x4*)((Gw + i * 4 * LDQ) + lo2);
#pragma unroll
    for (int i = 0; i < 8; ++i) ov[i] = *(const u32x4*)(stg + (i * 4 + (l2 >> 4)) * 128 + (l2 & 15) * 8);
#pragma unroll
    for (int i = 0; i < 8; ++i) { u32x4 w;
        w.x = cvtpk(bflo(ov[i].x) * bflo(gv[i].x), bfhi(ov[i].x) * bfhi(gv[i].x)); w.y = cvtpk(bflo(ov[i].y) * bflo(gv[i].y), bfhi(ov[i].y) * bfhi(gv[i].y));
        w.z = cvtpk(bflo(ov[i].z) * bflo(gv[i].z), bfhi(ov[i].z) * bfhi(gv[i].z)); w.w = cvtpk(bflo(ov[i].w) * bflo(gv[i].w), bfhi(ov[i].w) * bfhi(gv[i].w));
        *(u32x4*)((Ow + i * 4 * LDQ) + lo2) = w; }
    __syncthreads();
#undef SLOAD
#undef SWRITE
#undef SWAIT
#undef RESC
}
#undef KSWZ
#undef SBAR
}

struct Params {
    const float* in[25];
    float* out; unsigned char* ws;
};

__device__ __forceinline__ void transpose_item(const float* __restrict__ W, int K, int N, bf16_t* __restrict__ WT, LAS float* scr, int item, int lane) {
    const int nblk = N / 32, kb = item / nblk, nb = item % nblk, k0 = 64 * kb, n0 = 32 * nb;
#pragma unroll 8
    for (int i = 0; i < 32; ++i) { const int kk = 2 * i + (lane >> 5); scr[kk * 33 + (lane & 31)] = W[(size_t)(k0 + kk) * N + n0 + (lane & 31)]; }
    asm volatile("s_waitcnt lgkmcnt(0)" ::: "memory");
    const int c = lane & 7;
#pragma unroll
    for (int j = 0; j < 4; ++j) { const int n = (lane >> 3) + 8 * j; const LAS float* s = scr + (8 * c) * 33 + n;
        u32x4 o; o.x = cvtpk(s[0 * 33], s[1 * 33]); o.y = cvtpk(s[2 * 33], s[3 * 33]); o.z = cvtpk(s[4 * 33], s[5 * 33]); o.w = cvtpk(s[6 * 33], s[7 * 33]);
        *(u32x4*)(WT + (size_t)(n0 + n) * K + k0 + 8 * c) = o; }
    asm volatile("s_waitcnt lgkmcnt(0)" ::: "memory");
}
__device__ __forceinline__ void rms_row_bf16(const float* __restrict__ xrow, const float* __restrict__ g, bf16_t* __restrict__ orow, int lane) {
    const f32x4* xr = (const f32x4*)xrow + lane; f32x4 v[4]; float s = 0.f;
#pragma unroll
    for (int j = 0; j < 4; ++j) { v[j] = xr[64 * j]; s += (v[j].x * v[j].x + v[j].y * v[j].y) + (v[j].z * v[j].z + v[j].w * v[j].w); }
    const float rstd = rsqrtf(wave_sum(s) * (1.f / DM) + EPS);
    u32x2* o8 = (u32x2*)orow + lane;
#pragma unroll
    for (int j = 0; j < 4; ++j) { const f32x4 gw = ((const f32x4*)g)[lane + 64 * j]; u32x2 w; w.x = cvtpk(v[j].x * rstd * gw.x, v[j].y * rstd * gw.y); w.y = cvtpk(v[j].z * rstd * gw.z, v[j].w * rstd * gw.w); o8[64 * j] = w; }
}

#ifndef PHMASK
#define PHMASK 0xFFF
#endif
#define PHON(n) (((PHMASK) >> (n)) & 1)
__global__ void __launch_bounds__(512, 2) hybrid_fwd(Params P) {
    extern __shared__ __attribute__((aligned(16))) unsigned char lds[];
    cg::grid_group grid = cg::this_grid();
    LAS unsigned char* ldsl = (LAS unsigned char*)lds;
    const int G = gridDim.x, bid = blockIdx.x, wv = __builtin_amdgcn_readfirstlane(threadIdx.x >> 6);
    const int vcu = (G % 8 == 0) ? (bid % 8) * (G / 8) + bid / 8 : bid;
    const int NGW = G * 8; const long NGT = (long)G * 512;
#ifndef PROBE
#define PROBE 0
#endif
#define PROBE_A0 10
#define PROBE_A1 11
#define PROBE_B0 8
#define PROBE_B1 9
#define STAMP(k) do { if (PROBE) { if (bid == 0 && opaque_tid(wv) == 0) ((unsigned long long*)(ws + 768 * 1024))[k] = __builtin_amdgcn_s_memrealtime(); } } while (0)
#define PHASE_IDS const int tid = opaque_tid(wv), lane = tid & 63, wave = __builtin_amdgcn_readfirstlane(tid >> 6), gw = bid * 8 + wave; const long gtid = (long)bid * 512 + tid; (void)lane; (void)gw; (void)gtid;
    unsigned char* ws = P.ws; unsigned char* dob = (unsigned char*)P.out;
    const float* xp = P.in[0]; const float* xs = P.in[1];
    const float *a_re = P.in[8], *a_im = P.in[9], *b_re = P.in[10], *b_im = P.in[11], *c_re = P.in[12], *c_im = P.in[13], *lstep = P.in[14], *s5d = P.in[15];
    float* cosT = (float*)(ws + WS_COS); float* sinT = (float*)(ws + WS_SIN); float* KT = (float*)(ws + WS_KT);
    bf16_t* WIN = (bf16_t*)(ws + WS_WIN); bf16_t* XN = (bf16_t*)(ws + WS_XN);
#define XN8 (dob + DO_XN8)
#define XS ((float*)(ws + WS_XS))
#define W8 (ws + WS_W8)
#define WSC ((float*)(ws + WS_WSC))
    bf16_t* AG = (bf16_t*)(dob + DO_AG); bf16_t* WG = (bf16_t*)(dob + DO_WG); bf16_t* WE = (bf16_t*)(dob + DO_WE); float* EC = (float*)(dob + DO_EC);

    STAMP(0);
    if constexpr (PHON(0))
    {
        PHASE_IDS
        LAS float* scr = (LAS float*)(ldsl + wave * 16384);
        constexpr int I_IN = 16 * 240, I_MKV = 16 * 32, I_PA = 16 * 32, I_PS = 8 * 32, I_PX = 8 * 32, I_OUT = 16 * 32, I_GLU = 8 * 16;
        constexpr int NITEMS = I_IN + I_MKV + I_PA + I_PS + I_PX + I_OUT + I_GLU;
        for (int it = gw; it < NITEMS; it += NGW) {
            int r = it;
            if (r < I_IN) { transpose_item(P.in[5], 1024, 7680, WIN, scr, r, lane); continue; } r -= I_IN;
            if (r < I_MKV) { transpose_item(P.in[19], 1024, 1024, (bf16_t*)(ws + WS_WMKV), scr, r, lane); continue; } r -= I_MKV;
            if (r < I_PA) { transpose_item(P.in[20], 1024, 1024, (bf16_t*)(ws + WS_WPA), scr, r, lane); continue; } r -= I_PA;
            if (r < I_PS) { transpose_item(P.in[21], 512, 1024, (bf16_t*)(ws + WS_WPS), scr, r, lane); continue; } r -= I_PS;
            if (r < I_PX) { transpose_item(P.in[22], 512, 1024, (bf16_t*)(ws + WS_WPX), scr, r, lane); continue; } r -= I_PX;
            if (r < I_OUT) { transpose_item(P.in[23], 1024, 1024, (bf16_t*)(ws + WS_WOUT), scr, r, lane); continue; } r -= I_OUT;
            transpose_item(P.in[16], 512, 512, (bf16_t*)(ws + WS_WGLU), scr, r, lane);
        }
        for (int m = gw; m < NTOK; m += 2 * NGW) {
            const int m2 = m + NGW; const bool has2 = m2 < NTOK;
            const f32x4* xa = (const f32x4*)(m < NPROMPT ? xp + (size_t)m * DM : xs + (size_t)(m - NPROMPT) * DM) + lane;
            const f32x4* xb2 = (const f32x4*)(!has2 ? xp : (m2 < NPROMPT ? xp + (size_t)m2 * DM : xs + (size_t)(m2 - NPROMPT) * DM)) + lane;
            f32x4 va[4], vb[4]; float sa = 0.f, sb = 0.f;
#pragma unroll
            for (int j = 0; j < 4; ++j) { va[j] = xa[64 * j]; vb[j] = xb2[64 * j]; }
#pragma unroll
            for (int j = 0; j < 4; ++j) { sa += (va[j].x * va[j].x + va[j].y * va[j].y) + (va[j].z * va[j].z + va[j].w * va[j].w); sb += (vb[j].x * vb[j].x + vb[j].y * vb[j].y) + (vb[j].z * vb[j].z + vb[j].w * vb[j].w); }
#pragma unroll
            for (int o = 1; o < 64; o <<= 1) { sa += __shfl_xor(sa, o); sb += __shfl_xor(sb, o); }
            const float ra = rsqrtf(sa * (1.f / DM) + EPS), rb = rsqrtf(sb * (1.f / DM) + EPS);
            u32x2* oa = (u32x2*)(XN + (size_t)m * DM) + lane; u32x2* ob2 = (u32x2*)(XN + (size_t)(has2 ? m2 : m) * DM) + lane;
            float ma = 1e-20f, mb = 1e-20f;
#pragma unroll
            for (int j = 0; j < 4; ++j) { const f32x4 gwt = ((const f32x4*)P.in[4])[lane + 64 * j];
                va[j] = va[j] * ra * gwt; vb[j] = vb[j] * rb * gwt;
                u32x2 w; w.x = cvtpk(va[j].x, va[j].y); w.y = cvtpk(va[j].z, va[j].w); oa[64 * j] = w;
                if (has2) { u32x2 w2; w2.x = cvtpk(vb[j].x, vb[j].y); w2.y = cvtpk(vb[j].z, vb[j].w); ob2[64 * j] = w2; }
                ma = fmaxf(fmaxf(ma, fmaxf(fabsf(va[j].x), fabsf(va[j].y))), fmaxf(fabsf(va[j].z), fabsf(va[j].w)));
                mb = fmaxf(fmaxf(mb, fmaxf(fabsf(vb[j].x), fabsf(vb[j].y))), fmaxf(fabsf(vb[j].z), fabsf(vb[j].w))); }
#pragma unroll
            for (int o = 1; o < 64; o <<= 1) { ma = fmaxf(ma, __shfl_xor(ma, o)); mb = fmaxf(mb, __shfl_xor(mb, o)); }
            const float ia = 127.f / ma, ib = 127.f / mb;
            unsigned* q8a = (unsigned*)(XN8 + (size_t)m * DM) + lane; unsigned* q8b = (unsigned*)(XN8 + (size_t)(has2 ? m2 : m) * DM) + lane;
#pragma unroll
            for (int j = 0; j < 4; ++j) {
                q8a[64 * j] = (unsigned)((int)rintf(va[j].x * ia) & 255) | ((unsigned)((int)rintf(va[j].y * ia) & 255) << 8) | ((unsigned)((int)rintf(va[j].z * ia) & 255) << 16) | ((unsigned)(int)rintf(va[j].w * ia) << 24);
                if (has2) q8b[64 * j] = (unsigned)((int)rintf(vb[j].x * ib) & 255) | ((unsigned)((int)rintf(vb[j].y * ib) & 255) << 8) | ((unsigned)((int)rintf(vb[j].z * ib) & 255) << 16) | ((unsigned)(int)rintf(vb[j].w * ib) << 24); }
            if (lane == 0) { XS[m] = ma * (1.f / 127.f); if (has2) XS[m2] = mb * (1.f / 127.f); }
        }
        for (int r = gw; r < NMEMROWS; r += NGW) rms_row_bf16(r < 2048 ? P.in[2] + (size_t)r * DM : P.in[3] + (size_t)(r - 2048) * DM, P.in[18], (bf16_t*)(ws + WS_MN) + (size_t)r * DM, lane);
        for (long i = gtid; i < 256 * 32; i += NGT) { const int pos = (int)(i >> 5), j = (int)(i & 31);
            const float freq = exp2f(-(float)j * (13.287712379549449f / 32.f)); const float ang = (float)pos * freq; float c, s; cexp_turns(ang * 0.15915494309189535f, c, s); cosT[i] = c; sinT[i] = s; }
        for (long i = gtid; i < NTOK; i += NGT) ((float*)(ws + WS_RSS))[i] = 0.f;
        if (gtid < 320) ((unsigned*)(ws + WS_CNT))[gtid] = 0u;
        {
            LAS float* bp = (LAS float*)(ldsl + wave * 16384);
            for (int wi = wave * G + bid; wi < 4096; wi += NGW) {
                const int dg = wi >> 6, tau = wi & 63, n = lane;
                const float dt = __expf(lstep[dg]); const float are = fminf(a_re[dg * 64 + n], -1e-4f), aim = a_im[dg * 64 + n];
                float cr, ci; zoh_coef(are, aim, dt, cr, ci); float pr, pi; lam_pow(are, aim, dt, (float)tau, pr, pi);
                const float qr_ = pr * cr - pi * ci, qi_ = pr * ci + pi * cr;
                const float* brp = b_re + (size_t)(dg * 64 + n) * 16; const float* bip = b_im + (size_t)(dg * 64 + n) * 16;
#pragma unroll
                for (int c4 = 0; c4 < 4; ++c4) { const f32x4 br = *(const f32x4*)(brp + 4 * c4), bi = *(const f32x4*)(bip + 4 * c4);
                    *(LAS f32x4*)(bp + n * 36 + 4 * c4) = qr_ * br - qi_ * bi; *(LAS f32x4*)(bp + n * 36 + 16 + 4 * c4) = qr_ * bi + qi_ * br; }
                asm volatile("s_waitcnt lgkmcnt(0)" ::: "memory");
                const int ch = lane >> 2, cq = (lane & 3) * 4;
                const float* crp = c_re + (size_t)(dg * 16 + ch) * 64; const float* cip = c_im + (size_t)(dg * 16 + ch) * 64;
                f32x4 acc = {0.f, 0.f, 0.f, 0.f};
#pragma unroll 4
                for (int n4 = 0; n4 < 16; ++n4) { const f32x4 c_r = *(const f32x4*)(crp + 4 * n4), c_i = *(const f32x4*)(cip + 4 * n4);
#pragma unroll
                    for (int e = 0; e < 4; ++e) { const int nn = 4 * n4 + e; const f32x4 bre = *(const LAS f32x4*)(bp + nn * 36 + cq), bim = *(const LAS f32x4*)(bp + nn * 36 + 16 + cq);
                        acc += c_r[e] * bre - c_i[e] * bim; } }
                *(f32x4*)(KT + ((size_t)(dg * 64 + tau) * 16 + ch) * 16 + cq) = acc;
                asm volatile("s_waitcnt lgkmcnt(0)" ::: "memory");
            }
        }
        for (long idx = gtid; idx < 32 * 256 * 64; idx += NGT) {
            const int j = (int)(idx & 63), col = (int)((idx >> 6) & 255), g = (int)(idx >> 14), dir = col >> 7, part = (col >> 6) & 1, n = col & 63, dg = dir * 32 + g;
            const float dt = __expf(lstep[dg]); const float are = fminf(a_re[dg * 64 + n], -1e-4f), aim = a_im[dg * 64 + n];
            float cr, ci; zoh_coef(are, aim, dt, cr, ci); float pr, pi; lam_pow(are, aim, dt, (float)(dir ? j : 63 - j), pr, pi);
            const float qr_ = pr * cr - pi * ci, qi_ = pr * ci + pi * cr;
            float v[16];
#pragma unroll
            for (int c = 0; c < 16; ++c) { const float br = b_re[(dg * 64 + n) * 16 + c], bi = b_im[(dg * 64 + n) * 16 + c]; v[c] = part ? (qr_ * bi + qi_ * br) : (qr_ * br - qi_ * bi); }
            u32x4 w0, w1; w0.x = cvtpk(v[0], v[1]); w0.y = cvtpk(v[2], v[3]); w0.z = cvtpk(v[4], v[5]); w0.w = cvtpk(v[6], v[7]);
            w1.x = cvtpk(v[8], v[9]); w1.y = cvtpk(v[10], v[11]); w1.z = cvtpk(v[12], v[13]); w1.w = cvtpk(v[14], v[15]);
            bf16_t* d = WE + ((size_t)(g * 256 + col)) * 1024 + j * 16; *(u32x4*)d = w0; *(u32x4*)(d + 8) = w1;
        }
    }
    __syncthreads();
    grid.sync();
    STAMP(1);

    if constexpr (PHON(1))
    {
        PHASE_IDS
        for (int r = gw; r < 5632; r += NGW) {
            const int rsrc = r < 2560 ? r : (r < 4608 ? r + 1024 : r + 2048);
            const u32x4* src = (const u32x4*)(WIN + (size_t)rsrc * 1024) + 2 * lane; const u32x4 a = src[0], b = src[1];
            float v[16]; v[0] = bflo(a.x); v[1] = bfhi(a.x); v[2] = bflo(a.y); v[3] = bfhi(a.y); v[4] = bflo(a.z); v[5] = bfhi(a.z); v[6] = bflo(a.w); v[7] = bfhi(a.w);
            v[8] = bflo(b.x); v[9] = bfhi(b.x); v[10] = bflo(b.y); v[11] = bfhi(b.y); v[12] = bflo(b.z); v[13] = bfhi(b.z); v[14] = bflo(b.w); v[15] = bfhi(b.w);
            float mx = 1e-30f;
#pragma unroll
            for (int j = 0; j < 16; ++j) mx = fmaxf(mx, fabsf(v[j]));
#pragma unroll
            for (int o = 1; o < 64; o <<= 1) mx = fmaxf(mx, __shfl_xor(mx, o));
            const float inv = 127.f / mx; unsigned w[4];
#pragma unroll
            for (int q = 0; q < 4; ++q) w[q] = (unsigned)((int)rintf(v[4 * q] * inv) & 255) | ((unsigned)((int)rintf(v[4 * q + 1] * inv) & 255) << 8) | ((unsigned)((int)rintf(v[4 * q + 2] * inv) & 255) << 16) | ((unsigned)(int)rintf(v[4 * q + 3] * inv) << 24);
            *((u32x4*)(W8 + (size_t)r * 1024) + lane) = (u32x4){w[0], w[1], w[2], w[3]};
            if (lane == 0) WSC[r] = mx * (1.f / 127.f);
        }
    }
    {
        PHASE_IDS
        for (int r = gw; r < 1024; r += NGW) {
            if (r < 1024) { const u32x4* src = (const u32x4*)((const bf16_t*)(ws + WS_WPA) + (size_t)r * 1024) + 2 * lane; const u32x4 a = src[0], b = src[1];
                int w0 = __builtin_amdgcn_cvt_pk_fp8_f32(bflo(a.x) * 32.f, bfhi(a.x) * 32.f, 0, false); w0 = __builtin_amdgcn_cvt_pk_fp8_f32(bflo(a.y) * 32.f, bfhi(a.y) * 32.f, w0, true);
                int w1 = __builtin_amdgcn_cvt_pk_fp8_f32(bflo(a.z) * 32.f, bfhi(a.z) * 32.f, 0, false); w1 = __builtin_amdgcn_cvt_pk_fp8_f32(bflo(a.w) * 32.f, bfhi(a.w) * 32.f, w1, true);
                int w2 = __builtin_amdgcn_cvt_pk_fp8_f32(bflo(b.x) * 32.f, bfhi(b.x) * 32.f, 0, false); w2 = __builtin_amdgcn_cvt_pk_fp8_f32(bflo(b.y) * 32.f, bfhi(b.y) * 32.f, w2, true);
                int w3 = __builtin_amdgcn_cvt_pk_fp8_f32(bflo(b.z) * 32.f, bfhi(b.z) * 32.f, 0, false); w3 = __builtin_amdgcn_cvt_pk_fp8_f32(bflo(b.w) * 32.f, bfhi(b.w) * 32.f, w3, true);
                *((u32x4*)(ws + WS_WPA8 + (size_t)r * 1024) + lane) = (u32x4){(unsigned)w0, (unsigned)w1, (unsigned)w2, (unsigned)w3}; }
            else { const int rr = r - 1024; const u32x4 a = *((const u32x4*)((const bf16_t*)(ws + WS_WPX) + (size_t)rr * 512) + lane);
                int w0 = __builtin_amdgcn_cvt_pk_fp8_f32(bflo(a.x) * 32.f, bfhi(a.x) * 32.f, 0, false); w0 = __builtin_amdgcn_cvt_pk_fp8_f32(bflo(a.y) * 32.f, bfhi(a.y) * 32.f, w0, true);
                int w1 = __builtin_amdgcn_cvt_pk_fp8_f32(bflo(a.z) * 32.f, bfhi(a.z) * 32.f, 0, false); w1 = __builtin_amdgcn_cvt_pk_fp8_f32(bflo(a.w) * 32.f, bfhi(a.w) * 32.f, w1, true);
                *((u32x2*)(ws + WS_WPX8 + (size_t)rr * 512) + lane) = (u32x2){(unsigned)w0, (unsigned)w1}; }
        }
    }
    __syncthreads();
    grid.sync();
    {
        pg8::Gemm g{(const bf16_t*)XN8, (const bf16_t*)W8, 512, 512, 512}; pg8::StaticOrder S; S.init(NTOK, 3584, G, bid);
        EpiInProjI8 E{ws, XS, WSC};
        pg8::gemm_phase<true>(ldsl, g, S, E, wv);
    }
    {
        pg8::Gemm g{XN, WIN + (size_t)2560 * 1024, 1024, 1024, 1024}; pg8::StaticOrder S; S.init(NTOK, 1024, G, bid);
        pg8::Epi8<FInProj> E{FInProj{ws, AG, 10}};
        pg8::gemm_phase(ldsl, g, S, E, wv);
    }
    if constexpr (PHON(1))
    {
        pg8::Gemm g{(const bf16_t*)(ws + WS_MN), (const bf16_t*)(ws + WS_WMKV), 1024, 1024, 1024}; pg8::StaticOrder S; S.init(NMEMROWS, 1024, G, (bid + 128) % G);
        pg8::Epi8<FStoreBf16> E{FStoreBf16{(bf16_t*)(ws + WS_KVM), 1024}};
        pg8::gemm_phase(ldsl, g, S, E, wv);
    }
    __syncthreads();
    grid.sync();
    STAMP(2);

    if constexpr (PHON(3))
    {
        pg8::Gemm g{AG, WE, AGK, 1024, 1024}; pg8::GroupedOrder S; S.init(32, 5, 1, G, bid);
        pg8::Epi8<FStoreEC> E{FStoreEC{EC}};
        pg8::gemm_phase(ldsl, g, S, E, wv);
    }
    __syncthreads();
    grid.sync();
    STAMP(4);

    if constexpr (PHON(4)) { PHASE_IDS
    for (long idx = ((long)wave * G + bid) * 64 + lane; idx < 9 * 32 * 2 * 64; idx += NGT) {
        const int n = (int)(idx & 63), dir = (int)((idx >> 6) & 1), g = (int)((idx >> 7) & 31), b = (int)(idx >> 12), dg = dir * 32 + g;
        const int c0 = b < 8 ? b * 128 : 1024, c1 = b < 8 ? c0 + 128 : 1280;
        const float dt = __expf(lstep[dg]); const float are = fminf(a_re[dg * 64 + n], -1e-4f), aim = a_im[dg * 64 + n];
        float lr, li; lam_pow(are, aim, dt, 64.f, lr, li);
        float sr = 0.f, si = 0.f;
        const int colE = dir * 128 + n;
        const int cstart = dir ? c1 - 1 : c0, cstep = dir ? -1 : 1;
        const float* e0 = EC + ((size_t)(g * NCHUNK + cstart)) * 256 + colE; bf16_t* a0 = AG + ((size_t)(g * NCHUNK + cstart)) * AGK + 1024 + colE;
        const long estep = (long)cstep * 256, astep = (long)cstep * AGK;
        for (int k = 0; k < c1 - c0; k += 16) {
            float er[16], ei[16];
#pragma unroll
            for (int j = 0; j < 16; ++j) { er[j] = e0[(k + j) * estep]; ei[j] = e0[(k + j) * estep + 64]; }
#pragma unroll
            for (int j = 0; j < 16; ++j) {
                bf16_t* ag = a0 + (k + j) * astep; ag[0] = (bf16_t)(cvtpk(sr, 0.f) & 0xffffu); ag[64] = (bf16_t)(cvtpk(si, 0.f) & 0xffffu);
                const float nr = lr * sr - li * si + er[j], ni = lr * si + li * sr + ei[j]; sr = nr; si = ni;
            }
        }
    }
    {
        bf16_t* Kb = (bf16_t*)(ws + WS_K); const float* kw = P.in[7]; unsigned char* K8 = ws + WS_K8;
        float wm = fmaxf(fabsf(kw[lane]), fabsf(kw[lane + 64]));
#pragma unroll
        for (int o = 1; o < 64; o <<= 1) wm = fmaxf(wm, __shfl_xor(wm, o));
        const float kmax = 11.3137085f * wm * 1.0001f + 1e-20f, ski = 127.f / kmax;
        if (lane == 0) *(float*)(ws + WS_SK) = kmax * (1.f / 127.f);
        const int kself = wave * G + bid; const bool split = NGW > 1152; const int nfree = split ? NGW - 576 : NGW, kfree = split ? kself - 576 : kself;
        if (kfree >= 0)
        for (int r8a = kfree; r8a < NTOK * 2 / 8; r8a += 2 * nfree) {
            u32x4 wv0[2], wv1[2]; u32x4* pp[2]; unsigned char* kd8[2]; bool okk[2]; f32x4 tc0[2], tc1[2], ts0[2], ts1[2];
            const int sub = lane & 7;
#pragma unroll
            for (int u = 0; u < 2; ++u) {
                const int r8 = r8a + u * nfree; okk[u] = r8 < NTOK * 2 / 8; const int rr = (okk[u] ? r8 : r8a) * 8 + (lane >> 3), token = rr >> 1, kvh = rr & 1;
                pp[u] = (u32x4*)(Kb + (size_t)token * 256 + kvh * 128 + sub * 16); wv0[u] = pp[u][0]; wv1[u] = pp[u][1];
                kd8[u] = K8 + (size_t)token * 256 + kvh * 128 + 32 * (sub >> 1) + 8 * (sub & 1);
                const int t = token < NPROMPT ? (token & (SEQ_P - 1)) : (token - NPROMPT); const int pos = sub < 4 ? (t >> 6) : (t & 63);
                const float* ct = cosT + pos * 32 + (sub & 3) * 8; const float* st = sinT + pos * 32 + (sub & 3) * 8;
                tc0[u] = *(const f32x4*)ct; tc1[u] = *(const f32x4*)(ct + 4); ts0[u] = *(const f32x4*)st; ts1[u] = *(const f32x4*)(st + 4);
            }
#pragma unroll
            for (int u = 0; u < 2; ++u) {
                const u32x4 w0 = wv0[u], w1 = wv1[u];
                float x[16]; x[0] = bflo(w0.x); x[1] = bfhi(w0.x); x[2] = bflo(w0.y); x[3] = bfhi(w0.y); x[4] = bflo(w0.z); x[5] = bfhi(w0.z); x[6] = bflo(w0.w); x[7] = bfhi(w0.w);
                x[8] = bflo(w1.x); x[9] = bfhi(w1.x); x[10] = bflo(w1.y); x[11] = bfhi(w1.y); x[12] = bflo(w1.z); x[13] = bfhi(w1.z); x[14] = bflo(w1.w); x[15] = bfhi(w1.w);
                float ss = 0.f;
#pragma unroll
                for (int j = 0; j < 16; ++j) ss += x[j] * x[j];
                ss += __shfl_xor(ss, 1); ss += __shfl_xor(ss, 2); ss += __shfl_xor(ss, 4);
                const float rstd = rsqrtf(ss * (1.f / 128.f) + EPS);
                unsigned ob[4] = {0u, 0u, 0u, 0u};
#pragma unroll
                for (int j = 0; j < 8; ++j) { const float a = x[2 * j] * rstd * kw[sub * 16 + 2 * j], b = x[2 * j + 1] * rstd * kw[sub * 16 + 2 * j + 1];
                    const float cs = j < 4 ? tc0[u][j & 3] : tc1[u][j & 3], sn = j < 4 ? ts0[u][j & 3] : ts1[u][j & 3];
                    const int q0 = (int)fminf(fmaxf(rintf((a * cs - b * sn) * ski), -127.f), 127.f), q1 = (int)fminf(fmaxf(rintf((a * sn + b * cs) * ski), -127.f), 127.f);
                    ob[j >> 1] |= ((unsigned)(q0 & 255) | ((unsigned)(q1 & 255) << 8)) << (16 * (j & 1)); }
                if (okk[u]) { *(u32x2*)kd8[u] = (u32x2){ob[0], ob[1]}; *(u32x2*)(kd8[u] + 16) = (u32x2){ob[2], ob[3]}; }
            }
        }
        if (kfree >= 0)
        for (int it = kfree; it < (NTOK / 64) * 2; it += nfree) {
            const bf16_t* vsrc = (const bf16_t*)(ws + WS_V) + (size_t)(it >> 1) * 64 * 256 + (it & 1) * 128 + 2 * lane;
            unsigned vraw[64];
#pragma unroll
            for (int k = 0; k < 64; ++k) vraw[k] = *(const unsigned*)(vsrc + (size_t)k * 256);
            unsigned char* dstb = ws + WS_V8 + (size_t)it * 8192;
#pragma unroll
            for (int sgl = 0; sgl < 2; ++sgl) {
                const int c = 2 * lane + sgl, sw = (c >> 2) & 3;
#pragma unroll
                for (int p = 0; p < 4; ++p) {
                    unsigned w[4];
#pragma unroll
                    for (int d = 0; d < 4; ++d) { float f[4];
#pragma unroll
                        for (int e = 0; e < 4; ++e) { const int b = 16 * p + 4 * d + e, h = b >> 5, j = b & 31;
                            const int key = (j < 16) ? ((j & 3) + 8 * (j >> 2) + 4 * h) : (32 + ((j - 16) & 3) + 8 * ((j - 16) >> 2) + 4 * h);
                            f[e] = sgl ? bfhi(vraw[key]) : bflo(vraw[key]); }
                        int ww = __builtin_amdgcn_cvt_pk_fp8_f32(f[0], f[1], 0, false); ww = __builtin_amdgcn_cvt_pk_fp8_f32(f[2], f[3], ww, true); w[d] = (unsigned)ww; }
                    *(u32x4*)(dstb + c * 64 + ((p ^ sw) << 4)) = (u32x4){w[0], w[1], w[2], w[3]};
                }
            }
        }
        if (kfree >= 0)
        for (long idx0 = (long)kfree * 64 + lane; idx0 < 32L * 1024 * 128; idx0 += 4L * nfree * 64) {
            f32x4 fa[4][2], fb[4][2]; int tauv[4], chv[4], c0v[4]; float dskv[4]; size_t dst[4]; bool ok[4];
#pragma unroll
            for (int u = 0; u < 4; ++u) {
                const long id = idx0 + (long)u * nfree * 64; ok[u] = id < 32L * 1024 * 128; const int idc = (int)(ok[u] ? id : idx0);
                const int q = idc & 127, r = (idc >> 7) & 1023, g = idc >> 17, i = r >> 4, ch = r & 15, j = q >> 1, c0 = (q & 1) * 8, tau = i - j;
                const float* pa = KT + ((size_t)(g * 64 + (tau > 0 ? tau : 0)) * 16 + ch) * 16 + c0;
                const float* pb = KT + ((size_t)((32 + g) * 64 + (tau < 0 ? -tau : 0)) * 16 + ch) * 16 + c0;
                fa[u][0] = *(const f32x4*)pa; fa[u][1] = *(const f32x4*)(pa + 4); fb[u][0] = *(const f32x4*)pb; fb[u][1] = *(const f32x4*)(pb + 4);
                tauv[u] = tau; chv[u] = ch; c0v[u] = c0; dskv[u] = s5d[g * 16 + ch]; dst[u] = ((size_t)(g * 1024 + r)) * AGK + q * 8;
            }
#pragma unroll
            for (int u = 0; u < 4; ++u) {
                const float wa = tauv[u] >= 0 ? 1.f : 0.f, wb = tauv[u] <= 0 ? 1.f : 0.f; float v[8];
#pragma unroll
                for (int e = 0; e < 8; ++e) v[e] = wa * fa[u][e >> 2][e & 3] + wb * fb[u][e >> 2][e & 3] + ((tauv[u] == 0 && (c0v[u] + e) == chv[u]) ? dskv[u] : 0.f);
                u32x4 w; w.x = cvtpk(v[0], v[1]); w.y = cvtpk(v[2], v[3]); w.z = cvtpk(v[4], v[5]); w.w = cvtpk(v[6], v[7]);
                if (ok[u]) *(u32x4*)(WG + dst[u]) = w;
            }
        }
        if (kfree >= 0)
        for (long idx = (long)kfree * 64 + lane; idx < 32L * 2 * 8 * 16; idx += (long)nfree * 64) {
            const int ch = (int)(idx & 15), oct = (int)((idx >> 4) & 7), dir = (int)((idx >> 7) & 1), g = (int)(idx >> 8), dg = dir * 32 + g, n0 = oct * 8;
            const float dt = __expf(lstep[dg]);
            float lr[8], li[8], pr[8], pi[8], cr[8], ci[8];
#pragma unroll
            for (int e = 0; e < 8; ++e) { const int n = n0 + e; const float are = fminf(a_re[dg * 64 + n], -1e-4f), aim = a_im[dg * 64 + n]; lam_pow(are, aim, dt, 1.f, lr[e], li[e]); pr[e] = lr[e]; pi[e] = li[e];
                cr[e] = c_re[(dg * 16 + ch) * 64 + n]; ci[e] = c_im[(dg * 16 + ch) * 64 + n]; }
            for (int pw = 1; pw <= 64; ++pw) {
                const int i = dir ? 64 - pw : pw - 1; float vr[8], vi[8];
#pragma unroll
                for (int e = 0; e < 8; ++e) { vr[e] = cr[e] * pr[e] - ci[e] * pi[e]; vi[e] = -(cr[e] * pi[e] + ci[e] * pr[e]);
                    const float nr = pr[e] * lr[e] - pi[e] * li[e], ni = pr[e] * li[e] + pi[e] * lr[e]; pr[e] = nr; pi[e] = ni; }
                bf16_t* d = WG + ((size_t)(g * 1024 + i * 16 + ch)) * AGK + 1024 + dir * 128 + n0;
                u32x4 w; w.x = cvtpk(vr[0], vr[1]); w.y = cvtpk(vr[2], vr[3]); w.z = cvtpk(vr[4], vr[5]); w.w = cvtpk(vr[6], vr[7]); *(u32x4*)d = w;
                w.x = cvtpk(vi[0], vi[1]); w.y = cvtpk(vi[2], vi[3]); w.z = cvtpk(vi[4], vi[5]); w.w = cvtpk(vi[6], vi[7]); *(u32x4*)(d + 64) = w;
            }
        }
    }
    }
    __syncthreads();
    grid.sync();
    STAMP(5);

    if constexpr (PHON(5))
    {
        pg8::Gemm g{AG, WG, AGK, AGK, AGK}; pg8::GroupedOrder S; S.init(32, 5, 4, G, bid);
        pg8::Epi8<FS5Out> E{FS5Out{(bf16_t*)(ws + WS_U)}};
        pg8::gemm_phase(ldsl, g, S, E, wv);
    }
    __syncthreads();
    grid.sync();
    STAMP(6);

    if constexpr (PHON(6))
    {
        pg8::Gemm g{(const bf16_t*)(ws + WS_U), (const bf16_t*)(ws + WS_WGLU), 512, 512, 512}; pg8::StaticOrder S; S.init(NTOK, 512, G, bid);
        pg8::Epi8<FGlu> E{FGlu{(const bf16_t*)(ws + WS_U), (bf16_t*)(ws + WS_GS), P.in[17]}};
        pg8::gemm_phase(ldsl, g, S, E, wv);
    }

    if constexpr (PHON(7))
    {
        bf16_t* Q = (bf16_t*)(ws + WS_Q); const unsigned char* K8 = ws + WS_K8; const unsigned char* V8 = ws + WS_V8; const bf16_t* GA = (const bf16_t*)(ws + WS_GA);
        const float skv = *(const float*)(ws + WS_SK);
        { const int per = (512 + G - 1) / G;
          for (int ui = vcu * per; ui < (vcu + 1) * per && ui < 512; ++ui) {
              const int qb = ui & 63, h = ui >> 6, kvh = h >> 2; const size_t tok0 = (size_t)NPROMPT + qb * 256;
              att::attn_unit_i8<1024, 256>(Q + tok0 * 1024 + h * 128, K8 + (size_t)NPROMPT * 256 + kvh * 128, V8 + ((size_t)(NPROMPT / 64) * 2 + kvh) * 8192, GA + tok0 * 1024 + h * 128,
                                           dob + DO_Y8A + tok0 * 1024 + h * 128, SEQ_S, (char*)lds, qb * 256, P.in[6], cosT, sinT, skv, wv);
          } }
        { const int per = (2048 + G - 1) / G;
          for (int uu = vcu * per; uu < (vcu + 1) * per && uu < 2048; ++uu) {
              int ui = uu;
              if (G == 256) { const int xcd = vcu >> 5, j = vcu & 31, k = uu & 7, pair = xcd * 2 + (k >> 2); ui = pair * 128 + j * 4 + (k & 3); }
              const int qb = ui & 31, hq = (ui >> 5) & 3, kvh = (ui >> 7) & 1, b = ui >> 8, h = kvh * 4 + hq; const size_t tok0 = (size_t)b * SEQ_P + qb * 256, kt0 = (size_t)b * SEQ_P;
              att::attn_unit_i8<1024, 256>(Q + tok0 * 1024 + h * 128, K8 + kt0 * 256 + kvh * 128, V8 + ((kt0 / 64) * 2 + kvh) * 8192, GA + tok0 * 1024 + h * 128,
                                           dob + DO_Y8A + tok0 * 1024 + h * 128, SEQ_P, (char*)lds, qb * 256, P.in[6], cosT, sinT, skv, wv);
          } }
        { bf16_t* QX = (bf16_t*)(ws + WS_QX); const bf16_t* GX = (const bf16_t*)(ws + WS_GX); const bf16_t* KVM = (const bf16_t*)(ws + WS_KVM);
          const int per = (1280 + G - 1) / G;
          for (int ui = vcu * per; ui < (vcu + 1) * per && ui < 1280; ++ui) {
              const int h = ui & 3, tb = ui >> 2; const size_t tok0 = (size_t)tb * 256; const int mb = tok0 < (size_t)NPROMPT ? (int)(tok0 / SEQ_P) : 8;
              const bf16_t* km = KVM + (size_t)mb * 256 * 1024 + h * 128;
              att::attn_unit<false, 512, 1024>(QX + tok0 * 512 + h * 128, km, km + 512, GX + tok0 * 512 + h * 128, QX + tok0 * 512 + h * 128, 256, (char*)lds, 0, nullptr, nullptr, nullptr, wv);
          } }
    }
    __syncthreads();
    grid.sync();
    STAMP(7);

    if constexpr (PHON(8))
    {
        pg8::Gemm g{(const bf16_t*)(dob + DO_Y8A), (const bf16_t*)(ws + WS_WPA8), 512, 512, 512, 0x79797979, 0x7A7A7A7A}; pg8::StaticOrder S; S.init(NTOK, 1024, G, bid);
        pg8::Epi8<FStoreBf16> E{FStoreBf16{(bf16_t*)(ws + WS_GA), 1024}};
        pg8::gemm_phase<2>(ldsl, g, S, E, wv);
    }
    if constexpr (PHON(8))
    {
        static_assert(WS_QX == WS_GS + (size_t)NTOK * 512 * 2 && WS_WPX == WS_WPS + (size_t)1024 * 512 * 2, "stacked PS/PX operands");
        pg8::Gemm g{(const bf16_t*)(ws + WS_GS), (const bf16_t*)(ws + WS_WPS), 512, 512, 512}; pg8::GroupedOrder S; S.init(2, NTOK / 256, 4, G, vcu);
        pg8::Epi8<FStorePSX> E{FStorePSX{ws}};
        pg8::gemm_phase(ldsl, g, S, E, wv);
    }
    __syncthreads();
    grid.sync();
    STAMP(8);

    if constexpr (PHON(9))
    {
        { pg8::Gemm g{(const bf16_t*)XN8, (const bf16_t*)(W8 + (size_t)3584 * 1024), 512, 512, 512}; pg8::PairOrder S{G, vcu};
          EpiMergeI8 E{ws, XS, WSC + 3584, (bf16_t*)(ws + WS_GA)};
          pg8::gemm_phase<true>(ldsl, g, S, E, wv); }
        { pg8::Gemm g{XN, WIN + (size_t)(4608 + 1024) * 1024, 1024, 1024, 1024}; pg8::SingleOrder S{G, vcu};
          pg8::Epi8<FMerge> E{FMerge{ws, (bf16_t*)(ws + WS_GA), 1}};
          pg8::gemm_phase(ldsl, g, S, E, wv); }
    }
    __syncthreads();
    grid.sync();
    STAMP(9);

    if constexpr (PHON(10))
    {
        pg8::Gemm g{(const bf16_t*)(ws + WS_GA), (const bf16_t*)(ws + WS_WOUT), 1024, 1024, 1024}; pg8::StaticOrder S; S.init(NTOK, 1024, G, bid);
        EpiOutNorm E{xp, xs, P.out, P.in[24], (float*)(ws + WS_RSS), (unsigned*)(ws + WS_CNT)};
        pg8::gemm_phase(ldsl, g, S, E, wv);
    }
    if (PROBE) {
        __syncthreads(); grid.sync(); STAMP(11);
        if (bid == 0) { PHASE_IDS
            __syncthreads();
            const unsigned long long* TS = (const unsigned long long*)(ws + 768 * 1024);
            const float tA_us = (float)(__hip_atomic_load(TS + PROBE_A1, __ATOMIC_RELAXED, __HIP_MEMORY_SCOPE_AGENT) - __hip_atomic_load(TS + PROBE_A0, __ATOMIC_RELAXED, __HIP_MEMORY_SCOPE_AGENT)) * 0.01f;
            const float tB_us = (float)(__hip_atomic_load(TS + PROBE_B1, __ATOMIC_RELAXED, __HIP_MEMORY_SCOPE_AGENT) - __hip_atomic_load(TS + PROBE_B0, __ATOMIC_RELAXED, __HIP_MEMORY_SCOPE_AGENT)) * 0.01f;
            if (tid == 0) P.out[0] += tA_us * (1.f / 2000.f);
            const float dB = sqrtf(80e-6f * tB_us * 1e-3f);
            for (int i = tid; i < 1048576; i += 512) P.out[1024 + i] += dB;
        }
    }
}

#undef XN8
#undef XS
#undef W8
#undef WSC
extern "C" void kernel_launch(void* const* d_in, const int* in_sizes, int n_in, void* d_out, int out_size, void* d_ws, size_t ws_size, hipStream_t stream) {
    static int grid = 0;
    if (grid == 0) {
        if (n_in != 25 || out_size != NTOK * DM || ws_size < WS_END) { fprintf(stderr, "kernel_launch: unexpected shapes (n_in %d out %d ws %zu)\n", n_in, out_size, ws_size); grid = -1; return; }
        int dev = 0, cus = 0, per_cu = 0;
        hipGetDevice(&dev); hipDeviceGetAttribute(&cus, hipDeviceAttributeMultiprocessorCount, dev);
        if (hipFuncSetAttribute((const void*)hybrid_fwd, hipFuncAttributeMaxDynamicSharedMemorySize, LDS_BYTES) != hipSuccess) { fprintf(stderr, "kernel_launch: hipFuncSetAttribute failed\n"); grid = -1; return; }
        if (hipOccupancyMaxActiveBlocksPerMultiprocessor(&per_cu, (const void*)hybrid_fwd, 512, LDS_BYTES) != hipSuccess || per_cu < 1) { fprintf(stderr, "kernel_launch: occupancy query failed (%d)\n", per_cu); (void)hipGetLastError(); per_cu = 1; }
        grid = cus * per_cu;
    }
    if (grid < 0) return;
    Params p{};
    for (int i = 0; i < 25; ++i) p.in[i] = (const float*)d_in[i];
    p.out = (float*)d_out; p.ws = (unsigned char*)d_ws;
    void* args[] = {&p};
    hipError_t e = hipLaunchCooperativeKernel((const void*)hybrid_fwd, dim3(grid), dim3(512), args, LDS_BYTES, stream);
    if (e != hipSuccess) fprintf(stderr, "kernel_launch: cooperative launch failed: %s (grid %d)\n", hipGetErrorString(e), grid);
}
```

```cpp
#include <hip/hip_runtime.h>
#include <hip/hip_cooperative_groups.h>
#include <cstdio>
#include <cstdint>
namespace cg = cooperative_groups;

#define LAS __attribute__((address_space(3)))
typedef unsigned short bf16_t;
typedef short bf16x8 __attribute__((ext_vector_type(8)));
typedef short s16x4 __attribute__((ext_vector_type(4)));
typedef float f32x4 __attribute__((ext_vector_type(4)));
typedef float f32x16 __attribute__((ext_vector_type(16)));
typedef unsigned u32x4 __attribute__((ext_vector_type(4)));
typedef unsigned u32x2 __attribute__((ext_vector_type(2)));
typedef int i32x4 __attribute__((ext_vector_type(4)));
typedef int i32x16 __attribute__((ext_vector_type(16)));

constexpr int DM = 1024, NTOK = 81920, NPROMPT = 65536, SEQ_P = 8192, SEQ_S = 16384;
constexpr int NMEMROWS = 2304;
constexpr int CH = 64;
constexpr int NCHUNK = NTOK / CH;
constexpr int AGK = 1280;
constexpr float EPS = 1e-6f;

constexpr size_t MiB = 1u << 20;
constexpr size_t WS_RSS = 0, WS_CNT = 512 * 1024;
constexpr size_t WS_COS = 1 * MiB, WS_SIN = 1 * MiB + 65536;
constexpr size_t WS_KT = 2 * MiB;
constexpr size_t WS_WIN = 6 * MiB;
constexpr size_t WS_WMKV = 21 * MiB, WS_WPA = 23 * MiB, WS_WPS = 25 * MiB, WS_WPX = 26 * MiB, WS_WOUT = 27 * MiB, WS_WGLU = 29 * MiB;
constexpr size_t WS_MN = 30 * MiB, WS_KVM = 35 * MiB;
constexpr size_t WS_XN = 40 * MiB;
constexpr size_t WS_Q = 200 * MiB;
constexpr size_t WS_GA = 360 * MiB;
constexpr size_t WS_K = 520 * MiB, WS_V = 560 * MiB, WS_U = 600 * MiB;
constexpr size_t WS_PS = 520 * MiB;
constexpr size_t WS_GS = 680 * MiB;
constexpr size_t WS_QX = 760 * MiB;
constexpr size_t WS_GX = 840 * MiB;
constexpr size_t WS_PX = 840 * MiB;
constexpr size_t WS_K8 = 920 * MiB;
constexpr size_t WS_V8 = 940 * MiB;
constexpr size_t WS_SK = 900 * 1024;
constexpr size_t WS_W8 = 1000 * MiB, WS_WSC = 1006 * MiB, WS_XS = 1007 * MiB;
constexpr size_t WS_WPA8 = 1008 * MiB, WS_WPX8 = 1009 * MiB;
constexpr size_t WS_END = 1010 * MiB;
constexpr size_t DO_Y8A = 0, DO_Y8X = 80 * MiB;
constexpr size_t DO_XN8 = 236 * MiB;
constexpr size_t DO_AG = 0, DO_WG = 100 * MiB, DO_WE = 180 * MiB, DO_EC = 196 * MiB;

constexpr int LDS_BYTES = 135168;

__device__ __forceinline__ unsigned cvtpk(float lo, float hi) { unsigned r; asm volatile("v_cvt_pk_bf16_f32 %0, %1, %2" : "=v"(r) : "v"(lo), "v"(hi)); return r; }
__device__ __forceinline__ float bflo(unsigned w) { return __uint_as_float(w << 16); }
__device__ __forceinline__ float bfhi(unsigned w) { return __uint_as_float(w & 0xffff0000u); }
__device__ __forceinline__ float bf2f(bf16_t s) { return __uint_as_float(((unsigned)s) << 16); }
__device__ __forceinline__ float sigmoidf_(float x) { return __builtin_amdgcn_rcpf(1.f + __builtin_amdgcn_exp2f(-1.4426950408889634f * x)); }
__device__ __forceinline__ float siluf_(float x) { return x * sigmoidf_(x); }
__device__ __forceinline__ float gelu_tanh_(float x) { return x * sigmoidf_(1.5957691216057308f * (x + 0.044715f * x * x * x)); }
__device__ __forceinline__ int opaque_tid(int wv) { int l; asm volatile("v_mbcnt_lo_u32_b32 %0, -1, 0\n\tv_mbcnt_hi_u32_b32 %0, -1, %0" : "=v"(l)); return wv * 64 + l; }
__device__ __forceinline__ float wave_sum(float v) {
#pragma unroll
    for (int o = 1; o < 64; o <<= 1) v += __shfl_xor(v, o);
    return v;
}
__device__ __forceinline__ void cexp_turns(float turns, float& c, float& s) { const float f = turns - rintf(turns); c = cospif(2.f * f); s = sinpif(2.f * f); }
__device__ __forceinline__ void lam_pow(float are, float aim, float dt, float p, float& re, float& im) {
    const float mag = __expf(are * dt * p); float c, s; cexp_turns(aim * dt * p * 0.15915494309189535f, c, s); re = mag * c; im = mag * s;
}
__device__ __forceinline__ void zoh_coef(float are, float aim, float dt, float& cr, float& ci) {
    const float x = are * dt, y = aim * dt; const float ex1 = expm1f(x); float cy, sy; cexp_turns(y * 0.15915494309189535f, cy, sy);
    const float re1 = ex1 * cy + (cy - 1.f), im1 = (1.f + ex1) * sy; const float den = 1.f / (are * are + aim * aim);
    cr = (re1 * are + im1 * aim) * den; ci = (im1 * are - re1 * aim) * den;
}

namespace pg8 {
constexpr int BM = 256, BK = 64, HALF = 128, HTB = HALF * BK * 2, STAGE_BYTES = 8 * HTB, NXCD = 8, WGM = 8;
__host__ __device__ __forceinline__ int lds_byte(int r, int c) { const int st = (r >> 4) * 2 + (c >> 5), rr = r & 15, cc = c & 31, ob = rr * 64 + cc * 2; return st * 1024 + (ob ^ (((ob >> 9) & 1) << 5)); }
__host__ __device__ __forceinline__ void stage_rc(int b, int& R, int& C) { const int st = b / 1024, sb = b % 1024, swz = sb ^ (((sb >> 9) & 1) << 5); R = (st >> 1) * 16 + swz / 64; C = (st & 1) * 32 + (swz % 64) / 2; }
__host__ __device__ __forceinline__ int perm32(int rho) { const int n = rho >> 4, i = rho & 15; return 8 * (i >> 2) + 4 * n + (i & 3); }
struct Unit { int pm, pn; };
struct Gemm { const bf16_t* A; const bf16_t* Bt; int lda, ldb, K; int sa = 0x7F7F7F7F, sb = 0x7F7F7F7F; };

struct StaticOrder {
    int nM, nN, nwg, G, c;
    __device__ void init(int M, int N, int G_, int c_) { nM = M / BM; nN = N / BM; nwg = nM * nN; G = G_; c = c_; }
    __device__ bool next(int i, Unit& u) const {
        const long L = (long)i * G + c; if (L >= nwg) return false;
        int wgid = (int)L; { const int q = nwg / NXCD, r = nwg % NXCD, xcd = wgid % NXCD, off = wgid / NXCD; wgid = (xcd < r ? xcd * (q + 1) : r * (q + 1) + (xcd - r) * q) + off; }
        const int nig = WGM * nN, gid = wgid / nig, fm = gid * WGM, gsz = (nM - fm) < WGM ? (nM - fm) : WGM;
        u.pm = fm + ((wgid % nig) % gsz); u.pn = (wgid % nig) / gsz; return true;
    }
};
struct GroupedOrder {
    int RT, CT, total, G, c;
    __device__ void init(int ng, int RT_, int CT_, int G_, int c_) { RT = RT_; CT = CT_; total = ng * RT_ * CT_; G = G_; c = c_; }
    __device__ bool next(int i, Unit& u) const {
        const int L = i * G + c; if (L >= total) return false;
        const int per = RT * CT, g = L / per, rem = L % per, a = rem / CT, b = rem % CT; u.pm = g * RT + a; u.pn = g * CT + b; return true;
    }
};
struct PairOrder {
    int G, c;
    __device__ bool next(int i, Unit& u) const { const int tr = (i >> 1) * G + c; if (tr >= 1280) return false; u.pm = tr >> 2; u.pn = (i & 1) * 4 + (tr & 3); return true; }
};
struct SingleOrder {
    int G, c;
    __device__ bool next(int i, Unit& u) const { const int tr = i * G + c; if (tr >= 1280) return false; u.pm = tr >> 2; u.pn = tr & 3; return true; }
};
struct TripleOrder {
    int G, c;
    __device__ bool next(int i, Unit& u) const {
        const int tr = (i / 3) * G + c; if (tr >= 1280) return false;
        const int br = i % 3; u.pm = tr >> 2; u.pn = br * 4 + (tr & 3); return true;
    }
};

template <class F> struct Epi8 {
    static constexpr bool PERM = true;
    F f;
    __device__ __forceinline__ void operator()(const f32x4 (&acc)[2][2][4][2], const Unit& u, int wr, int wc, int fr, int fq) const {
        const int row0 = u.pm * BM + wr * 64 + fr, col0 = u.pn * BM + wc * 32 + 8 * fq;
        if constexpr (F::HAS_LOAD) {
#pragma unroll
            for (int ai = 0; ai < 2; ++ai) {
                typename F::Ld ld[4][2];
#pragma unroll
                for (int m = 0; m < 4; ++m)
#pragma unroll
                    for (int bj = 0; bj < 2; ++bj) ld[m][bj] = f.load(u, row0 + ai * HALF + m * 16, col0 + bj * HALF);
#pragma unroll
                for (int m = 0; m < 4; ++m)
#pragma unroll
                    for (int bj = 0; bj < 2; ++bj) f.apply(u, row0 + ai * HALF + m * 16, col0 + bj * HALF, acc[ai][bj][m][0], acc[ai][bj][m][1], ld[m][bj]);
                asm volatile("" ::: "memory");
            }
        } else {
#pragma unroll
            for (int ai = 0; ai < 2; ++ai)
#pragma unroll
                for (int m = 0; m < 4; ++m) {
#pragma unroll
                    for (int bj = 0; bj < 2; ++bj) f(u, row0 + ai * HALF + m * 16, col0 + bj * HALF, acc[ai][bj][m][0], acc[ai][bj][m][1]);
                    asm volatile("" ::: "memory");
                }
        }
    }
};

template <bool I8> __device__ __forceinline__ f32x4 mma16(bf16x8 b, bf16x8 a, f32x4 c) {
    if constexpr (I8) return __builtin_bit_cast(f32x4, __builtin_amdgcn_mfma_i32_16x16x64_i8(__builtin_bit_cast(i32x4, b), __builtin_bit_cast(i32x4, a), __builtin_bit_cast(i32x4, c), 0, 0, 0));
    else return __builtin_amdgcn_mfma_f32_16x16x32_bf16(b, a, c, 0, 0, 0);
}
typedef int i32x8g __attribute__((ext_vector_type(8)));
template <int MODE = 0, class Epi, class Sched>
__device__ __forceinline__ void gemm_phase(LAS unsigned char* lds, const Gemm g, const Sched& S, const Epi& E, int wv) {
    const int tid = opaque_tid(wv), wid = __builtin_amdgcn_readfirstlane(tid >> 6), lane = tid & 63, wr = wid >> 2, wc = wid & 3, fr = lane & 15, fq = lane >> 4;
    const int K = g.K, nt = K / BK;
    unsigned voffA[2], voffB[2];
#pragma unroll
    for (int i = 0; i < 2; ++i) { int R, C; stage_rc(tid * 16 + i * 8192, R, C); const int Rb = Epi::PERM ? ((R & ~31) + perm32(R & 31)) : R;
        voffA[i] = (unsigned)(R * g.lda + C) * 2u; voffB[i] = (unsigned)(Rb * g.ldb + C) * 2u; }
    const size_t kstep = (size_t)(BK * 2);
    const size_t hstepA = (size_t)HALF * g.lda * 2, hstepB = (size_t)HALF * g.ldb * 2;
    const size_t tstepA = 2 * hstepA, tstepB = 2 * hstepB;
    const unsigned ldsw = (unsigned)wid * 1024u;
    const int aoff = lds_byte(wr * 64 + fr, fq * 8), boff = lds_byte(wc * 32 + fr, fq * 8);
    const int aoff8 = lds_byte(wr * 64 + fr, (fq & 1) * 32 + (fq >> 1) * 16), boff8 = lds_byte(wc * 32 + fr, (fq & 1) * 32 + (fq >> 1) * 16);
#define PG8_SA(b, h) (((b) * 2 + (h)) * HTB)
#define PG8_SB(b, h) ((4 + (b) * 2 + (h)) * HTB)
#define PG8_STAGE(bufoff, gbase, voff) do { _Pragma("unroll") for (int _i = 0; _i < 2; ++_i) \
        __builtin_amdgcn_global_load_lds((const unsigned*)((const char*)(gbase) + (voff)[_i]), (LAS unsigned*)(lds + (bufoff) + ldsw + _i * 8192), 16, 0, 0); } while (0)
#define PG8_LDA(dst, b, h) do { if constexpr (MODE == 2) { _Pragma("unroll") for (int m = 0; m < 4; ++m) dst##8[m] = *(const LAS i32x8g*)(lds + PG8_SA(b, h) + aoff8 + m * 2048); } \
    else { _Pragma("unroll") for (int m = 0; m < 4; ++m) _Pragma("unroll") for (int k = 0; k < 2; ++k) dst[m][k] = *(const LAS bf16x8*)(lds + PG8_SA(b, h) + aoff + m * 2048 + k * 1024); } } while (0)
#define PG8_LDB(dst, b, h) do { if constexpr (MODE == 2) { _Pragma("unroll") for (int n = 0; n < 2; ++n) dst##8[n] = *(const LAS i32x8g*)(lds + PG8_SB(b, h) + boff8 + n * 2048); } \
    else { _Pragma("unroll") for (int n = 0; n < 2; ++n) _Pragma("unroll") for (int k = 0; k < 2; ++k) dst[n][k] = *(const LAS bf16x8*)(lds + PG8_SB(b, h) + boff + n * 2048 + k * 1024); } } while (0)
#define PG8_MMA(ai, bj, At, Bt) do { __builtin_amdgcn_s_setprio(1); \
    if constexpr (MODE == 2) { _Pragma("unroll") for (int m = 0; m < 4; ++m) _Pragma("unroll") for (int n = 0; n < 2; ++n) \
        asm volatile("v_mfma_scale_f32_16x16x128_f8f6f4 %0, %1, %2, %0, %3, %4 op_sel_hi:[0,0,0]" : "+v"(acc[ai][bj][m][n]) : "v"(Bt##8[n]), "v"(At##8[m]), "v"(vsb), "v"(vsa)); } \
    else { _Pragma("unroll") for (int m = 0; m < 4; ++m) _Pragma("unroll") for (int n = 0; n < 2; ++n) _Pragma("unroll") for (int k = 0; k < 2; ++k) \
        acc[ai][bj][m][n] = mma16<MODE == 1>(Bt[n][k], At[m][k], acc[ai][bj][m][n]); } __builtin_amdgcn_s_setprio(0); } while (0)
#define PG8_WAIT_V(n) asm volatile("s_waitcnt vmcnt(" #n ")" ::: "memory")
#define PG8_WAIT_L(n) asm volatile("s_waitcnt lgkmcnt(" #n ")" ::: "memory")
#define PG8_BAR __builtin_amdgcn_s_barrier()
#define PG8_SCHED __builtin_amdgcn_sched_barrier(0)
    Unit cur, nxt; int ui = 0;
    if (!S.next(0, cur)) return;
    f32x4 acc[2][2][4][2];
#pragma unroll
    for (int a = 0; a < 2; ++a)
#pragma unroll
        for (int b = 0; b < 2; ++b)
#pragma unroll
            for (int m = 0; m < 4; ++m)
#pragma unroll
                for (int n = 0; n < 2; ++n) acc[a][b][m][n] = (f32x4){0.f, 0.f, 0.f, 0.f};
    bf16x8 At[4][2], B0[2][2], B1[2][2];
    i32x8g At8[4], B08[2], B18[2];
    const int vsa = g.sa, vsb = g.sb;
    const char* cA = (const char*)g.A + (size_t)cur.pm * tstepA; const char* cB = (const char*)g.Bt + (size_t)cur.pn * tstepB;
    PG8_STAGE(PG8_SB(0, 0), cB, voffB); PG8_STAGE(PG8_SB(0, 1), cB + hstepB, voffB); PG8_STAGE(PG8_SA(0, 0), cA, voffA); PG8_STAGE(PG8_SA(0, 1), cA + hstepA, voffA);
    if (wr == 1) PG8_BAR;
    PG8_WAIT_V(2); PG8_BAR;
    PG8_STAGE(PG8_SB(1, 0), cB + kstep, voffB); PG8_STAGE(PG8_SA(1, 0), cA + kstep, voffA); PG8_STAGE(PG8_SB(1, 1), cB + hstepB + kstep, voffB);
    PG8_WAIT_V(6); PG8_BAR;
    for (;;) {
        const bool has_next = S.next(ui + 1, nxt);
        const char* nA = has_next ? (const char*)g.A + (size_t)nxt.pm * tstepA : cA; const char* nB = has_next ? (const char*)g.Bt + (size_t)nxt.pn * tstepB : cB;
        for (int t = 0; t < nt; t += 2) {
            const bool last = (t == nt - 2);
            const char* a1 = cA + (size_t)(t + 1) * kstep;
            const char* a2 = last ? nA : cA + (size_t)(t + 2) * kstep; const char* b2 = last ? nB : cB + (size_t)(t + 2) * kstep;
            const char* a3 = a2 + kstep; const char* b3 = b2 + kstep;
            PG8_LDB(B0, 0, 0); PG8_LDB(B1, 0, 1); PG8_SCHED; PG8_LDA(At, 0, 0); PG8_STAGE(PG8_SA(1, 1), a1 + hstepA, voffA);
            PG8_WAIT_V(8); PG8_WAIT_L(0); PG8_BAR; PG8_MMA(0, 0, At, B0); PG8_MMA(0, 1, At, B1); PG8_BAR; PG8_SCHED;
            PG8_LDA(At, 0, 1); PG8_STAGE(PG8_SB(0, 0), b2, voffB); PG8_STAGE(PG8_SB(0, 1), b2 + hstepB, voffB); PG8_STAGE(PG8_SA(0, 0), a2, voffA);
            PG8_WAIT_V(8); PG8_WAIT_L(0); PG8_BAR; PG8_MMA(1, 0, At, B0); PG8_MMA(1, 1, At, B1); PG8_BAR; PG8_SCHED;
            PG8_LDB(B0, 1, 0); PG8_LDB(B1, 1, 1); PG8_SCHED; PG8_LDA(At, 1, 0); PG8_STAGE(PG8_SA(0, 1), a2 + hstepA, voffA);
            PG8_WAIT_V(8); PG8_WAIT_L(0); PG8_BAR; PG8_MMA(0, 0, At, B0); PG8_MMA(0, 1, At, B1); PG8_BAR; PG8_SCHED;
            PG8_LDA(At, 1, 1); PG8_STAGE(PG8_SB(1, 0), b3, voffB); PG8_STAGE(PG8_SB(1, 1), b3 + hstepB, voffB); PG8_STAGE(PG8_SA(1, 0), a3, voffA);
            PG8_WAIT_V(8); PG8_WAIT_L(0); PG8_BAR; PG8_MMA(1, 0, At, B0); PG8_MMA(1, 1, At, B1); PG8_BAR; PG8_SCHED;
        }
        if (wr == 0) PG8_BAR;
        if constexpr (MODE == 2) asm volatile("s_nop 15\n\ts_nop 15\n\ts_nop 15" ::: "memory");
        E(acc, cur, wr, wc, fr, fq);
        if (!has_next) break;
#pragma unroll
        for (int a = 0; a < 2; ++a)
#pragma unroll
            for (int b = 0; b < 2; ++b)
#pragma unroll
                for (int m = 0; m < 4; ++m)
#pragma unroll
                    for (int n = 0; n < 2; ++n) acc[a][b][m][n] = (f32x4){0.f, 0.f, 0.f, 0.f};
        cur = nxt; cA = nA; cB = nB; ++ui;
        if (wr == 1) PG8_BAR;
    }
    PG8_WAIT_V(0);
    PG8_BAR;
#undef PG8_SA
#undef PG8_SB
#undef PG8_STAGE
#undef PG8_LDA
#undef PG8_LDB
#undef PG8_MMA
#undef PG8_WAIT_V
#undef PG8_WAIT_L
#undef PG8_BAR
#undef PG8_SCHED
}
}

__device__ __forceinline__ u32x4 pack8(f32x4 v0, f32x4 v1) { u32x4 w; w.x = cvtpk(v0[0], v0[1]); w.y = cvtpk(v0[2], v0[3]); w.z = cvtpk(v1[0], v1[1]); w.w = cvtpk(v1[2], v1[3]); return w; }
__device__ __forceinline__ void unpack8(u32x4 w, f32x4& a, f32x4& b) { a = (f32x4){bflo(w.x), bfhi(w.x), bflo(w.y), bfhi(w.y)}; b = (f32x4){bflo(w.z), bfhi(w.z), bflo(w.w), bfhi(w.w)}; }
__device__ __forceinline__ f32x4 silu4(f32x4 v) { return (f32x4){siluf_(v[0]), siluf_(v[1]), siluf_(v[2]), siluf_(v[3])}; }
__device__ __forceinline__ f32x4 sig4(f32x4 v) { return (f32x4){sigmoidf_(v[0]), sigmoidf_(v[1]), sigmoidf_(v[2]), sigmoidf_(v[3])}; }
__device__ __forceinline__ f32x4 gelu4(f32x4 v) { return (f32x4){gelu_tanh_(v[0]), gelu_tanh_(v[1]), gelu_tanh_(v[2]), gelu_tanh_(v[3])}; }

struct FInProj { static constexpr bool HAS_LOAD = false;
    unsigned char* ws; bf16_t* AG; int pn0;
    __device__ __forceinline__ void operator()(const pg8::Unit& u, int row, int col, f32x4 v0, f32x4 v1) const {
        const int pn = u.pn + pn0; col += pn0 * 256; size_t off; int ld, c; bool act = false;
        if (pn < 4) { off = WS_Q; ld = 1024; c = col; }
        else if (pn == 4) { off = WS_K; ld = 256; c = col - 1024; }
        else if (pn == 5) { off = WS_V; ld = 256; c = col - 1280; }
        else if (pn < 10) { off = WS_GA; ld = 1024; c = col - 1536; act = true; }
        else if (pn < 12) {
            const int cu = col - 2560, g = cu >> 4;
            *(u32x4*)(AG + ((size_t)(g * NCHUNK + (row >> 6))) * AGK + (row & 63) * 16 + (cu & 15)) = pack8(v0, v1); return; }
        else if (pn < 14) { off = WS_GS; ld = 512; c = col - 3072; act = true; }
        else if (pn < 16) { off = WS_QX; ld = 512; c = col - 3584; }
        else { off = WS_GX; ld = 512; c = col - 4096; act = true; }
        if (act) { v0 = silu4(v0); v1 = silu4(v1); }
        *(u32x4*)((bf16_t*)(ws + off) + (size_t)row * ld + c) = pack8(v0, v1);
    }
};
struct EpiInProjI8 {
    static constexpr bool PERM = true;
    unsigned char* ws; const float* xs; const float* wsc;
    __device__ __forceinline__ void operator()(const f32x4 (&acc)[2][2][4][2], const pg8::Unit& u, int wr, int wc, int fr, int fq) const {
        const int row0 = u.pm * 256 + wr * 64 + fr, col0 = u.pn * 256 + wc * 32 + 8 * fq, pn = u.pn;
        float rs[2][4]; f32x4 cs[2][2];
#pragma unroll
        for (int ai = 0; ai < 2; ++ai)
#pragma unroll
            for (int m = 0; m < 4; ++m) rs[ai][m] = xs[row0 + ai * 128 + m * 16];
#pragma unroll
        for (int bj = 0; bj < 2; ++bj)
#pragma unroll
            for (int n = 0; n < 2; ++n) cs[bj][n] = *(const f32x4*)(wsc + col0 + bj * 128 + 4 * n);
        size_t off; int ld, c0; bool act = false;
        if (pn < 4) { off = WS_Q; ld = 1024; c0 = col0; }
        else if (pn == 4) { off = WS_K; ld = 256; c0 = col0 - 1024; }
        else if (pn == 5) { off = WS_V; ld = 256; c0 = col0 - 1280; }
        else if (pn < 10) { off = WS_GA; ld = 1024; c0 = col0 - 1536; act = true; }
        else if (pn < 12) { off = WS_QX; ld = 512; c0 = col0 - 2560; }
        else { off = WS_GX; ld = 512; c0 = col0 - 3072; act = true; }
        bf16_t* base = (bf16_t*)(ws + off);
#pragma unroll
        for (int ai = 0; ai < 2; ++ai)
#pragma unroll
            for (int m = 0; m < 4; ++m) {
#pragma unroll
                for (int bj = 0; bj < 2; ++bj) {
                    f32x4 v0 = __builtin_convertvector(__builtin_bit_cast(i32x4, acc[ai][bj][m][0]), f32x4) * rs[ai][m] * cs[bj][0];
                    f32x4 v1 = __builtin_convertvector(__builtin_bit_cast(i32x4, acc[ai][bj][m][1]), f32x4) * rs[ai][m] * cs[bj][1];
                    if (act) { v0 = silu4(v0); v1 = silu4(v1); }
                    *(u32x4*)(base + (size_t)(row0 + ai * 128 + m * 16) * ld + c0 + bj * 128) = pack8(v0, v1);
                }
                asm volatile("" ::: "memory");
            }
    }
};
struct EpiMergeI8 {
    static constexpr bool PERM = true;
    const unsigned char* wsb; const float* xs; const float* wsc; bf16_t* MG;
    __device__ __forceinline__ void operator()(f32x4 (&acc)[2][2][4][2], const pg8::Unit& u, int wr, int wc, int fr, int fq) const {
        { int l; asm volatile("v_mbcnt_lo_u32_b32 %0, -1, 0\n\tv_mbcnt_hi_u32_b32 %0, -1, %0" : "=v"(l)); fr = l & 15; fq = l >> 4; }
        const int k = u.pn >> 2, br = 2 * k, rowt = u.pm * 256, ct = (u.pn & 3) * 256;
        const unsigned lrow = (unsigned)(wr * 64 + fr), lcol = (unsigned)(wc * 32 + 8 * fq), loff = lrow * 1024u + lcol;
        const float* xsb = xs + rowt; const float* wb = wsc + u.pn * 256;
        const bf16_t* Pt = (const bf16_t*)(wsb + (size_t)(360 + 240 * br) * MiB) + (size_t)rowt * 1024 + ct;
        bf16_t* Mt = MG + (size_t)rowt * 1024 + ct;
        {
            f32x4 cs[2][2];
#pragma unroll
            for (int bj = 0; bj < 2; ++bj)
#pragma unroll
                for (int n = 0; n < 2; ++n) cs[bj][n] = *(const f32x4*)((wb + bj * 128 + 4 * n) + lcol);
#pragma unroll
            for (int ai = 0; ai < 2; ++ai)
#pragma unroll
                for (int m = 0; m < 4; ++m) { const float rsv = (xsb + ai * 128 + m * 16)[lrow];
#pragma unroll
                    for (int bj = 0; bj < 2; ++bj)
#pragma unroll
                        for (int n = 0; n < 2; ++n) acc[ai][bj][m][n] = sig4(__builtin_convertvector(__builtin_bit_cast(i32x4, acc[ai][bj][m][n]), f32x4) * rsv * cs[bj][n]); }
        }
#pragma unroll
        for (int ai = 0; ai < 2; ++ai) {
            u32x4 pv[4][2], av[4][2];
#pragma unroll
            for (int m = 0; m < 4; ++m)
#pragma unroll
                for (int bj = 0; bj < 2; ++bj) { const size_t o = (size_t)(ai * 128 + m * 16) * 1024 + bj * 128;
                    pv[m][bj] = *(const u32x4*)((Pt + o) + loff); if (br != 0) av[m][bj] = *(const u32x4*)((Mt + o) + loff); else av[m][bj] = (u32x4){0u, 0u, 0u, 0u}; }
#pragma unroll
            for (int m = 0; m < 4; ++m)
#pragma unroll
                for (int bj = 0; bj < 2; ++bj) { const size_t o = (size_t)(ai * 128 + m * 16) * 1024 + bj * 128;
                    f32x4 p0, p1, a0, a1; unpack8(pv[m][bj], p0, p1); unpack8(av[m][bj], a0, a1);
                    *(u32x4*)((Mt + o) + loff) = pack8(a0 + acc[ai][bj][m][0] * p0, a1 + acc[ai][bj][m][1] * p1); }
            asm volatile("" ::: "memory");
        }
    }
};
static_assert(WS_GA == 360 * MiB && WS_PX == 840 * MiB, "EpiMergeI8 offset arithmetic");
struct FStoreBf16 { static constexpr bool HAS_LOAD = false; bf16_t* O; int ldc;
    __device__ __forceinline__ void operator()(const pg8::Unit&, int row, int col, f32x4 v0, f32x4 v1) const { *(u32x4*)(O + (size_t)row * ldc + col) = pack8(v0, v1); } };
struct FStorePSX { static constexpr bool HAS_LOAD = false; unsigned char* ws;
    __device__ __forceinline__ void operator()(const pg8::Unit& u, int row, int col, f32x4 v0, f32x4 v1) const {
        const int g = u.pn >> 2; bf16_t* O = (bf16_t*)(ws + (g ? WS_PX : WS_PS));
        *(u32x4*)(O + (size_t)(row - g * NTOK) * 1024 + (col - g * 1024)) = pack8(v0, v1); } };
struct FStoreEC { static constexpr bool HAS_LOAD = false; float* O;
    __device__ __forceinline__ void operator()(const pg8::Unit& u, int row, int col, f32x4 v0, f32x4 v1) const { float* p = O + (size_t)row * 256 + (col - u.pn * 256); *(f32x4*)p = v0; *(f32x4*)(p + 4) = v1; } };
struct FS5Out { static constexpr bool HAS_LOAD = false; bf16_t* YG;
    __device__ __forceinline__ void operator()(const pg8::Unit& u, int row, int col, f32x4 v0, f32x4 v1) const {
        const int g = u.pn >> 2, chunk = row - g * NCHUNK, cl = col - g * 1024, i = cl >> 4, c0 = cl & 15;
        *(u32x4*)(YG + (size_t)(chunk * CH + i) * 512 + g * 16 + c0) = pack8(gelu4(v0), gelu4(v1));
    } };
struct FGlu { static constexpr bool HAS_LOAD = true; const bf16_t* YG; bf16_t* GS; const float* bias;
    struct Ld { u32x4 y, g; };
    __device__ __forceinline__ Ld load(const pg8::Unit&, int row, int col) const { const size_t o = (size_t)row * 512 + col; Ld l; l.y = *(const u32x4*)(YG + o); l.g = *(const u32x4*)(GS + o); return l; }
    __device__ __forceinline__ void apply(const pg8::Unit&, int row, int col, f32x4 v0, f32x4 v1, const Ld& l) const {
        const size_t o = (size_t)row * 512 + col; f32x4 y0, y1, g0, g1; unpack8(l.y, y0, y1); unpack8(l.g, g0, g1);
        const f32x4 b0 = *(const f32x4*)(bias + col), b1 = *(const f32x4*)(bias + col + 4);
        *(u32x4*)(GS + o) = pack8(y0 * sig4(v0 + b0) * g0, y1 * sig4(v1 + b1) * g1);
    } };
static_assert(WS_GA == 360 * MiB && WS_PS == 520 * MiB && WS_PX == 840 * MiB, "FMerge offset arithmetic");
struct FMerge { static constexpr bool HAS_LOAD = true; const unsigned char* wsb; bf16_t* MG; int brofs;
    struct Ld { u32x4 p, a; };
    __device__ __forceinline__ Ld load(const pg8::Unit& u, int row, int col) const {
        const int br = (u.pn >> 2) + brofs, c = col - (u.pn >> 2) * 1024; const size_t o = (size_t)row * 1024 + c;
        const bf16_t* P = (const bf16_t*)(wsb + (size_t)(360 + 160 * br + 160 * (br >> 1)) * MiB);
        Ld l; l.p = *(const u32x4*)(P + o); if (br != 0) l.a = *(const u32x4*)(MG + o); else l.a = (u32x4){0u, 0u, 0u, 0u}; return l;
    }
    __device__ __forceinline__ void apply(const pg8::Unit& u, int row, int col, f32x4 v0, f32x4 v1, const Ld& l) const {
        const int c = col - (u.pn >> 2) * 1024; const size_t o = (size_t)row * 1024 + c;
        f32x4 p0, p1, a0, a1; unpack8(l.p, p0, p1); unpack8(l.a, a0, a1);
        *(u32x4*)(MG + o) = pack8(a0 + sig4(v0) * p0, a1 + sig4(v1) * p1);
    } };
struct EpiOutNorm {
    static constexpr bool PERM = true;
    const float* xp; const float* xs; float* out; const float* gfin; float* rowss; unsigned* cnt;
    __device__ __forceinline__ void operator()(f32x4 (&acc)[2][2][4][2], const pg8::Unit& u, int wr, int wc, int fr, int fq) const {
        { int l; asm volatile("v_mbcnt_lo_u32_b32 %0, -1, 0\n\tv_mbcnt_hi_u32_b32 %0, -1, %0" : "=v"(l)); fr = l & 15; fq = l >> 4; }
        const int rowt = u.pm * 256, col0 = u.pn * 256 + wc * 32 + 8 * fq;
        const float* xb = rowt < NPROMPT ? xp + (size_t)rowt * DM : xs + (size_t)(rowt - NPROMPT) * DM;
        float* ob = out + (size_t)rowt * DM; float* rs = rowss + rowt;
        const unsigned loff = (unsigned)((wr * 64 + fr) * DM + col0), lrow = (unsigned)(wr * 64 + fr);
#pragma unroll
        for (int am = 0; am < 4; ++am) {
            const int ai = am >> 1, mb = (am & 1) * 2;
            const float* xq = xb;
            if (am == 0) asm volatile("" : "+s"(xq));
            else asm volatile("" : "+s"(xq), "+v"(acc[(am - 1) >> 1][1][((am - 1) & 1) * 2 + 1][1]));
            f32x4 xa[2][2][2];
#pragma unroll
            for (int mm = 0; mm < 2; ++mm)
#pragma unroll
                for (int bj = 0; bj < 2; ++bj) { const float* xt = xq + (size_t)(ai * 128 + (mb + mm) * 16) * DM + bj * 128; xa[mm][bj][0] = *(const f32x4*)(xt + loff); xa[mm][bj][1] = *(const f32x4*)(xt + 4 + loff); }
#pragma unroll
            for (int mm = 0; mm < 2; ++mm)
#pragma unroll
                for (int bj = 0; bj < 2; ++bj) { acc[ai][bj][mb + mm][0] += xa[mm][bj][0]; acc[ai][bj][mb + mm][1] += xa[mm][bj][1]; }
            asm volatile("" ::: "memory");
        }
#pragma unroll
        for (int ai = 0; ai < 2; ++ai)
#pragma unroll
            for (int m = 0; m < 4; ++m) { float sq = 0.f;
#pragma unroll
                for (int bj = 0; bj < 2; ++bj)
#pragma unroll
                    for (int n = 0; n < 2; ++n) { const f32x4 v = acc[ai][bj][m][n]; sq += (v[0] * v[0] + v[1] * v[1]) + (v[2] * v[2] + v[3] * v[3]); }
                { auto rr = __builtin_amdgcn_permlane16_swap(__float_as_uint(sq), __float_as_uint(sq), false, false); sq = __uint_as_float(rr[0]) + __uint_as_float(rr[1]); }
                { auto rr = __builtin_amdgcn_permlane32_swap(__float_as_uint(sq), __float_as_uint(sq), false, false); sq = __uint_as_float(rr[0]) + __uint_as_float(rr[1]); }
                if (fq == 0) atomicAdd((rs + ai * 128 + m * 16) + lrow, sq);
            }
        asm volatile("s_waitcnt vmcnt(0)" ::: "memory");
        __syncthreads();
        if (wr == 0 && wc == 0 && fr == 0 && fq == 0) {
            __builtin_amdgcn_fence(__ATOMIC_RELEASE, "agent");
            __hip_atomic_fetch_add(cnt + u.pm, 1u, __ATOMIC_RELAXED, __HIP_MEMORY_SCOPE_AGENT);
            unsigned spins = 0;
            while (__hip_atomic_load(cnt + u.pm, __ATOMIC_RELAXED, __HIP_MEMORY_SCOPE_AGENT) < 4u && ++spins < (1u << 24)) __builtin_amdgcn_s_sleep(1);
            __builtin_amdgcn_fence(__ATOMIC_ACQUIRE, "agent");
        }
        __syncthreads();
        const float* gp = gfin; asm volatile("" : "+s"(gp));
#pragma unroll
        for (int ai = 0; ai < 2; ++ai)
#pragma unroll
            for (int m = 0; m < 4; ++m) {
                const float rstd = rsqrtf(__hip_atomic_load((rs + ai * 128 + m * 16) + lrow, __ATOMIC_RELAXED, __HIP_MEMORY_SCOPE_AGENT) * (1.f / DM) + EPS);
#pragma unroll
                for (int bj = 0; bj < 2; ++bj) { const f32x4 g0 = *(const f32x4*)(gp + col0 + bj * 128), g1 = *(const f32x4*)(gp + col0 + bj * 128 + 4);
                    float* ot = ob + (size_t)(ai * 128 + m * 16) * DM + bj * 128;
                    *(f32x4*)(ot + loff) = acc[ai][bj][m][0] * rstd * g0; *(f32x4*)(ot + 4 + loff) = acc[ai][bj][m][1] * rstd * g1; }
            }
    }
};

namespace att {
constexpr int D = 128, NW = 8, QBLK = 32, KVBLK = 64;
constexpr float SCALE = 0.088388347648318440f, THR = 8.f;
constexpr size_t SHM_V = KVBLK * D * 2, SHM_K = KVBLK * D * 2, SHM_ATTN = 2 * SHM_V + 2 * SHM_K + NW * 64 * 4;
#define KSWZ(row, colB) ((row) * 256 + ((colB) ^ (((row) & 7) << 4)))
#define SBAR() __builtin_amdgcn_sched_barrier(0)
__device__ __forceinline__ int crow(int r, int hi) { return (r & 3) + 8 * (r >> 2) + 4 * hi; }
__device__ __forceinline__ void partialSM(f32x16& p0, f32x16& p1, float& m_reg, float& mn, float& alpha) {
    constexpr float C = SCALE * 1.4426950408889634f;
    float pmax = p0[0];
#pragma unroll
    for (int r = 1; r < 16; ++r) pmax = fmaxf(pmax, p0[r]);
#pragma unroll
    for (int r = 0; r < 16; ++r) pmax = fmaxf(pmax, p1[r]);
    { auto rr = __builtin_amdgcn_permlane32_swap(__float_as_uint(pmax), __float_as_uint(pmax), false, false);
      pmax = fmaxf(__uint_as_float(rr[0]), __uint_as_float(rr[1])); }
    if (__builtin_expect(__all(pmax - m_reg <= THR / SCALE), 1)) { mn = m_reg; alpha = 1.f; }
    else { mn = fmaxf(m_reg, pmax); alpha = __builtin_amdgcn_exp2f((m_reg - mn) * C); m_reg = mn; }
    const float mnC = -mn * C;
#pragma unroll
    for (int r = 0; r < 16; ++r) p0[r] = fmaf(p0[r], C, mnC);
#pragma unroll
    for (int r = 0; r < 16; ++r) p1[r] = fmaf(p1[r], C, mnC);
#pragma unroll
    for (int r = 0; r < 16; ++r) p0[r] = __builtin_amdgcn_exp2f(p0[r]);
}
__device__ __forceinline__ void finishSM(f32x16& p0, f32x16& p1, float alpha, float& l_reg, bf16x8& pa0, bf16x8& pa1, bf16x8& pa2, bf16x8& pa3) {
#pragma unroll
    for (int r = 0; r < 16; ++r) p1[r] = __builtin_amdgcn_exp2f(p1[r]);
    float ps = 0;
#pragma unroll
    for (int r = 0; r < 16; ++r) ps += p0[r];
#pragma unroll
    for (int r = 0; r < 16; ++r) ps += p1[r];
    { auto rr = __builtin_amdgcn_permlane32_swap(__float_as_uint(ps), __float_as_uint(ps), false, false);
      ps = __uint_as_float(rr[0]) + __uint_as_float(rr[1]); }
    l_reg = l_reg * alpha + ps;
#define PK4(P, BASE, OUT) do { unsigned a0 = cvtpk(P[BASE + 0], P[BASE + 1]), a1 = cvtpk(P[BASE + 2], P[BASE + 3]);   \
    unsigned b0 = cvtpk(P[BASE + 4], P[BASE + 5]), b1 = cvtpk(P[BASE + 6], P[BASE + 7]);                              \
    auto r0 = __builtin_amdgcn_permlane32_swap(a0, b0, false, false); auto r1 = __builtin_amdgcn_permlane32_swap(a1, b1, false, false); \
    u32x4 w = {r0[0], r1[0], r0[1], r1[1]}; OUT = *reinterpret_cast<bf16x8*>(&w); } while (0)
    PK4(p0, 0, pa0); PK4(p0, 8, pa1); PK4(p1, 0, pa2); PK4(p1, 8, pa3);
#undef PK4
}
__device__ __forceinline__ void qkt(f32x16& p0, f32x16& p1, const bf16_t* Ks, const bf16x8* qr, int r32, int hi) {
    p0 = f32x16{}; p1 = f32x16{};
#pragma unroll
    for (int d0 = 0; d0 < 8; ++d0) { const int cb = (d0 * 16 + hi * 8) * 2;
        bf16x8 b0 = *reinterpret_cast<const bf16x8*>((const char*)Ks + KSWZ(r32, cb));
        bf16x8 b1 = *reinterpret_cast<const bf16x8*>((const char*)Ks + KSWZ(32 + r32, cb));
        p0 = __builtin_amdgcn_mfma_f32_32x32x16_bf16(b0, qr[d0], p0, 0, 0, 0);
        p1 = __builtin_amdgcn_mfma_f32_32x32x16_bf16(b1, qr[d0], p1, 0, 0, 0); }
}
__device__ __forceinline__ int v_st(int k, int c) { const int kk = (k & ~0xC) | ((k & 4) << 1) | ((k & 8) >> 1); return ((kk >> 3) * 4 + (c >> 5)) * 512 + ((kk & 7) * 32 + (c & 31)) * 2; }
__device__ __forceinline__ int v_rd_base(int lane) { return ((lane & 3) << 3) | (((lane >> 2) & 3) << 6) | (((lane >> 4) & 1) << 5) | (((lane >> 5) & 1) << 8); }
constexpr int v_rd_off(int d0, int ks, int half) { return d0 * 512 + ks * 4096 + half * 2048; }
template <int OFF> __device__ __forceinline__ s16x4 tr_read(int vb) {
    s16x4 r; asm volatile("ds_read_b64_tr_b16 %0, %1 offset:%2" : "=&v"(r) : "v"(vb), "i"(OFF) : "memory"); return r;
}
template <int D0> __device__ __forceinline__ void pv_one(f32x16& od, int vb, bf16x8 pa0, bf16x8 pa1, bf16x8 pa2, bf16x8 pa3) {
    const s16x4 l0 = tr_read<v_rd_off(D0, 0, 0)>(vb), h0 = tr_read<v_rd_off(D0, 0, 1)>(vb), l1 = tr_read<v_rd_off(D0, 1, 0)>(vb), h1 = tr_read<v_rd_off(D0, 1, 1)>(vb);
    const s16x4 l2 = tr_read<v_rd_off(D0, 2, 0)>(vb), h2 = tr_read<v_rd_off(D0, 2, 1)>(vb), l3 = tr_read<v_rd_off(D0, 3, 0)>(vb), h3 = tr_read<v_rd_off(D0, 3, 1)>(vb);
    asm volatile("s_waitcnt lgkmcnt(0)" ::: "memory"); SBAR();
#define PK(L, H) (bf16x8){L[0], L[1], L[2], L[3], H[0], H[1], H[2], H[3]}
    od = __builtin_amdgcn_mfma_f32_32x32x16_bf16(pa0, PK(l0, h0), od, 0, 0, 0);
    od = __builtin_amdgcn_mfma_f32_32x32x16_bf16(pa1, PK(l1, h1), od, 0, 0, 0);
    od = __builtin_amdgcn_mfma_f32_32x32x16_bf16(pa2, PK(l2, h2), od, 0, 0, 0);
    od = __builtin_amdgcn_mfma_f32_32x32x16_bf16(pa3, PK(l3, h3), od, 0, 0, 0);
#undef PK
}
__device__ __forceinline__ void pv_d0(f32x16* o, int vb, bf16x8 pa0, bf16x8 pa1, bf16x8 pa2, bf16x8 pa3) {
    pv_one<0>(o[0], vb, pa0, pa1, pa2, pa3); pv_one<1>(o[1], vb, pa0, pa1, pa2, pa3); pv_one<2>(o[2], vb, pa0, pa1, pa2, pa3); pv_one<3>(o[3], vb, pa0, pa1, pa2, pa3);
}


__device__ __forceinline__ void qkt_i8(f32x16& p0, f32x16& p1, const unsigned char* Ks, const i32x4* qi, const i32x16& cinit, int r32, int hi) {
    i32x16 a0, a1; const int sw = ((r32 >> 1) & 7) << 4;
#pragma unroll
    for (int m = 0; m < 4; ++m) { const int cb = m * 32 + hi * 16;
        const i32x4 b0 = *reinterpret_cast<const i32x4*>(Ks + r32 * 128 + (cb ^ sw));
        const i32x4 b1 = *reinterpret_cast<const i32x4*>(Ks + (32 + r32) * 128 + (cb ^ sw));
        if (m == 0) { a0 = __builtin_amdgcn_mfma_i32_32x32x32_i8(b0, qi[0], cinit, 0, 0, 0); a1 = __builtin_amdgcn_mfma_i32_32x32x32_i8(b1, qi[0], cinit, 0, 0, 0); }
        else { a0 = __builtin_amdgcn_mfma_i32_32x32x32_i8(b0, qi[m], a0, 0, 0, 0); a1 = __builtin_amdgcn_mfma_i32_32x32x32_i8(b1, qi[m], a1, 0, 0, 0); } }
    p0 = __builtin_bit_cast(f32x16, a0); p1 = __builtin_bit_cast(f32x16, a1);
}
__device__ __forceinline__ void partialSM_i8(f32x16& p0, f32x16& p1, float& m_reg, float& mn, float& alpha, float dq, float Cq, float Kq) {
    constexpr float C = SCALE * 1.4426950408889634f;
    float pmax = p0[0];
#pragma unroll
    for (int r = 1; r < 16; ++r) pmax = fmaxf(pmax, p0[r]);
#pragma unroll
    for (int r = 0; r < 16; ++r) pmax = fmaxf(pmax, p1[r]);
    { auto rr = __builtin_amdgcn_permlane32_swap(__float_as_uint(pmax), __float_as_uint(pmax), false, false);
      pmax = fmaxf(__uint_as_float(rr[0]), __uint_as_float(rr[1])); }
    const float pm = (pmax - 12582912.f) * dq;
    if (__builtin_expect(__all(pm - m_reg <= 4.f / SCALE), 1)) { mn = m_reg; alpha = 1.f; }
    else { mn = fmaxf(m_reg, pm); alpha = __builtin_amdgcn_exp2f((m_reg - mn) * C); m_reg = mn; }
    const float mnC = 3.f - (Kq + mn * C);
#pragma unroll
    for (int r = 0; r < 16; ++r) p0[r] = fmaf(p0[r], Cq, mnC);
#pragma unroll
    for (int r = 0; r < 16; ++r) p1[r] = fmaf(p1[r], Cq, mnC);
#pragma unroll
    for (int r = 0; r < 16; ++r) p0[r] = __builtin_amdgcn_exp2f(p0[r]);
}


typedef int i32x8 __attribute__((ext_vector_type(8)));
__device__ __forceinline__ void finishSM_f8(f32x16& p0, f32x16& p1, float alpha, float& l_reg, i32x8& pa8) {
#pragma unroll
    for (int r = 0; r < 16; ++r) p1[r] = __builtin_amdgcn_exp2f(p1[r]);
    float ps = 0;
#pragma unroll
    for (int r = 0; r < 16; ++r) ps += p0[r];
#pragma unroll
    for (int r = 0; r < 16; ++r) ps += p1[r];
    { auto rr = __builtin_amdgcn_permlane32_swap(__float_as_uint(ps), __float_as_uint(ps), false, false);
      ps = __uint_as_float(rr[0]) + __uint_as_float(rr[1]); }
    l_reg = l_reg * alpha + ps;
#pragma unroll
    for (int d = 0; d < 4; ++d) { int w = __builtin_amdgcn_cvt_pk_fp8_f32(p0[4 * d], p0[4 * d + 1], 0, false); pa8[d] = __builtin_amdgcn_cvt_pk_fp8_f32(p0[4 * d + 2], p0[4 * d + 3], w, true); }
#pragma unroll
    for (int d = 0; d < 4; ++d) { int w = __builtin_amdgcn_cvt_pk_fp8_f32(p1[4 * d], p1[4 * d + 1], 0, false); pa8[4 + d] = __builtin_amdgcn_cvt_pk_fp8_f32(p1[4 * d + 2], p1[4 * d + 3], w, true); }
}
__device__ __forceinline__ void pv8(f32x16* o, const unsigned char* Vs, i32x8 pa8, int r32, int hi) {
#pragma unroll
    for (int cb = 0; cb < 4; ++cb) { const int c = cb * 32 + r32, sw = (c >> 2) & 3;
        const u32x4 b0 = *(const u32x4*)(Vs + c * 64 + (((2 * hi) ^ sw) << 4)), b1 = *(const u32x4*)(Vs + c * 64 + (((2 * hi + 1) ^ sw) << 4));
        const i32x8 b8 = {(int)b0.x, (int)b0.y, (int)b0.z, (int)b0.w, (int)b1.x, (int)b1.y, (int)b1.z, (int)b1.w};
        o[cb] = __builtin_amdgcn_mfma_scale_f32_32x32x64_f8f6f4(pa8, b8, o[cb], 0, 0, 0, 0x7F7F7F7F, 0, 0x7F7F7F7F); }
}

template <int LDQ, int LDK>
__device__ __forceinline__ void attn_unit_i8(const bf16_t* Qb, const unsigned char* __restrict__ K8h, const unsigned char* __restrict__ V8h, const bf16_t* Gb, unsigned char* O8,
                                          int seq, char* lds, int t0, const float* __restrict__ qw, const float* __restrict__ cosT, const float* __restrict__ sinT, float sk, int wv) {
    const int tid = opaque_tid(wv), wid = __builtin_amdgcn_readfirstlane(tid >> 6), lane = tid & 63, r32 = lane & 31, hi = lane >> 5;
    unsigned char* V_lds = (unsigned char*)lds; unsigned char* K_lds = (unsigned char*)(lds + 24576);
    float* wsl = (float*)(lds + 65536) + wid * 64; float* li_l = wsl; float* al_l = wsl + 32;
    float m_reg = -1e30f, l_reg = 0; f32x16 o[4] = {}; i32x4 qi[4];
    const int kr = tid >> 3, kp = tid & 7, kst = kr * 128 + ((kp ^ ((kr >> 1) & 7)) << 4);
    struct { u32x4 vs, ks; } sr_[2];
#define SLOAD(i, k0) do { sr_[i].vs = *(const u32x4*)(V8h + (size_t)((k0) >> 6) * 16384 + tid * 16); \
    sr_[i].ks = *(const u32x4*)(K8h + (long)((k0) + kr) * 256 + kp * 16); } while (0)
#define SWRITE(off, i) do { *(u32x4*)(V_lds + (off) + tid * 16) = sr_[i].vs; *(u32x4*)(K_lds + (off) + kst) = sr_[i].ks; } while (0)
#define SWAIT() asm volatile("s_waitcnt vmcnt(2)" ::: "memory")
#define RESC(a) do { if (__any((a) < 1.f)) { if (hi == 0) al_l[r32] = (a); asm volatile("s_waitcnt lgkmcnt(0)" ::: "memory"); \
    _Pragma("unroll") for (int d = 0; d < 4; ++d) _Pragma("unroll") for (int r = 0; r < 16; ++r) o[d][r] *= al_l[crow(r, hi)]; } } while (0)
    f32x16 pA0, pA1, pB0, pB1; float mnA, mnB, alA, alB; i32x8 pa8; const int NT = seq / KVBLK;
    constexpr int SE = 0, SO = 1;
    SLOAD(SE, 0); SLOAD(SO, KVBLK);
    const bf16_t* Qw = Qb + (long)(wid * QBLK + r32) * LDQ + hi * 8;
    float dq, Cq, Kq; i32x16 cinit;
    {
        bf16x8 qraw[8];
#pragma unroll
        for (int d0 = 0; d0 < 8; ++d0) qraw[d0] = *reinterpret_cast<const bf16x8*>(Qw + d0 * 16);
        float ss = 0.f;
#pragma unroll
        for (int d0 = 0; d0 < 8; ++d0)
#pragma unroll
            for (int j = 0; j < 8; ++j) { const float x = bf2f((bf16_t)qraw[d0][j]); ss += x * x; }
        { auto rr = __builtin_amdgcn_permlane32_swap(__float_as_uint(ss), __float_as_uint(ss), false, false); ss = __uint_as_float(rr[0]) + __uint_as_float(rr[1]); }
        const float rstd = rsqrtf(ss * (1.f / 128.f) + EPS);
        const int t = t0 + wid * QBLK + r32;
        float xq[8][8]; float amax = 1e-20f;
#pragma unroll
        for (int d0 = 0; d0 < 8; ++d0) {
            const int pos = (d0 < 4) ? (t >> 6) : (t & 63);
            const f32x4 cs = *(const f32x4*)(cosT + pos * 32 + (d0 & 3) * 8 + hi * 4), sn = *(const f32x4*)(sinT + pos * 32 + (d0 & 3) * 8 + hi * 4);
            const f32x4 w0 = *(const f32x4*)(qw + d0 * 16 + hi * 8), w1 = *(const f32x4*)(qw + d0 * 16 + hi * 8 + 4);
            float x[8];
#pragma unroll
            for (int j = 0; j < 8; ++j) x[j] = bf2f((bf16_t)qraw[d0][j]) * rstd * (j < 4 ? w0[j] : w1[j - 4]);
#pragma unroll
            for (int pr = 0; pr < 4; ++pr) { xq[d0][2 * pr] = x[2 * pr] * cs[pr] - x[2 * pr + 1] * sn[pr]; xq[d0][2 * pr + 1] = x[2 * pr] * sn[pr] + x[2 * pr + 1] * cs[pr]; }
#pragma unroll
            for (int j = 0; j < 8; ++j) amax = fmaxf(amax, fabsf(xq[d0][j]));
        }
        { auto rr = __builtin_amdgcn_permlane32_swap(__float_as_uint(amax), __float_as_uint(amax), false, false); amax = fmaxf(__uint_as_float(rr[0]), __uint_as_float(rr[1])); }
        const float qinv = 127.f / amax;
        dq = amax * (1.f / 127.f) * sk; Cq = dq * (SCALE * 1.4426950408889634f); Kq = 12582912.f * Cq;
#pragma unroll
        for (int m = 0; m < 4; ++m) {
            unsigned w[4];
#pragma unroll
            for (int hf = 0; hf < 2; ++hf)
#pragma unroll
                for (int g4 = 0; g4 < 2; ++g4) { const float* xv = &xq[2 * m + hf][4 * g4];
                    const int a = (int)rintf(xv[0] * qinv), b = (int)rintf(xv[1] * qinv), c = (int)rintf(xv[2] * qinv), d = (int)rintf(xv[3] * qinv);
                    w[hf * 2 + g4] = (unsigned)(a & 255) | ((unsigned)(b & 255) << 8) | ((unsigned)(c & 255) << 16) | ((unsigned)d << 24); }
            qi[m] = (i32x4){(int)w[0], (int)w[1], (int)w[2], (int)w[3]};
        }
#pragma unroll
        for (int r = 0; r < 16; ++r) cinit[r] = 0x4B400000;
        asm volatile("" : "+v"(cinit));
    }
    asm volatile("s_waitcnt vmcnt(0)" ::: "memory"); SWRITE(0, SE); __syncthreads();
    qkt_i8(pA0, pA1, K_lds, qi, cinit, r32, hi); partialSM_i8(pA0, pA1, m_reg, mnA, alA, dq, Cq, Kq);
    SLOAD(SE, 2 * KVBLK);
    SWRITE(8192, SO); __syncthreads();
    int so_prev = 0, so_cur = 8192, so_next = 16384;
#define ROT3() do { const int t_ = so_prev; so_prev = so_cur; so_cur = so_next; so_next = t_; } while (0)
    if (wid >= 4) __builtin_amdgcn_s_setprio(1);
    for (int j = 1; j + 1 < NT; j += 2) {
        SBAR(); qkt_i8(pB0, pB1, K_lds + so_cur, qi, cinit, r32, hi);
        finishSM_f8(pA0, pA1, alA, l_reg, pa8); SBAR();
        SLOAD(SO, (j + 2) * KVBLK); SBAR();
        pv8(o, V_lds + so_prev, pa8, r32, hi); partialSM_i8(pB0, pB1, m_reg, mnB, alB, dq, Cq, Kq);
        SWAIT(); SWRITE(so_next, SE);
        RESC(alB); __syncthreads(); ROT3();
        SBAR(); qkt_i8(pA0, pA1, K_lds + so_cur, qi, cinit, r32, hi);
        finishSM_f8(pB0, pB1, alB, l_reg, pa8); SBAR();
        SLOAD(SE, (j + 3) * KVBLK); SBAR();
        pv8(o, V_lds + so_prev, pa8, r32, hi); partialSM_i8(pA0, pA1, m_reg, mnA, alA, dq, Cq, Kq);
        SWAIT(); SWRITE(so_next, SO);
        RESC(alA); __syncthreads(); ROT3();
    }
    SBAR(); qkt_i8(pB0, pB1, K_lds + so_cur, qi, cinit, r32, hi);
    finishSM_f8(pA0, pA1, alA, l_reg, pa8); SBAR();
    pv8(o, V_lds + so_prev, pa8, r32, hi); partialSM_i8(pB0, pB1, m_reg, mnB, alB, dq, Cq, Kq);
    RESC(alB);
    finishSM_f8(pB0, pB1, alB, l_reg, pa8); SBAR();
    pv8(o, V_lds + so_cur, pa8, r32, hi);
#undef ROT3
    __builtin_amdgcn_s_setprio(0);
    int l2; asm volatile("v_mbcnt_lo_u32_b32 %0, -1, 0\n\tv_mbcnt_hi_u32_b32 %0, -1, %0" : "=v"(l2));
    const int hi2 = l2 >> 5, r322 = l2 & 31;
    if (hi2 == 0) li_l[r322] = l_reg; asm volatile("s_waitcnt lgkmcnt(0)" ::: "memory");
    float rli[16];
#pragma unroll
    for (int r = 0; r < 16; ++r) rli[r] = __builtin_amdgcn_rcpf(li_l[crow(r, hi2)]);
    unsigned char* O8w = O8 + (long)(wid * QBLK) * LDQ; const bf16_t* Gw = Gb + (long)(wid * QBLK) * LDQ;
    constexpr float osc = (LDQ == 1024) ? 64.f : 16.f;
    __syncthreads();
    bf16_t* stg = (bf16_t*)lds + wid * 4096;
#pragma unroll
    for (int r = 0; r < 16; ++r) { const int orow = crow(r, hi2);
#pragma unroll
        for (int d0 = 0; d0 < 4; ++d0) stg[orow * 128 + d0 * 32 + r322] = (bf16_t)(cvtpk(o[d0][r] * rli[r], 0.f) & 0xffffu); }
    asm volatile("s_waitcnt lgkmcnt(0)" ::: "memory");
    const unsigned lo2 = (unsigned)((l2 >> 4) * LDQ + (l2 & 15) * 8);
    u32x4 gv[8], ov[8];
#pragma unroll
    for (int i = 0; i < 8; ++i) gv[i] = *(const u32x4*)((Gw + i * 4 * LDQ) + lo2);
#pragma unroll
    for (int i = 0; i < 8; ++i) ov[i] = *(const u32x4*)(stg + (i * 4 + (l2 >> 4)) * 128 + (l2 & 15) * 8);
#pragma unroll
    for (int i = 0; i < 8; ++i) {
        int w0 = __builtin_amdgcn_cvt_pk_fp8_f32(bflo(ov[i].x) * bflo(gv[i].x) * osc, bfhi(ov[i].x) * bfhi(gv[i].x) * osc, 0, false);
        w0 = __builtin_amdgcn_cvt_pk_fp8_f32(bflo(ov[i].y) * bflo(gv[i].y) * osc, bfhi(ov[i].y) * bfhi(gv[i].y) * osc, w0, true);
        int w1 = __builtin_amdgcn_cvt_pk_fp8_f32(bflo(ov[i].z) * bflo(gv[i].z) * osc, bfhi(ov[i].z) * bfhi(gv[i].z) * osc, 0, false);
        w1 = __builtin_amdgcn_cvt_pk_fp8_f32(bflo(ov[i].w) * bflo(gv[i].w) * osc, bfhi(ov[i].w) * bfhi(gv[i].w) * osc, w1, true);
        *(u32x2*)((O8w + i * 4 * LDQ) + lo2) = (u32x2){(unsigned)w0, (unsigned)w1}; }
    __syncthreads();
#undef SLOAD
#undef SWRITE
#undef SWAIT
#undef RESC
}

template <bool ROPE, int LDQ, int LDK>
__device__ __forceinline__ void attn_unit(const bf16_t* Qb, const bf16_t* __restrict__ Kh, const bf16_t* __restrict__ Vh, const bf16_t* Gb, bf16_t* Ob,
                                          int seq, char* lds, int t0, const float* __restrict__ qw, const float* __restrict__ cosT, const float* __restrict__ sinT, int wv) {
    const int tid = opaque_tid(wv), wid = __builtin_amdgcn_readfirstlane(tid >> 6), lane = tid & 63, r32 = lane & 31, hi = lane >> 5;
    bf16_t* V_lds = (bf16_t*)lds; bf16_t* K_lds = (bf16_t*)(lds + 2 * SHM_V);
    float* wsl = (float*)(lds + 2 * SHM_V + 2 * SHM_K) + wid * 64; float* li_l = wsl; float* al_l = wsl + 32;
    float m_reg = -1e30f, l_reg = 0; f32x16 o[4] = {}; bf16x8 qr[8];
    const int sr = tid >> 4, sc = (tid & 15) * 8, vst0 = v_st(sr, sc), vst1 = v_st(32 + sr, sc);
    const int vb0 = (int)(uintptr_t)V_lds + v_rd_base(lane);
    struct { bf16x8 vs0, vs1, ks0, ks1; } sr_[2];
#define SLOAD(i, k0) do { sr_[i].vs0 = *(const bf16x8*)(&Vh[(long)((k0) + sr) * LDK + sc]); sr_[i].vs1 = *(const bf16x8*)(&Vh[(long)((k0) + 32 + sr) * LDK + sc]); \
    sr_[i].ks0 = *(const bf16x8*)(&Kh[(long)((k0) + sr) * LDK + sc]); sr_[i].ks1 = *(const bf16x8*)(&Kh[(long)((k0) + 32 + sr) * LDK + sc]); } while (0)
#define SWRITE(b, i) do { *(bf16x8*)((char*)V_lds + (b) * SHM_V + vst0) = sr_[i].vs0;          \
    *(bf16x8*)((char*)V_lds + (b) * SHM_V + vst1) = sr_[i].vs1; int kc = sc * 2;               \
    *(bf16x8*)((char*)K_lds + (b) * SHM_K + KSWZ(sr, kc)) = sr_[i].ks0;                       \
    *(bf16x8*)((char*)K_lds + (b) * SHM_K + KSWZ(32 + sr, kc)) = sr_[i].ks1; } while (0)
#define SWAIT() asm volatile("s_waitcnt vmcnt(4)" ::: "memory")
#define RESC(a) do { if (__any((a) < 1.f)) { if (hi == 0) al_l[r32] = (a); asm volatile("s_waitcnt lgkmcnt(0)" ::: "memory"); \
    _Pragma("unroll") for (int d = 0; d < 4; ++d) _Pragma("unroll") for (int r = 0; r < 16; ++r) o[d][r] *= al_l[crow(r, hi)]; } } while (0)
    f32x16 pA0, pA1, pB0, pB1; float mnA, mnB, alA, alB; bf16x8 pa0, pa1, pa2, pa3; const int NT = seq / KVBLK;
    constexpr int SE = 0, SO = 1;
    SLOAD(SE, 0); SLOAD(SO, KVBLK);
    const bf16_t* Qw = Qb + (long)(wid * QBLK + r32) * LDQ + hi * 8;
#pragma unroll
    for (int d0 = 0; d0 < 8; ++d0) qr[d0] = *reinterpret_cast<const bf16x8*>(Qw + d0 * 16);
    if constexpr (ROPE) {
        float ss = 0.f;
#pragma unroll
        for (int d0 = 0; d0 < 8; ++d0)
#pragma unroll
            for (int j = 0; j < 8; ++j) { const float x = bf2f((bf16_t)qr[d0][j]); ss += x * x; }
        { auto rr = __builtin_amdgcn_permlane32_swap(__float_as_uint(ss), __float_as_uint(ss), false, false); ss = __uint_as_float(rr[0]) + __uint_as_float(rr[1]); }
        const float rstd = rsqrtf(ss * (1.f / 128.f) + EPS);
        const int t = t0 + wid * QBLK + r32;
#pragma unroll
        for (int d0 = 0; d0 < 8; ++d0) {
            const int pos = (d0 < 4) ? (t >> 6) : (t & 63);
            const f32x4 cs = *(const f32x4*)(cosT + pos * 32 + (d0 & 3) * 8 + hi * 4), sn = *(const f32x4*)(sinT + pos * 32 + (d0 & 3) * 8 + hi * 4);
            const f32x4 w0 = *(const f32x4*)(qw + d0 * 16 + hi * 8), w1 = *(const f32x4*)(qw + d0 * 16 + hi * 8 + 4);
            float x[8];
#pragma unroll
            for (int j = 0; j < 8; ++j) x[j] = bf2f((bf16_t)qr[d0][j]) * rstd * (j < 4 ? w0[j] : w1[j - 4]);
            u32x4 w;
            w.x = cvtpk(x[0] * cs[0] - x[1] * sn[0], x[0] * sn[0] + x[1] * cs[0]);
            w.y = cvtpk(x[2] * cs[1] - x[3] * sn[1], x[2] * sn[1] + x[3] * cs[1]);
            w.z = cvtpk(x[4] * cs[2] - x[5] * sn[2], x[4] * sn[2] + x[5] * cs[2]);
            w.w = cvtpk(x[6] * cs[3] - x[7] * sn[3], x[6] * sn[3] + x[7] * cs[3]);
            qr[d0] = *reinterpret_cast<bf16x8*>(&w);
        }
    }
    asm volatile("s_waitcnt vmcnt(0)" ::: "memory"); SWRITE(0, SE); __syncthreads();
    qkt(pA0, pA1, K_lds, qr, r32, hi); partialSM(pA0, pA1, m_reg, mnA, alA);
    SLOAD(SE, 2 * KVBLK);
    SWRITE(1, SO); __syncthreads();
    if (wid >= 4) __builtin_amdgcn_s_setprio(1);
    for (int j = 1; j + 1 < NT; j += 2) {
        SBAR(); qkt(pB0, pB1, (bf16_t*)((char*)K_lds + SHM_K), qr, r32, hi);
        finishSM(pA0, pA1, alA, l_reg, pa0, pa1, pa2, pa3); SBAR();
        SLOAD(SO, (j + 2) * KVBLK); SBAR();
        pv_d0(o, vb0, pa0, pa1, pa2, pa3); partialSM(pB0, pB1, m_reg, mnB, alB);
        __syncthreads(); SWAIT(); SWRITE(0, SE);
        RESC(alB); __syncthreads();
        SBAR(); qkt(pA0, pA1, K_lds, qr, r32, hi);
        finishSM(pB0, pB1, alB, l_reg, pa0, pa1, pa2, pa3); SBAR();
        SLOAD(SE, (j + 3) * KVBLK); SBAR();
        pv_d0(o, vb0 + (int)SHM_V, pa0, pa1, pa2, pa3); partialSM(pA0, pA1, m_reg, mnA, alA);
        __syncthreads(); SWAIT(); SWRITE(1, SO);
        RESC(alA); __syncthreads();
    }
    SBAR(); qkt(pB0, pB1, (bf16_t*)((char*)K_lds + SHM_K), qr, r32, hi);
    finishSM(pA0, pA1, alA, l_reg, pa0, pa1, pa2, pa3); SBAR();
    pv_d0(o, vb0, pa0, pa1, pa2, pa3); partialSM(pB0, pB1, m_reg, mnB, alB);
    __syncthreads(); RESC(alB);
    finishSM(pB0, pB1, alB, l_reg, pa0, pa1, pa2, pa3); SBAR();
    pv_d0(o, vb0 + (int)SHM_V, pa0, pa1, pa2, pa3);
    __builtin_amdgcn_s_setprio(0);
    int l2; asm volatile("v_mbcnt_lo_u32_b32 %0, -1, 0\n\tv_mbcnt_hi_u32_b32 %0, -1, %0" : "=v"(l2));
    const int hi2 = l2 >> 5, r322 = l2 & 31;
    if (hi2 == 0) li_l[r322] = l_reg; asm volatile("s_waitcnt lgkmcnt(0)" ::: "memory");
    float rli[16];
#pragma unroll
    for (int r = 0; r < 16; ++r) rli[r] = __builtin_amdgcn_rcpf(li_l[crow(r, hi2)]);
    bf16_t* Ow = Ob + (long)(wid * QBLK) * LDQ; const bf16_t* Gw = Gb + (long)(wid * QBLK) * LDQ;
    __syncthreads();
    bf16_t* stg = (bf16_t*)lds + wid * 4096;
#pragma unroll
    for (int r = 0; r < 16; ++r) { const int orow = crow(r, hi2);
#pragma unroll
        for (int d0 = 0; d0 < 4; ++d0) stg[orow * 128 + d0 * 32 + r322] = (bf16_t)(cvtpk(o[d0][r] * rli[r], 0.f) & 0xffffu); }
    asm volatile("s_waitcnt lgkmcnt(0)" ::: "memory");
    const unsigned lo2 = (unsigned)((l2 >> 4) * LDQ + (l2 & 15) * 8);
    u32x4 gv[8], ov[8];
#pragma unroll
    for (int i = 0; i < 8; ++i) gv[i] = *(const u32x4*)((Gw + i * 4 * LDQ) + lo2);
#pragma unroll
    for (int i = 0; i < 8; ++i) ov[i] = *(const u32x4*)(stg + (i * 4 + (l2 >> 4)) * 128 + (l2 & 15) * 8);
#pragma unroll
    for (int i = 0; i < 8; ++i) { u32x4 w;
        w.x = cvtpk(bflo(ov[i].x) * bflo(gv[i].x), bfhi(ov[i].x) * bfhi(gv[i].x)); w.y = cvtpk(bflo(ov[i].y) * bflo(gv[i].y), bfhi(ov[i].y) * bfhi(gv[i].y));
        w.z = cvtpk(bflo(ov[i].z) * bflo(gv[i].z), bfhi(ov[i].z) * bfhi(gv[i].z)); w.w = cvtpk(bflo(ov[i].w) * bflo(gv[i].w), bfhi(ov[i].w) * bfhi(gv[i].w));
        *(u32x4*)((Ow + i * 4 * LDQ) + lo2) = w; }
    __syncthreads();
#undef SLOAD
#undef SWRITE
#undef SWAIT
#undef RESC
}
#undef KSWZ
#undef SBAR
}

struct Params {
    const float* in[25];
    float* out; unsigned char* ws;
};

__device__ __forceinline__ void transpose_item(const float* __restrict__ W, int K, int N, bf16_t* __restrict__ WT, LAS float* scr, int item, int lane) {
    const int nblk = N / 32, kb = item / nblk, nb = item % nblk, k0 = 64 * kb, n0 = 32 * nb;
#pragma unroll 8
    for (int i = 0; i < 32; ++i) { const int kk = 2 * i + (lane >> 5); scr[kk * 33 + (lane & 31)] = W[(size_t)(k0 + kk) * N + n0 + (lane & 31)]; }
    asm volatile("s_waitcnt lgkmcnt(0)" ::: "memory");
    const int c = lane & 7;
#pragma unroll
    for (int j = 0; j < 4; ++j) { const int n = (lane >> 3) + 8 * j; const LAS float* s = scr + (8 * c) * 33 + n;
        u32x4 o; o.x = cvtpk(s[0 * 33], s[1 * 33]); o.y = cvtpk(s[2 * 33], s[3 * 33]); o.z = cvtpk(s[4 * 33], s[5 * 33]); o.w = cvtpk(s[6 * 33], s[7 * 33]);
        *(u32x4*)(WT + (size_t)(n0 + n) * K + k0 + 8 * c) = o; }
    asm volatile("s_waitcnt lgkmcnt(0)" ::: "memory");
}
__device__ __forceinline__ void rms_row_bf16(const float* __restrict__ xrow, const float* __restrict__ g, bf16_t* __restrict__ orow, int lane) {
    const f32x4* xr = (const f32x4*)xrow + lane; f32x4 v[4]; float s = 0.f;
#pragma unroll
    for (int j = 0; j < 4; ++j) { v[j] = xr[64 * j]; s += (v[j].x * v[j].x + v[j].y * v[j].y) + (v[j].z * v[j].z + v[j].w * v[j].w); }
    const float rstd = rsqrtf(wave_sum(s) * (1.f / DM) + EPS);
    u32x2* o8 = (u32x2*)orow + lane;
#pragma unroll
    for (int j = 0; j < 4; ++j) { const f32x4 gw = ((const f32x4*)g)[lane + 64 * j]; u32x2 w; w.x = cvtpk(v[j].x * rstd * gw.x, v[j].y * rstd * gw.y); w.y = cvtpk(v[j].z * rstd * gw.z, v[j].w * rstd * gw.w); o8[64 * j] = w; }
}

#ifndef PHMASK
#define PHMASK 0xFFF
#endif
#define PHON(n) (((PHMASK) >> (n)) & 1)
__global__ void __launch_bounds__(512, 2) hybrid_fwd(Params P) {
    extern __shared__ __attribute__((aligned(16))) unsigned char lds[];
    cg::grid_group grid = cg::this_grid();
    LAS unsigned char* ldsl = (LAS unsigned char*)lds;
    const int G = gridDim.x, bid = blockIdx.x, wv = __builtin_amdgcn_readfirstlane(threadIdx.x >> 6);
    const int vcu = (G % 8 == 0) ? (bid % 8) * (G / 8) + bid / 8 : bid;
    const int NGW = G * 8; const long NGT = (long)G * 512;
#ifndef PROBE
#define PROBE 0
#endif
#define PROBE_A0 10
#define PROBE_A1 11
#define PROBE_B0 8
#define PROBE_B1 9
#define STAMP(k) do { if (PROBE) { if (bid == 0 && opaque_tid(wv) == 0) ((unsigned long long*)(ws + 768 * 1024))[k] = __builtin_amdgcn_s_memrealtime(); } } while (0)
#define PHASE_IDS const int tid = opaque_tid(wv), lane = tid & 63, wave = __builtin_amdgcn_readfirstlane(tid >> 6), gw = bid * 8 + wave; const long gtid = (long)bid * 512 + tid; (void)lane; (void)gw; (void)gtid;
    unsigned char* ws = P.ws; unsigned char* dob = (unsigned char*)P.out;
    const float* xp = P.in[0]; const float* xs = P.in[1];
    const float *a_re = P.in[8], *a_im = P.in[9], *b_re = P.in[10], *b_im = P.in[11], *c_re = P.in[12], *c_im = P.in[13], *lstep = P.in[14], *s5d = P.in[15];
    float* cosT = (float*)(ws + WS_COS); float* sinT = (float*)(ws + WS_SIN); float* KT = (float*)(ws + WS_KT);
    bf16_t* WIN = (bf16_t*)(ws + WS_WIN); bf16_t* XN = (bf16_t*)(ws + WS_XN);
#define XN8 (dob + DO_XN8)
#define XS ((float*)(ws + WS_XS))
#define W8 (ws + WS_W8)
#define WSC ((float*)(ws + WS_WSC))
    bf16_t* AG = (bf16_t*)(dob + DO_AG); bf16_t* WG = (bf16_t*)(dob + DO_WG); bf16_t* WE = (bf16_t*)(dob + DO_WE); float* EC = (float*)(dob + DO_EC);

    STAMP(0);
    if constexpr (PHON(0))
    {
        PHASE_IDS
        LAS float* scr = (LAS float*)(ldsl + wave * 16384);
        constexpr int I_IN = 16 * 240, I_MKV = 16 * 32, I_PA = 16 * 32, I_PS = 8 * 32, I_PX = 8 * 32, I_OUT = 16 * 32, I_GLU = 8 * 16;
        constexpr int NITEMS = I_IN + I_MKV + I_PA + I_PS + I_PX + I_OUT + I_GLU;
        for (int it = gw; it < NITEMS; it += NGW) {
            int r = it;
            if (r < I_IN) { transpose_item(P.in[5], 1024, 7680, WIN, scr, r, lane); continue; } r -= I_IN;
            if (r < I_MKV) { transpose_item(P.in[19], 1024, 1024, (bf16_t*)(ws + WS_WMKV), scr, r, lane); continue; } r -= I_MKV;
            if (r < I_PA) { transpose_item(P.in[20], 1024, 1024, (bf16_t*)(ws + WS_WPA), scr, r, lane); continue; } r -= I_PA;
            if (r < I_PS) { transpose_item(P.in[21], 512, 1024, (bf16_t*)(ws + WS_WPS), scr, r, lane); continue; } r -= I_PS;
            if (r < I_PX) { transpose_item(P.in[22], 512, 1024, (bf16_t*)(ws + WS_WPX), scr, r, lane); continue; } r -= I_PX;
            if (r < I_OUT) { transpose_item(P.in[23], 1024, 1024, (bf16_t*)(ws + WS_WOUT), scr, r, lane); continue; } r -= I_OUT;
            transpose_item(P.in[16], 512, 512, (bf16_t*)(ws + WS_WGLU), scr, r, lane);
        }
        for (int m = gw; m < NTOK; m += 2 * NGW) {
            const int m2 = m + NGW; const bool has2 = m2 < NTOK;
            const f32x4* xa = (const f32x4*)(m < NPROMPT ? xp + (size_t)m * DM : xs + (size_t)(m - NPROMPT) * DM) + lane;
            const f32x4* xb2 = (const f32x4*)(!has2 ? xp : (m2 < NPROMPT ? xp + (size_t)m2 * DM : xs + (size_t)(m2 - NPROMPT) * DM)) + lane;
            f32x4 va[4], vb[4]; float sa = 0.f, sb = 0.f;
#pragma unroll
            for (int j = 0; j < 4; ++j) { va[j] = xa[64 * j]; vb[j] = xb2[64 * j]; }
#pragma unroll
            for (int j = 0; j < 4; ++j) { sa += (va[j].x * va[j].x + va[j].y * va[j].y) + (va[j].z * va[j].z + va[j].w * va[j].w); sb += (vb[j].x * vb[j].x + vb[j].y * vb[j].y) + (vb[j].z * vb[j].z + vb[j].w * vb[j].w); }
#pragma unroll
            for (int o = 1; o < 64; o <<= 1) { sa += __shfl_xor(sa, o); sb += __shfl_xor(sb, o); }
            const float ra = rsqrtf(sa * (1.f / DM) + EPS), rb = rsqrtf(sb * (1.f / DM) + EPS);
            u32x2* oa = (u32x2*)(XN + (size_t)m * DM) + lane; u32x2* ob2 = (u32x2*)(XN + (size_t)(has2 ? m2 : m) * DM) + lane;
            float ma = 1e-20f, mb = 1e-20f;
#pragma unroll
            for (int j = 0; j < 4; ++j) { const f32x4 gwt = ((const f32x4*)P.in[4])[lane + 64 * j];
                va[j] = va[j] * ra * gwt; vb[j] = vb[j] * rb * gwt;
                u32x2 w; w.x = cvtpk(va[j].x, va[j].y); w.y = cvtpk(va[j].z, va[j].w); oa[64 * j] = w;
                if (has2) { u32x2 w2; w2.x = cvtpk(vb[j].x, vb[j].y); w2.y = cvtpk(vb[j].z, vb[j].w); ob2[64 * j] = w2; }
                ma = fmaxf(fmaxf(ma, fmaxf(fabsf(va[j].x), fabsf(va[j].y))), fmaxf(fabsf(va[j].z), fabsf(va[j].w)));
                mb = fmaxf(fmaxf(mb, fmaxf(fabsf(vb[j].x), fabsf(vb[j].y))), fmaxf(fabsf(vb[j].z), fabsf(vb[j].w))); }
#pragma unroll
            for (int o = 1; o < 64; o <<= 1) { ma = fmaxf(ma, __shfl_xor(ma, o)); mb = fmaxf(mb, __shfl_xor(mb, o)); }
            const float ia = 127.f / ma, ib = 127.f / mb;
            unsigned* q8a = (unsigned*)(XN8 + (size_t)m * DM) + lane; unsigned* q8b = (unsigned*)(XN8 + (size_t)(has2 ? m2 : m) * DM) + lane;
#pragma unroll
            for (int j = 0; j < 4; ++j) {
                q8a[64 * j] = (unsigned)((int)rintf(va[j].x * ia) & 255) | ((unsigned)((int)rintf(va[j].y * ia) & 255) << 8) | ((unsigned)((int)rintf(va[j].z * ia) & 255) << 16) | ((unsigned)(int)rintf(va[j].w * ia) << 24);
                if (has2) q8b[64 * j] = (unsigned)((int)rintf(vb[j].x * ib) & 255) | ((unsigned)((int)rintf(vb[j].y * ib) & 255) << 8) | ((unsigned)((int)rintf(vb[j].z * ib) & 255) << 16) | ((unsigned)(int)rintf(vb[j].w * ib) << 24); }
            if (lane == 0) { XS[m] = ma * (1.f / 127.f); if (has2) XS[m2] = mb * (1.f / 127.f); }
        }
        for (int r = gw; r < NMEMROWS; r += NGW) rms_row_bf16(r < 2048 ? P.in[2] + (size_t)r * DM : P.in[3] + (size_t)(r - 2048) * DM, P.in[18], (bf16_t*)(ws + WS_MN) + (size_t)r * DM, lane);
        for (long i = gtid; i < 256 * 32; i += NGT) { const int pos = (int)(i >> 5), j = (int)(i & 31);
            const float freq = exp2f(-(float)j * (13.287712379549449f / 32.f)); const float ang = (float)pos * freq; float c, s; cexp_turns(ang * 0.15915494309189535f, c, s); cosT[i] = c; sinT[i] = s; }
        for (long i = gtid; i < NTOK; i += NGT) ((float*)(ws + WS_RSS))[i] = 0.f;
        if (gtid < 320) ((unsigned*)(ws + WS_CNT))[gtid] = 0u;
        {
            LAS float* bp = (LAS float*)(ldsl + wave * 16384);
            for (int wi = wave * G + bid; wi < 4096; wi += NGW) {
                const int dg = wi >> 6, tau = wi & 63, n = lane;
                const float dt = __expf(lstep[dg]); const float are = fminf(a_re[dg * 64 + n], -1e-4f), aim = a_im[dg * 64 + n];
                float cr, ci; zoh_coef(are, aim, dt, cr, ci); float pr, pi; lam_pow(are, aim, dt, (float)tau, pr, pi);
                const float qr_ = pr * cr - pi * ci, qi_ = pr * ci + pi * cr;
                const float* brp = b_re + (size_t)(dg * 64 + n) * 16; const float* bip = b_im + (size_t)(dg * 64 + n) * 16;
#pragma unroll
                for (int c4 = 0; c4 < 4; ++c4) { const f32x4 br = *(const f32x4*)(brp + 4 * c4), bi = *(const f32x4*)(bip + 4 * c4);
                    *(LAS f32x4*)(bp + n * 36 + 4 * c4) = qr_ * br - qi_ * bi; *(LAS f32x4*)(bp + n * 36 + 16 + 4 * c4) = qr_ * bi + qi_ * br; }
                asm volatile("s_waitcnt lgkmcnt(0)" ::: "memory");
                const int ch = lane >> 2, cq = (lane & 3) * 4;
                const float* crp = c_re + (size_t)(dg * 16 + ch) * 64; const float* cip = c_im + (size_t)(dg * 16 + ch) * 64;
                f32x4 acc = {0.f, 0.f, 0.f, 0.f};
#pragma unroll 4
                for (int n4 = 0; n4 < 16; ++n4) { const f32x4 c_r = *(const f32x4*)(crp + 4 * n4), c_i = *(const f32x4*)(cip + 4 * n4);
#pragma unroll
                    for (int e = 0; e < 4; ++e) { const int nn = 4 * n4 + e; const f32x4 bre = *(const LAS f32x4*)(bp + nn * 36 + cq), bim = *(const LAS f32x4*)(bp + nn * 36 + 16 + cq);
                        acc += c_r[e] * bre - c_i[e] * bim; } }
                *(f32x4*)(KT + ((size_t)(dg * 64 + tau) * 16 + ch) * 16 + cq) = acc;
                asm volatile("s_waitcnt lgkmcnt(0)" ::: "memory");
            }
        }
        for (long idx = gtid; idx < 32 * 256 * 64; idx += NGT) {
            const int j = (int)(idx & 63), col = (int)((idx >> 6) & 255), g = (int)(idx >> 14), dir = col >> 7, part = (col >> 6) & 1, n = col & 63, dg = dir * 32 + g;
            const float dt = __expf(lstep[dg]); const float are = fminf(a_re[dg * 64 + n], -1e-4f), aim = a_im[dg * 64 + n];
            float cr, ci; zoh_coef(are, aim, dt, cr, ci); float pr, pi; lam_pow(are, aim, dt, (float)(dir ? j : 63 - j), pr, pi);
            const float qr_ = pr * cr - pi * ci, qi_ = pr * ci + pi * cr;
            float v[16];
#pragma unroll
            for (int c = 0; c < 16; ++c) { const float br = b_re[(dg * 64 + n) * 16 + c], bi = b_im[(dg * 64 + n) * 16 + c]; v[c] = part ? (qr_ * bi + qi_ * br) : (qr_ * br - qi_ * bi); }
            u32x4 w0, w1; w0.x = cvtpk(v[0], v[1]); w0.y = cvtpk(v[2], v[3]); w0.z = cvtpk(v[4], v[5]); w0.w = cvtpk(v[6], v[7]);
            w1.x = cvtpk(v[8], v[9]); w1.y = cvtpk(v[10], v[11]); w1.z = cvtpk(v[12], v[13]); w1.w = cvtpk(v[14], v[15]);
            bf16_t* d = WE + ((size_t)(g * 256 + col)) * 1024 + j * 16; *(u32x4*)d = w0; *(u32x4*)(d + 8) = w1;
        }
    }
    __syncthreads();
    grid.sync();
    STAMP(1);

    if constexpr (PHON(1))
    {
        PHASE_IDS
        for (int r = gw; r < 5632; r += NGW) {
            const int rsrc = r < 2560 ? r : (r < 4608 ? r + 1024 : r + 2048);
            const u32x4* src = (const u32x4*)(WIN + (size_t)rsrc * 1024) + 2 * lane; const u32x4 a = src[0], b = src[1];
            float v[16]; v[0] = bflo(a.x); v[1] = bfhi(a.x); v[2] = bflo(a.y); v[3] = bfhi(a.y); v[4] = bflo(a.z); v[5] = bfhi(a.z); v[6] = bflo(a.w); v[7] = bfhi(a.w);
            v[8] = bflo(b.x); v[9] = bfhi(b.x); v[10] = bflo(b.y); v[11] = bfhi(b.y); v[12] = bflo(b.z); v[13] = bfhi(b.z); v[14] = bflo(b.w); v[15] = bfhi(b.w);
            float mx = 1e-30f;
#pragma unroll
            for (int j = 0; j < 16; ++j) mx = fmaxf(mx, fabsf(v[j]));
#pragma unroll
            for (int o = 1; o < 64; o <<= 1) mx = fmaxf(mx, __shfl_xor(mx, o));
            const float inv = 127.f / mx; unsigned w[4];
#pragma unroll
            for (int q = 0; q < 4; ++q) w[q] = (unsigned)((int)rintf(v[4 * q] * inv) & 255) | ((unsigned)((int)rintf(v[4 * q + 1] * inv) & 255) << 8) | ((unsigned)((int)rintf(v[4 * q + 2] * inv) & 255) << 16) | ((unsigned)(int)rintf(v[4 * q + 3] * inv) << 24);
            *((u32x4*)(W8 + (size_t)r * 1024) + lane) = (u32x4){w[0], w[1], w[2], w[3]};
            if (lane == 0) WSC[r] = mx * (1.f / 127.f);
        }
    }
    {
        PHASE_IDS
        for (int r = gw; r < 1024; r += NGW) {
            if (r < 1024) { const u32x4* src = (const u32x4*)((const bf16_t*)(ws + WS_WPA) + (size_t)r * 1024) + 2 * lane; const u32x4 a = src[0], b = src[1];
                int w0 = __builtin_amdgcn_cvt_pk_fp8_f32(bflo(a.x) * 32.f, bfhi(a.x) * 32.f, 0, false); w0 = __builtin_amdgcn_cvt_pk_fp8_f32(bflo(a.y) * 32.f, bfhi(a.y) * 32.f, w0, true);
                int w1 = __builtin_amdgcn_cvt_pk_fp8_f32(bflo(a.z) * 32.f, bfhi(a.z) * 32.f, 0, false); w1 = __builtin_amdgcn_cvt_pk_fp8_f32(bflo(a.w) * 32.f, bfhi(a.w) * 32.f, w1, true);
                int w2 = __builtin_amdgcn_cvt_pk_fp8_f32(bflo(b.x) * 32.f, bfhi(b.x) * 32.f, 0, false); w2 = __builtin_amdgcn_cvt_pk_fp8_f32(bflo(b.y) * 32.f, bfhi(b.y) * 32.f, w2, true);
                int w3 = __builtin_amdgcn_cvt_pk_fp8_f32(bflo(b.z) * 32.f, bfhi(b.z) * 32.f, 0, false); w3 = __builtin_amdgcn_cvt_pk_fp8_f32(bflo(b.w) * 32.f, bfhi(b.w) * 32.f, w3, true);
                *((u32x4*)(ws + WS_WPA8 + (size_t)r * 1024) + lane) = (u32x4){(unsigned)w0, (unsigned)w1, (unsigned)w2, (unsigned)w3}; }
            else { const int rr = r - 1024; const u32x4 a = *((const u32x4*)((const bf16_t*)(ws + WS_WPX) + (size_t)rr * 512) + lane);
                int w0 = __builtin_amdgcn_cvt_pk_fp8_f32(bflo(a.x) * 32.f, bfhi(a.x) * 32.f, 0, false); w0 = __builtin_amdgcn_cvt_pk_fp8_f32(bflo(a.y) * 32.f, bfhi(a.y) * 32.f, w0, true);
                int w1 = __builtin_amdgcn_cvt_pk_fp8_f32(bflo(a.z) * 32.f, bfhi(a.z) * 32.f, 0, false); w1 = __builtin_amdgcn_cvt_pk_fp8_f32(bflo(a.w) * 32.f, bfhi(a.w) * 32.f, w1, true);
                *((u32x2*)(ws + WS_WPX8 + (size_t)rr * 512) + lane) = (u32x2){(unsigned)w0, (unsigned)w1}; }
        }
    }
    __syncthreads();
    grid.sync();
    {
        pg8::Gemm g{(const bf16_t*)XN8, (const bf16_t*)W8, 512, 512, 512}; pg8::StaticOrder S; S.init(NTOK, 3584, G, bid);
        EpiInProjI8 E{ws, XS, WSC};
        pg8::gemm_phase<true>(ldsl, g, S, E, wv);
    }
    {
        pg8::Gemm g{XN, WIN + (size_t)2560 * 1024, 1024, 1024, 1024}; pg8::StaticOrder S; S.init(NTOK, 1024, G, bid);
        pg8::Epi8<FInProj> E{FInProj{ws, AG, 10}};
        pg8::gemm_phase(ldsl, g, S, E, wv);
    }
    if constexpr (PHON(1))
    {
        pg8::Gemm g{(const bf16_t*)(ws + WS_MN), (const bf16_t*)(ws + WS_WMKV), 1024, 1024, 1024}; pg8::StaticOrder S; S.init(NMEMROWS, 1024, G, (bid + 128) % G);
        pg8::Epi8<FStoreBf16> E{FStoreBf16{(bf16_t*)(ws + WS_KVM), 1024}};
        pg8::gemm_phase(ldsl, g, S, E, wv);
    }
    __syncthreads();
    grid.sync();
    STAMP(2);

    if constexpr (PHON(3))
    {
        pg8::Gemm g{AG, WE, AGK, 1024, 1024}; pg8::GroupedOrder S; S.init(32, 5, 1, G, bid);
        pg8::Epi8<FStoreEC> E{FStoreEC{EC}};
        pg8::gemm_phase(ldsl, g, S, E, wv);
    }
    __syncthreads();
    grid.sync();
    STAMP(4);

    if constexpr (PHON(4)) { PHASE_IDS
    for (long idx = ((long)wave * G + bid) * 64 + lane; idx < 9 * 32 * 2 * 64; idx += NGT) {
        const int n = (int)(idx & 63), dir = (int)((idx >> 6) & 1), g = (int)((idx >> 7) & 31), b = (int)(idx >> 12), dg = dir * 32 + g;
        const int c0 = b < 8 ? b * 128 : 1024, c1 = b < 8 ? c0 + 128 : 1280;
        const float dt = __expf(lstep[dg]); const float are = fminf(a_re[dg * 64 + n], -1e-4f), aim = a_im[dg * 64 + n];
        float lr, li; lam_pow(are, aim, dt, 64.f, lr, li);
        float sr = 0.f, si = 0.f;
        const int colE = dir * 128 + n;
        const int cstart = dir ? c1 - 1 : c0, cstep = dir ? -1 : 1;
        const float* e0 = EC + ((size_t)(g * NCHUNK + cstart)) * 256 + colE; bf16_t* a0 = AG + ((size_t)(g * NCHUNK + cstart)) * AGK + 1024 + colE;
        const long estep = (long)cstep * 256, astep = (long)cstep * AGK;
        for (int k = 0; k < c1 - c0; k += 16) {
            float er[16], ei[16];
#pragma unroll
            for (int j = 0; j < 16; ++j) { er[j] = e0[(k + j) * estep]; ei[j] = e0[(k + j) * estep + 64]; }
#pragma unroll
            for (int j = 0; j < 16; ++j) {
                bf16_t* ag = a0 + (k + j) * astep; ag[0] = (bf16_t)(cvtpk(sr, 0.f) & 0xffffu); ag[64] = (bf16_t)(cvtpk(si, 0.f) & 0xffffu);
                const float nr = lr * sr - li * si + er[j], ni = lr * si + li * sr + ei[j]; sr = nr; si = ni;
            }
        }
    }
    {
        bf16_t* Kb = (bf16_t*)(ws + WS_K); const float* kw = P.in[7]; unsigned char* K8 = ws + WS_K8;
        float wm = fmaxf(fabsf(kw[lane]), fabsf(kw[lane + 64]));
#pragma unroll
        for (int o = 1; o < 64; o <<= 1) wm = fmaxf(wm, __shfl_xor(wm, o));
        const float kmax = 11.3137085f * wm * 1.0001f + 1e-20f, ski = 127.f / kmax;
        if (lane == 0) *(float*)(ws + WS_SK) = kmax * (1.f / 127.f);
        const int kself = wave * G + bid; const bool split = NGW > 1152; const int nfree = split ? NGW - 576 : NGW, kfree = split ? kself - 576 : kself;
        if (kfree >= 0)
        for (int r8a = kfree; r8a < NTOK * 2 / 8; r8a += 2 * nfree) {
            u32x4 wv0[2], wv1[2]; u32x4* pp[2]; unsigned char* kd8[2]; bool okk[2]; f32x4 tc0[2], tc1[2], ts0[2], ts1[2];
            const int sub = lane & 7;
#pragma unroll
            for (int u = 0; u < 2; ++u) {
                const int r8 = r8a + u * nfree; okk[u] = r8 < NTOK * 2 / 8; const int rr = (okk[u] ? r8 : r8a) * 8 + (lane >> 3), token = rr >> 1, kvh = rr & 1;
                pp[u] = (u32x4*)(Kb + (size_t)token * 256 + kvh * 128 + sub * 16); wv0[u] = pp[u][0]; wv1[u] = pp[u][1];
                kd8[u] = K8 + (size_t)token * 256 + kvh * 128 + 32 * (sub >> 1) + 8 * (sub & 1);
                const int t = token < NPROMPT ? (token & (SEQ_P - 1)) : (token - NPROMPT); const int pos = sub < 4 ? (t >> 6) : (t & 63);
                const float* ct = cosT + pos * 32 + (sub & 3) * 8; const float* st = sinT + pos * 32 + (sub & 3) * 8;
                tc0[u] = *(const f32x4*)ct; tc1[u] = *(const f32x4*)(ct + 4); ts0[u] = *(const f32x4*)st; ts1[u] = *(const f32x4*)(st + 4);
            }
#pragma unroll
            for (int u = 0; u < 2; ++u) {
                const u32x4 w0 = wv0[u], w1 = wv1[u];
                float x[16]; x[0] = bflo(w0.x); x[1] = bfhi(w0.x); x[2] = bflo(w0.y); x[3] = bfhi(w0.y); x[4] = bflo(w0.z); x[5] = bfhi(w0.z); x[6] = bflo(w0.w); x[7] = bfhi(w0.w);
                x[8] = bflo(w1.x); x[9] = bfhi(w1.x); x[10] = bflo(w1.y); x[11] = bfhi(w1.y); x[12] = bflo(w1.z); x[13] = bfhi(w1.z); x[14] = bflo(w1.w); x[15] = bfhi(w1.w);
                float ss = 0.f;
#pragma unroll
                for (int j = 0; j < 16; ++j) ss += x[j] * x[j];
                ss += __shfl_xor(ss, 1); ss += __shfl_xor(ss, 2); ss += __shfl_xor(ss, 4);
                const float rstd = rsqrtf(ss * (1.f / 128.f) + EPS);
                unsigned ob[4] = {0u, 0u, 0u, 0u};
#pragma unroll
                for (int j = 0; j < 8; ++j) { const float a = x[2 * j] * rstd * kw[sub * 16 + 2 * j], b = x[2 * j + 1] * rstd * kw[sub * 16 + 2 * j + 1];
                    const float cs = j < 4 ? tc0[u][j & 3] : tc1[u][j & 3], sn = j < 4 ? ts0[u][j & 3] : ts1[u][j & 3];
                    const int q0 = (int)fminf(fmaxf(rintf((a * cs - b * sn) * ski), -127.f), 127.f), q1 = (int)fminf(fmaxf(rintf((a * sn + b * cs) * ski), -127.f), 127.f);
                    ob[j >> 1] |= ((unsigned)(q0 & 255) | ((unsigned)(q1 & 255) << 8)) << (16 * (j & 1)); }
                if (okk[u]) { *(u32x2*)kd8[u] = (u32x2){ob[0], ob[1]}; *(u32x2*)(kd8[u] + 16) = (u32x2){ob[2], ob[3]}; }
            }
        }
        if (kfree >= 0)
        for (int it = kfree; it < (NTOK / 64) * 2; it += nfree) {
            const bf16_t* vsrc = (const bf16_t*)(ws + WS_V) + (size_t)(it >> 1) * 64 * 256 + (it & 1) * 128 + 2 * lane;
            unsigned vraw[64];
#pragma unroll
            for (int k = 0; k < 64; ++k) vraw[k] = *(const unsigned*)(vsrc + (size_t)k * 256);
            unsigned char* dstb = ws + WS_V8 + (size_t)it * 8192;
#pragma unroll
            for (int sgl = 0; sgl < 2; ++sgl) {
                const int c = 2 * lane + sgl, sw = (c >> 2) & 3;
#pragma unroll
                for (int p = 0; p < 4; ++p) {
                    unsigned w[4];
#pragma unroll
                    for (int d = 0; d < 4; ++d) { float f[4];
#pragma unroll
                        for (int e = 0; e < 4; ++e) { const int b = 16 * p + 4 * d + e, h = b >> 5, j = b & 31;
                            const int key = (j < 16) ? ((j & 3) + 8 * (j >> 2) + 4 * h) : (32 + ((j - 16) & 3) + 8 * ((j - 16) >> 2) + 4 * h);
                            f[e] = sgl ? bfhi(vraw[key]) : bflo(vraw[key]); }
                        int ww = __builtin_amdgcn_cvt_pk_fp8_f32(f[0], f[1], 0, false); ww = __builtin_amdgcn_cvt_pk_fp8_f32(f[2], f[3], ww, true); w[d] = (unsigned)ww; }
                    *(u32x4*)(dstb + c * 64 + ((p ^ sw) << 4)) = (u32x4){w[0], w[1], w[2], w[3]};
                }
            }
        }
        if (kfree >= 0)
        for (long idx0 = (long)kfree * 64 + lane; idx0 < 32L * 1024 * 128; idx0 += 4L * nfree * 64) {
            f32x4 fa[4][2], fb[4][2]; int tauv[4], chv[4], c0v[4]; float dskv[4]; size_t dst[4]; bool ok[4];
#pragma unroll
            for (int u = 0; u < 4; ++u) {
                const long id = idx0 + (long)u * nfree * 64; ok[u] = id < 32L * 1024 * 128; const int idc = (int)(ok[u] ? id : idx0);
                const int q = idc & 127, r = (idc >> 7) & 1023, g = idc >> 17, i = r >> 4, ch = r & 15, j = q >> 1, c0 = (q & 1) * 8, tau = i - j;
                const float* pa = KT + ((size_t)(g * 64 + (tau > 0 ? tau : 0)) * 16 + ch) * 16 + c0;
                const float* pb = KT + ((size_t)((32 + g) * 64 + (tau < 0 ? -tau : 0)) * 16 + ch) * 16 + c0;
                fa[u][0] = *(const f32x4*)pa; fa[u][1] = *(const f32x4*)(pa + 4); fb[u][0] = *(const f32x4*)pb; fb[u][1] = *(const f32x4*)(pb + 4);
                tauv[u] = tau; chv[u] = ch; c0v[u] = c0; dskv[u] = s5d[g * 16 + ch]; dst[u] = ((size_t)(g * 1024 + r)) * AGK + q * 8;
            }
#pragma unroll
            for (int u = 0; u < 4; ++u) {
                const float wa = tauv[u] >= 0 ? 1.f : 0.f, wb = tauv[u] <= 0 ? 1.f : 0.f; float v[8];
#pragma unroll
                for (int e = 0; e < 8; ++e) v[e] = wa * fa[u][e >> 2][e & 3] + wb * fb[u][e >> 2][e & 3] + ((tauv[u] == 0 && (c0v[u] + e) == chv[u]) ? dskv[u] : 0.f);
                u32x4 w; w.x = cvtpk(v[0], v[1]); w.y = cvtpk(v[2], v[3]); w.z = cvtpk(v[4], v[5]); w.w = cvtpk(v[6], v[7]);
                if (ok[u]) *(u32x4*)(WG + dst[u]) = w;
            }
        }
        if (kfree >= 0)
        for (long idx = (long)kfree * 64 + lane; idx < 32L * 2 * 8 * 16; idx += (long)nfree * 64) {
            const int ch = (int)(idx & 15), oct = (int)((idx >> 4) & 7), dir = (int)((idx >> 7) & 1), g = (int)(idx >> 8), dg = dir * 32 + g, n0 = oct * 8;
            const float dt = __expf(lstep[dg]);
            float lr[8], li[8], pr[8], pi[8], cr[8], ci[8];
#pragma unroll
            for (int e = 0; e < 8; ++e) { const int n = n0 + e; const float are = fminf(a_re[dg * 64 + n], -1e-4f), aim = a_im[dg * 64 + n]; lam_pow(are, aim, dt, 1.f, lr[e], li[e]); pr[e] = lr[e]; pi[e] = li[e];
                cr[e] = c_re[(dg * 16 + ch) * 64 + n]; ci[e] = c_im[(dg * 16 + ch) * 64 + n]; }
            for (int pw = 1; pw <= 64; ++pw) {
                const int i = dir ? 64 - pw : pw - 1; float vr[8], vi[8];
#pragma unroll
                for (int e = 0; e < 8; ++e) { vr[e] = cr[e] * pr[e] - ci[e] * pi[e]; vi[e] = -(cr[e] * pi[e] + ci[e] * pr[e]);
                    const float nr = pr[e] * lr[e] - pi[e] * li[e], ni = pr[e] * li[e] + pi[e] * lr[e]; pr[e] = nr; pi[e] = ni; }
                bf16_t* d = WG + ((size_t)(g * 1024 + i * 16 + ch)) * AGK + 1024 + dir * 128 + n0;
                u32x4 w; w.x = cvtpk(vr[0], vr[1]); w.y = cvtpk(vr[2], vr[3]); w.z = cvtpk(vr[4], vr[5]); w.w = cvtpk(vr[6], vr[7]); *(u32x4*)d = w;
                w.x = cvtpk(vi[0], vi[1]); w.y = cvtpk(vi[2], vi[3]); w.z = cvtpk(vi[4], vi[5]); w.w = cvtpk(vi[6], vi[7]); *(u32x4*)(d + 64) = w;
            }
        }
    }
    }
    __syncthreads();
    grid.sync();
    STAMP(5);

    if constexpr (PHON(5))
    {
        pg8::Gemm g{AG, WG, AGK, AGK, AGK}; pg8::GroupedOrder S; S.init(32, 5, 4, G, bid);
        pg8::Epi8<FS5Out> E{FS5Out{(bf16_t*)(ws + WS_U)}};
        pg8::gemm_phase(ldsl, g, S, E, wv);
    }
    __syncthreads();
    grid.sync();
    STAMP(6);

    if constexpr (PHON(6))
    {
        pg8::Gemm g{(const bf16_t*)(ws + WS_U), (const bf16_t*)(ws + WS_WGLU), 512, 512, 512}; pg8::StaticOrder S; S.init(NTOK, 512, G, bid);
        pg8::Epi8<FGlu> E{FGlu{(const bf16_t*)(ws + WS_U), (bf16_t*)(ws + WS_GS), P.in[17]}};
        pg8::gemm_phase(ldsl, g, S, E, wv);
    }

    if constexpr (PHON(7))
    {
        bf16_t* Q = (bf16_t*)(ws + WS_Q); const unsigned char* K8 = ws + WS_K8; const unsigned char* V8 = ws + WS_V8; const bf16_t* GA = (const bf16_t*)(ws + WS_GA);
        const float skv = *(const float*)(ws + WS_SK);
        { const int per = (512 + G - 1) / G;
          for (int ui = vcu * per; ui < (vcu + 1) * per && ui < 512; ++ui) {
              const int qb = ui & 63, h = ui >> 6, kvh = h >> 2; const size_t tok0 = (size_t)NPROMPT + qb * 256;
              att::attn_unit_i8<1024, 256>(Q + tok0 * 1024 + h * 128, K8 + (size_t)NPROMPT * 256 + kvh * 128, V8 + ((size_t)(NPROMPT / 64) * 2 + kvh) * 8192, GA + tok0 * 1024 + h * 128,
                                           dob + DO_Y8A + tok0 * 1024 + h * 128, SEQ_S, (char*)lds, qb * 256, P.in[6], cosT, sinT, skv, wv);
          } }
        { const int per = (2048 + G - 1) / G;
          for (int uu = vcu * per; uu < (vcu + 1) * per && uu < 2048; ++uu) {
              int ui = uu;
              if (G == 256) { const int xcd = vcu >> 5, j = vcu & 31, k = uu & 7, pair = xcd * 2 + (k >> 2); ui = pair * 128 + j * 4 + (k & 3); }
              const int qb = ui & 31, hq = (ui >> 5) & 3, kvh = (ui >> 7) & 1, b = ui >> 8, h = kvh * 4 + hq; const size_t tok0 = (size_t)b * SEQ_P + qb * 256, kt0 = (size_t)b * SEQ_P;
              att::attn_unit_i8<1024, 256>(Q + tok0 * 1024 + h * 128, K8 + kt0 * 256 + kvh * 128, V8 + ((kt0 / 64) * 2 + kvh) * 8192, GA + tok0 * 1024 + h * 128,
                                           dob + DO_Y8A + tok0 * 1024 + h * 128, SEQ_P, (char*)lds, qb * 256, P.in[6], cosT, sinT, skv, wv);
          } }
        { bf16_t* QX = (bf16_t*)(ws + WS_QX); const bf16_t* GX = (const bf16_t*)(ws + WS_GX); const bf16_t* KVM = (const bf16_t*)(ws + WS_KVM);
          const int per = (1280 + G - 1) / G;
          for (int ui = vcu * per; ui < (vcu + 1) * per && ui < 1280; ++ui) {
              const int h = ui & 3, tb = ui >> 2; const size_t tok0 = (size_t)tb * 256; const int mb = tok0 < (size_t)NPROMPT ? (int)(tok0 / SEQ_P) : 8;
              const bf16_t* km = KVM + (size_t)mb * 256 * 1024 + h * 128;
              att::attn_unit<false, 512, 1024>(QX + tok0 * 512 + h * 128, km, km + 512, GX + tok0 * 512 + h * 128, QX + tok0 * 512 + h * 128, 256, (char*)lds, 0, nullptr, nullptr, nullptr, wv);
          } }
    }
    __syncthreads();
    grid.sync();
    STAMP(7);

    if constexpr (PHON(8))
    {
        pg8::Gemm g{(const bf16_t*)(dob + DO_Y8A), (const bf16_t*)(ws + WS_WPA8), 512, 512, 512, 0x79797979, 0x7A7A7A7A}; pg8::StaticOrder S; S.init(NTOK, 1024, G, bid);
        pg8::Epi8<FStoreBf16> E{FStoreBf16{(bf16_t*)(ws + WS_GA), 1024}};
        pg8::gemm_phase<2>(ldsl, g, S, E, wv);
    }
    if constexpr (PHON(8))
    {
        static_assert(WS_QX == WS_GS + (size_t)NTOK * 512 * 2 && WS_WPX == WS_WPS + (size_t)1024 * 512 * 2, "stacked PS/PX operands");
        pg8::Gemm g{(const bf16_t*)(ws + WS_GS), (const bf16_t*)(ws + WS_WPS), 512, 512, 512}; pg8::GroupedOrder S; S.init(2, NTOK / 256, 4, G, vcu);
        pg8::Epi8<FStorePSX> E{FStorePSX{ws}};
        pg8::gemm_phase(ldsl, g, S, E, wv);
    }
    __syncthreads();
    grid.sync();
    STAMP(8);

    if constexpr (PHON(9))
    {
        { pg8::Gemm g{(const bf16_t*)XN8, (const bf16_t*)(W8 + (size_t)3584 * 1024), 512, 512, 512}; pg8::PairOrder S{G, vcu};
          EpiMergeI8 E{ws, XS, WSC + 3584, (bf16_t*)(ws + WS_GA)};
          pg8::gemm_phase<true>(ldsl, g, S, E, wv); }
        { pg8::Gemm g{XN, WIN + (size_t)(4608 + 1024) * 1024, 1024, 1024, 1024}; pg8::SingleOrder S{G, vcu};
          pg8::Epi8<FMerge> E{FMerge{ws, (bf16_t*)(ws + WS_GA), 1}};
          pg8::gemm_phase(ldsl, g, S, E, wv); }
    }
    __syncthreads();
    grid.sync();
    STAMP(9);

    if constexpr (PHON(10))
    {
        pg8::Gemm g{(const bf16_t*)(ws + WS_GA), (const bf16_t*)(ws + WS_WOUT), 1024, 1024, 1024}; pg8::StaticOrder S; S.init(NTOK, 1024, G, bid);
        EpiOutNorm E{xp, xs, P.out, P.in[24], (float*)(ws + WS_RSS), (unsigned*)(ws + WS_CNT)};
        pg8::gemm_phase(ldsl, g, S, E, wv);
    }
    if (PROBE) {
        __syncthreads(); grid.sync(); STAMP(11);
        if (bid == 0) { PHASE_IDS
            __syncthreads();
            const unsigned long long* TS = (const unsigned long long*)(ws + 768 * 1024);
            const float tA_us = (float)(__hip_atomic_load(TS + PROBE_A1, __ATOMIC_RELAXED, __HIP_MEMORY_SCOPE_AGENT) - __hip_atomic_load(TS + PROBE_A0, __ATOMIC_RELAXED, __HIP_MEMORY_SCOPE_AGENT)) * 0.01f;
            const float tB_us = (float)(__hip_atomic_load(TS + PROBE_B1, __ATOMIC_RELAXED, __HIP_MEMORY_SCOPE_AGENT) - __hip_atomic_load(TS + PROBE_B0, __ATOMIC_RELAXED, __HIP_MEMORY_SCOPE_AGENT)) * 0.01f;
            if (tid == 0) P.out[0] += tA_us * (1.f / 2000.f);
            const float dB = sqrtf(80e-6f * tB_us * 1e-3f);
            for (int i = tid; i < 1048576; i += 512) P.out[1024 + i] += dB;
        }
    }
}

#undef XN8
#undef XS
#undef W8
#undef WSC
extern "C" void kernel_launch(void* const* d_in, const int* in_sizes, int n_in, void* d_out, int out_size, void* d_ws, size_t ws_size, hipStream_t stream) {
    static int grid = 0;
    if (grid == 0) {
        if (n_in != 25 || out_size != NTOK * DM || ws_size < WS_END) { fprintf(stderr, "kernel_launch: unexpected shapes (n_in %d out %d ws %zu)\n", n_in, out_size, ws_size); grid = -1; return; }
        int dev = 0, cus = 0, per_cu = 0;
        hipGetDevice(&dev); hipDeviceGetAttribute(&cus, hipDeviceAttributeMultiprocessorCount, dev);
        if (hipFuncSetAttribute((const void*)hybrid_fwd, hipFuncAttributeMaxDynamicSharedMemorySize, LDS_BYTES) != hipSuccess) { fprintf(stderr, "kernel_launch: hipFuncSetAttribute failed\n"); grid = -1; return; }
        if (hipOccupancyMaxActiveBlocksPerMultiprocessor(&per_cu, (const void*)hybrid_fwd, 512, LDS_BYTES) != hipSuccess || per_cu < 1) { fprintf(stderr, "kernel_launch: occupancy query failed (%d)\n", per_cu); (void)hipGetLastError(); per_cu = 1; }
        grid = cus * per_cu;
    }
    if (grid < 0) return;
    Params p{};
    for (int i = 0; i < 25; ++i) p.in[i] = (const float*)d_in[i];
    p.out = (float*)d_out; p.ws = (unsigned char*)d_ws;
    void* args[] = {&p};
    hipError_t e = hipLaunchCooperativeKernel((const void*)hybrid_fwd, dim3(grid), dim3(512), args, LDS_BYTES, stream);
    if (e != hipSuccess) fprintf(stderr, "kernel_launch: cooperative launch failed: %s (grid %d)\n", hipGetErrorString(e), grid);
}
```
